# Optimizing an MI355X kernel written in HIP

```python
import jax, jax.numpy as jnp
from jax import lax
import numpy as np

D_MODEL = 1024
BATCH = 16
SEQ = 2048
DEPTH = 4

PE_DIM = 256
D_MIX = D_MODEL
N_MIXERS = 4
GROUP_W = D_MIX // N_MIXERS
HEAD_DIM = 64
GROUP_HEADS = GROUP_W // HEAD_DIM
CONV_K = 4
MLSTM_CHUNK = 64
RG_C = 8.0
RWKV_DECAY_RANK = 32
RWKV_ICL_RANK = 32
RWKV_GATE_RANK = 64
RWKV_GN_EPS = 64e-5
SSD_STATE = 64
SSD_GROUPS = 2
SSD_CHUNK = 128
SSD_XBC = GROUP_W + 2 * SSD_GROUPS * SSD_STATE
M_COLS = 4 * GROUP_W + 2 * GROUP_HEADS
G_COLS = 2 * GROUP_W
R_COLS = 3 * GROUP_W + RWKV_DECAY_RANK + RWKV_ICL_RANK + RWKV_GATE_RANK
S_COLS = GROUP_W + SSD_XBC + GROUP_HEADS
N_IN = M_COLS + G_COLS + R_COLS + S_COLS
D_FF = 256 * ((8 * D_MODEL // 3 + 255) // 256)
N_EXPERTS = 8
TOP_K = 2
EXPERT_FF = D_FF
MOE_BLOCK = 256
N_DENSE = (DEPTH + 1) // 2
N_MOE = DEPTH // 2
ALPHA = (2 * DEPTH) ** 0.25
BETA = (8 * DEPTH) ** -0.25
LN_EPS = 1e-5
RMS_EPS = 1e-6

kernel_name = 'hymba_style_hybrid_mlstm_rglru_rwkv7_ssd_moe'


def _layer_norm(x, g, b):
    xf = x.astype(jnp.float32)
    xc = xf - jnp.mean(xf, -1, keepdims=True)
    var = jnp.mean(xc * xc, -1, keepdims=True)
    return (xc * lax.rsqrt(var + LN_EPS)).astype(x.dtype) * g + b


def _rms(x, w):
    xf = x.astype(jnp.float32)
    y = xf * lax.rsqrt(jnp.mean(xf * xf, -1, keepdims=True) + RMS_EPS)
    return y.astype(x.dtype) * w


def _causal_dwconv(u, w, b):
    k, c = w.shape
    out = lax.conv_general_dilated(u, w[:, None, :].astype(u.dtype), window_strides=(1,),
                                   padding=[(k - 1, 0)], dimension_numbers=('NWC', 'WIO', 'NWC'),
                                   feature_group_count=c)
    return out + b


def _linrec_combine(left, right):
    a_l, b_l = left
    a_r, b_r = right
    return a_l * a_r, a_r * b_l + b_r


def mlstm_group(cols, i_bias, f_bias, norm_w):
    bsz, seq, _ = cols.shape
    L, H, dh = MLSTM_CHUNK, GROUP_HEADS, HEAD_DIM
    nc = seq // L
    W = GROUP_W
    q, k, v, o, i_pre, f_pre = jnp.split(cols, [W, 2 * W, 3 * W, 4 * W, 4 * W + H], axis=-1)

    def heads(t):
        return t.reshape(bsz, nc, L, H, dh).transpose(0, 3, 1, 2, 4)

    def gates(t):
        return t.astype(jnp.float32).reshape(bsz, nc, L, H).transpose(0, 3, 1, 2)

    qh, kh, vh = heads(q), heads(k) * (dh ** -0.5), heads(v)
    log_i = gates(i_pre + i_bias)
    log_f = jax.nn.log_sigmoid(gates(f_pre + f_bias))
    b = jnp.cumsum(log_f, axis=-1)
    g = b[..., -1]
    a = g[..., None] - b + log_i

    def chunk_step(carry, xs):
        C, n, m = carry
        k_c, v_c, a_c, g_c = xs
        m_new = jnp.maximum(g_c + m, a_c.max(-1))
        decay = jnp.exp(g_c + m - m_new)
        w = jnp.exp(a_c - m_new[..., None])
        C_new = decay[..., None, None] * C + jnp.einsum('bhl,bhlv,bhlk->bhvk', w, v_c, k_c)
        n_new = decay[..., None] * n + jnp.einsum('bhl,bhlk->bhk', w, k_c)
        return (C_new, n_new, m_new), (C, n, m)

    init = (jnp.zeros((bsz, H, dh, dh), jnp.float32), jnp.zeros((bsz, H, dh), jnp.float32),
            jnp.zeros((bsz, H), jnp.float32))
    xs = (kh.transpose(2, 0, 1, 3, 4), vh.transpose(2, 0, 1, 3, 4), a.transpose(2, 0, 1, 3), g.transpose(2, 0, 1))
    _, (C_prev, n_prev, m_prev) = lax.scan(chunk_step, init, xs)
    C_prev = C_prev.transpose(1, 2, 0, 3, 4)
    n_prev = n_prev.transpose(1, 2, 0, 3)
    m_prev = m_prev.transpose(1, 2, 0)

    causal = jnp.tril(jnp.ones((L, L), bool))
    log_D = jnp.where(causal, b[..., :, None] - b[..., None, :] + log_i[..., None, :], -jnp.inf)
    inter_log = b + m_prev[..., None]
    m_t = jnp.maximum(inter_log, log_D.max(-1))
    s = jnp.einsum('bhcld,bhcsd->bhcls', qh, kh) * jnp.exp(log_D - m_t[..., None])
    inter_w = jnp.exp(inter_log - m_t)
    num = jnp.einsum('bhcls,bhcsd->bhcld', s, vh) + inter_w[..., None] * jnp.einsum('bhcvk,bhclk->bhclv', C_prev, qh)
    den = s.sum(-1) + inter_w * jnp.einsum('bhck,bhclk->bhcl', n_prev, qh)
    h = num / jnp.maximum(jnp.abs(den), jnp.exp(-m_t))[..., None]
    h = h.transpose(0, 2, 3, 1, 4).reshape(bsz, seq, H, dh)
    h = _rms(h.astype(cols.dtype), norm_w.reshape(H, dh)).reshape(bsz, seq, W)
    return h * jax.nn.sigmoid(o)


def rglru_group(cols, conv_w, conv_b, w_a, b_a, w_x, b_x, lam):
    bsz, seq, _ = cols.shape
    xb, gate = jnp.split(cols, [GROUP_W], axis=-1)
    xc = _causal_dwconv(xb, conv_w, conv_b)
    xh = xc.reshape(bsz, seq, GROUP_HEADS, HEAD_DIM)
    r = jax.nn.sigmoid(jnp.einsum('bshi,hij->bshj', xh, w_a).reshape(bsz, seq, GROUP_W) + b_a)
    ig = jax.nn.sigmoid(jnp.einsum('bshi,hij->bshj', xh, w_x).reshape(bsz, seq, GROUP_W) + b_x)
    log_a = (-RG_C * jax.nn.softplus(-lam) * r).astype(jnp.float32)
    a = jnp.exp(log_a)
    u = jnp.sqrt(-jnp.expm1(2.0 * log_a)) * (ig * xc)
    _, h = lax.associative_scan(_linrec_combine, (a, u), axis=1)
    return h.astype(cols.dtype) * jax.nn.gelu(gate)


def rwkv7_group(cols, mu, w0, w2, a0, a2, g2, k_k, k_a, r_k, ln_w, ln_b):
    bsz, seq, _ = cols.shape
    H, N, W = GROUP_HEADS, HEAD_DIM, GROUP_W
    prev = jnp.pad(cols[:, :-1], ((0, 0), (1, 0), (0, 0)))
    cols = cols + (prev - cols) * mu
    r, k, v, wd, ad, gd = jnp.split(
        cols, [W, 2 * W, 3 * W, 3 * W + RWKV_DECAY_RANK, 3 * W + RWKV_DECAY_RANK + RWKV_ICL_RANK], axis=-1)
    w_log = -jax.nn.softplus(-(w0 + jnp.tanh(wd) @ w2)) - 0.5
    decay = jnp.exp(-jnp.exp(w_log.astype(jnp.float32)))
    a = jax.nn.sigmoid(a0 + ad @ a2)
    g = jax.nn.sigmoid(gd) @ g2

    def hd(t):
        return t.reshape(bsz, seq, H, N)

    kk = hd(k * k_k).astype(jnp.float32)
    kk = kk * lax.rsqrt(jnp.maximum(jnp.sum(kk * kk, -1, keepdims=True), 1e-24))
    k = k * (1.0 + (a - 1.0) * k_a)
    rh, kh, vh = hd(r), hd(k), hd(v)

    def step(S, xs):
        r_t, d_t, k_t, v_t, kk_t, a_t = xs
        sa = jnp.einsum('bhvk,bhk->bhv', S, kk_t)
        S = (S * d_t[:, :, None, :] - sa[..., None] * (kk_t * a_t)[:, :, None, :]
             + v_t[..., None] * k_t[:, :, None, :])
        return S, jnp.einsum('bhvk,bhk->bhv', S, r_t)

    def tm(t):
        return t.astype(jnp.float32).transpose(1, 0, 2, 3)

    S0 = jnp.zeros((bsz, H, N, N), jnp.float32)
    _, y = lax.scan(step, S0, (tm(rh), tm(hd(decay)), tm(kh), tm(vh), tm(kk), tm(hd(a))))
    y = y.transpose(1, 0, 2, 3)
    yc = y - jnp.mean(y, -1, keepdims=True)
    yn = yc * lax.rsqrt(jnp.mean(yc * yc, -1, keepdims=True) + RWKV_GN_EPS)
    yn = yn.reshape(bsz, seq, W).astype(cols.dtype) * ln_w + ln_b
    bonus = jnp.sum(rh * kh * r_k, -1, keepdims=True) * vh
    return (yn + bonus.reshape(bsz, seq, W)) * g


def ssd_group(cols, conv_w, conv_b, dt_bias, a_log, d_skip, norm_w):
    bsz, seq, _ = cols.shape
    H, P, G, N, L = GROUP_HEADS, HEAD_DIM, SSD_GROUPS, SSD_STATE, SSD_CHUNK
    nc = seq // L
    z, xbc, dt = jnp.split(cols, [GROUP_W, GROUP_W + SSD_XBC], axis=-1)
    xbc = jax.nn.silu(_causal_dwconv(xbc, conv_w, conv_b))
    xs, bm, cm = jnp.split(xbc, [GROUP_W, GROUP_W + G * N], axis=-1)
    x = xs.reshape(bsz, nc, L, H, P)
    rep = H // G
    bm = jnp.repeat(bm.reshape(bsz, nc, L, G, N), rep, axis=3)
    cm = jnp.repeat(cm.reshape(bsz, nc, L, G, N), rep, axis=3)
    dt = jax.nn.softplus((dt + dt_bias).astype(jnp.float32)).reshape(bsz, nc, L, H)
    a_dt = (-jnp.exp(a_log.astype(jnp.float32)) * dt).transpose(0, 3, 1, 2)
    a_cs = jnp.cumsum(a_dt, axis=-1)
    causal = jnp.tril(jnp.ones((L, L), bool))
    decay_in = jnp.exp(jnp.where(causal, a_cs[..., :, None] - a_cs[..., None, :], -jnp.inf))
    xdt = x * dt[..., None]
    scores = jnp.einsum('bclhn,bcshn->bhcls', cm, bm) * decay_in
    y_diag = jnp.einsum('bhcls,bcshp->bclhp', scores, xdt)
    decay_states = jnp.exp(a_cs[..., -1:] - a_cs)
    states = jnp.einsum('bclhn,bhcl,bclhp->bchpn', bm, decay_states, xdt)
    tot_cs = jnp.cumsum(jnp.pad(a_cs[..., -1], ((0, 0), (0, 0), (1, 0))), axis=-1)
    chunk_causal = jnp.tril(jnp.ones((nc + 1, nc + 1), bool))
    decay_chunk = jnp.exp(jnp.where(chunk_causal, tot_cs[..., :, None] - tot_cs[..., None, :], -jnp.inf))
    states = jnp.pad(states, ((0, 0), (1, 0), (0, 0), (0, 0), (0, 0)))
    states_in = jnp.einsum('bhzc,bchpn->bzhpn', decay_chunk, states)[:, :-1]
    y_off = jnp.einsum('bclhn,bchpn,bhcl->bclhp', cm, states_in, jnp.exp(a_cs))
    y = y_diag + y_off + x * d_skip[:, None]
    y = y.reshape(bsz, seq, GROUP_W).astype(cols.dtype) * jax.nn.silu(z)
    y = _rms(y.reshape(bsz, seq, G, GROUP_W // G), norm_w.reshape(G, GROUP_W // G))
    return y.reshape(bsz, seq, GROUP_W)


def _swiglu(x, w1, w3, w2):
    return (jax.nn.silu(x @ w1) * (x @ w3)) @ w2


def _moe_swiglu(x, w_router, w1, w3, w2):
    bsz, seq, d = x.shape
    T = bsz * seq
    xf = x.reshape(T, d)
    logits = (xf @ w_router).astype(jnp.float32)
    top_logit, top_e = lax.top_k(logits, TOP_K)
    gate = jax.nn.softmax(top_logit, axis=-1).astype(x.dtype)
    flat_e = top_e.reshape(-1)
    flat_tok = jnp.repeat(jnp.arange(T, dtype=jnp.int32), TOP_K)
    order = jnp.argsort(flat_e)
    se, st, sg = flat_e[order], flat_tok[order], gate.reshape(-1)[order]
    counts = jnp.bincount(flat_e, length=N_EXPERTS)
    padded = (counts + MOE_BLOCK - 1) // MOE_BLOCK * MOE_BLOCK
    pad_end = jnp.cumsum(padded)
    start = jnp.cumsum(counts) - counts
    dest = (pad_end - padded)[se] + jnp.arange(T * TOP_K) - start[se]
    n_blocks = -(-(T * TOP_K) // MOE_BLOCK) + N_EXPERTS
    rows = n_blocks * MOE_BLOCK
    slot_tok = jnp.zeros((rows,), jnp.int32).at[dest].set(st)
    slot_gate = jnp.zeros((rows,), x.dtype).at[dest].set(sg)
    block_e = jnp.minimum(jnp.searchsorted(pad_end, jnp.arange(n_blocks) * MOE_BLOCK, side='right'), N_EXPERTS - 1)
    xb = xf[slot_tok].reshape(n_blocks, MOE_BLOCK, d)

    def expert_block(args):
        xblk, e = args
        return (jax.nn.silu(xblk @ w1[e]) * (xblk @ w3[e])) @ w2[e]

    yb = lax.map(expert_block, (xb, block_e))
    y = jnp.zeros((T, d), x.dtype).at[slot_tok].add(yb.reshape(rows, d) * slot_gate[:, None])
    return y.reshape(bsz, seq, d)


def setup_inputs(seed: int = 0) -> dict:
    key = jax.random.key(seed)
    ks = iter(jax.random.split(key, 64))

    def nrm(shape, scale):
        return jax.random.normal(next(ks), shape, jnp.float32) * scale

    def unif(shape, lo, hi):
        return jax.random.uniform(next(ks), shape, jnp.float32, lo, hi)

    Lyr, W, H, P = DEPTH, GROUP_W, GROUP_HEADS, HEAD_DIM
    x = nrm((BATCH, SEQ, D_MODEL), 1.0)
    p = nrm((DEPTH, BATCH, SEQ, PE_DIM), 1.0)
    w_in = nrm((Lyr, D_MODEL, N_IN), D_MODEL ** -0.5)
    m_i_bias = nrm((Lyr, H), 0.1)
    m_f_bias = jnp.linspace(3.0, 6.0, H)[None, :] + nrm((Lyr, H), 0.1)
    m_norm_w = 1.0 + nrm((Lyr, W), 0.02)
    g_conv_w = nrm((Lyr, CONV_K, W), CONV_K ** -0.5)
    g_conv_b = nrm((Lyr, W), 0.01)
    g_w_a = nrm((Lyr, H, P, P), P ** -0.5)
    g_b_a = nrm((Lyr, W), 0.01)
    g_w_x = nrm((Lyr, H, P, P), P ** -0.5)
    g_b_x = nrm((Lyr, W), 0.01)
    s_pow = unif((Lyr, W), 0.9, 0.999) ** (1.0 / RG_C)
    g_lambda = jnp.log(s_pow) - jnp.log1p(-s_pow)
    r_mu = unif((Lyr, R_COLS), 0.0, 1.0)
    r_w0 = (-6.0 + 5.0 * (jnp.arange(W, dtype=jnp.float32) / (W - 1)) ** 0.85)[None, :] + nrm((Lyr, W), 0.1)
    r_w2 = nrm((Lyr, RWKV_DECAY_RANK, W), 0.1 * RWKV_DECAY_RANK ** -0.5)
    r_a0 = nrm((Lyr, W), 0.1)
    r_a2 = nrm((Lyr, RWKV_ICL_RANK, W), RWKV_ICL_RANK ** -0.5)
    r_g2 = nrm((Lyr, RWKV_GATE_RANK, W), RWKV_GATE_RANK ** -0.5)
    r_k_k = 0.85 + nrm((Lyr, W), 0.02)
    r_k_a = 1.0 + nrm((Lyr, W), 0.02)
    r_r_k = -0.04 + nrm((Lyr, H, P), 0.01)
    r_ln_w = 1.0 + nrm((Lyr, W), 0.02)
    r_ln_b = nrm((Lyr, W), 0.01)
    s_conv_w = nrm((Lyr, CONV_K, SSD_XBC), CONV_K ** -0.5)
    s_conv_b = nrm((Lyr, SSD_XBC), 0.01)
    dt0 = jnp.exp(unif((Lyr, H), float(np.log(1e-3)), float(np.log(1e-1))))
    s_dt_bias = dt0 + jnp.log(-jnp.expm1(-dt0))
    s_a_log = jnp.log(unif((Lyr, H), 1.0, 16.0))
    s_d = 1.0 + nrm((Lyr, H), 0.1)
    s_norm_w = 1.0 + nrm((Lyr, W), 0.02)
    w_out = nrm((Lyr, D_MIX, D_MODEL), D_MIX ** -0.5 * BETA)
    ln1_g = 1.0 + nrm((Lyr, D_MODEL), 0.02)
    ln1_b = nrm((Lyr, D_MODEL), 0.01)
    ln2_g = 1.0 + nrm((Lyr, D_MODEL), 0.02)
    ln2_b = nrm((Lyr, D_MODEL), 0.01)
    f_w1 = nrm((N_DENSE, D_MODEL, D_FF), D_MODEL ** -0.5)
    f_w3 = nrm((N_DENSE, D_MODEL, D_FF), D_MODEL ** -0.5)
    f_w2 = nrm((N_DENSE, D_FF, D_MODEL), D_FF ** -0.5 * BETA)
    e_router = nrm((N_MOE, D_MODEL, N_EXPERTS), D_MODEL ** -0.5)
    e_w1 = nrm((N_MOE, N_EXPERTS, D_MODEL, EXPERT_FF), D_MODEL ** -0.5)
    e_w3 = nrm((N_MOE, N_EXPERTS, D_MODEL, EXPERT_FF), D_MODEL ** -0.5)
    e_w2 = nrm((N_MOE, N_EXPERTS, EXPERT_FF, D_MODEL), EXPERT_FF ** -0.5 * BETA)
    pe_proj = nrm((Lyr, PE_DIM, D_MODEL), PE_DIM ** -0.5 * BETA)
    pe_gate_w = nrm((Lyr, D_MODEL, D_MODEL), D_MODEL ** -0.5)
    pe_gate_b = nrm((Lyr, D_MODEL), 0.01)
    return {'x': x, 'p': p, 'w_in': w_in, 'm_i_bias': m_i_bias, 'm_f_bias': m_f_bias, 'm_norm_w': m_norm_w,
            'g_conv_w': g_conv_w, 'g_conv_b': g_conv_b, 'g_w_a': g_w_a, 'g_b_a': g_b_a, 'g_w_x': g_w_x,
            'g_b_x': g_b_x, 'g_lambda': g_lambda, 'r_mu': r_mu, 'r_w0': r_w0, 'r_w2': r_w2, 'r_a0': r_a0,
            'r_a2': r_a2, 'r_g2': r_g2, 'r_k_k': r_k_k, 'r_k_a': r_k_a, 'r_r_k': r_r_k, 'r_ln_w': r_ln_w,
            'r_ln_b': r_ln_b, 's_conv_w': s_conv_w, 's_conv_b': s_conv_b, 's_dt_bias': s_dt_bias,
            's_a_log': s_a_log, 's_d': s_d, 's_norm_w': s_norm_w, 'w_out': w_out, 'ln1_g': ln1_g,
            'ln1_b': ln1_b, 'ln2_g': ln2_g, 'ln2_b': ln2_b, 'f_w1': f_w1, 'f_w3': f_w3, 'f_w2': f_w2,
            'e_router': e_router, 'e_w1': e_w1, 'e_w3': e_w3, 'e_w2': e_w2, 'pe_proj': pe_proj,
            'pe_gate_w': pe_gate_w, 'pe_gate_b': pe_gate_b}


def reference(x, p, w_in, m_i_bias, m_f_bias, m_norm_w, g_conv_w, g_conv_b, g_w_a, g_b_a, g_w_x, g_b_x,
              g_lambda, r_mu, r_w0, r_w2, r_a0, r_a2, r_g2, r_k_k, r_k_a, r_r_k, r_ln_w, r_ln_b,
              s_conv_w, s_conv_b, s_dt_bias, s_a_log, s_d, s_norm_w, w_out, ln1_g, ln1_b, ln2_g, ln2_b,
              f_w1, f_w3, f_w2, e_router, e_w1, e_w3, e_w2, pe_proj, pe_gate_w, pe_gate_b):
    splits = [M_COLS, M_COLS + G_COLS, M_COLS + G_COLS + R_COLS]
    for i in range(DEPTH):
        proj = x @ w_in[i]
        m_cols, g_cols, r_cols, s_cols = jnp.split(proj, splits, axis=-1)
        mix = jnp.concatenate([
            mlstm_group(m_cols, m_i_bias[i], m_f_bias[i], m_norm_w[i]),
            rglru_group(g_cols, g_conv_w[i], g_conv_b[i], g_w_a[i], g_b_a[i], g_w_x[i], g_b_x[i], g_lambda[i]),
            rwkv7_group(r_cols, r_mu[i], r_w0[i], r_w2[i], r_a0[i], r_a2[i], r_g2[i], r_k_k[i], r_k_a[i],
                        r_r_k[i], r_ln_w[i], r_ln_b[i]),
            ssd_group(s_cols, s_conv_w[i], s_conv_b[i], s_dt_bias[i], s_a_log[i], s_d[i], s_norm_w[i]),
        ], axis=-1)
        x = _layer_norm(ALPHA * x + mix @ w_out[i], ln1_g[i], ln1_b[i])
        if i % 2 == 0:
            ff = _swiglu(x, f_w1[i // 2], f_w3[i // 2], f_w2[i // 2])
        else:
            ff = _moe_swiglu(x, e_router[i // 2], e_w1[i // 2], e_w3[i // 2], e_w2[i // 2])
        pe = (p[i] @ pe_proj[i]) * jax.nn.sigmoid(x @ pe_gate_w[i] + pe_gate_b[i])
        x = _layer_norm(ALPHA * x + ff + pe, ln2_g[i], ln2_b[i])
    return x
```

```cpp
#include <hip/hip_runtime.h>
#include <cstdio>
#include <cstdint>

#define LAS __attribute__((address_space(3)))
typedef unsigned short bf16_t;
typedef short bf16x8 __attribute__((ext_vector_type(8)));
typedef float f32x4 __attribute__((ext_vector_type(4)));
typedef float f32x2 __attribute__((ext_vector_type(2)));
typedef unsigned u32x4 __attribute__((ext_vector_type(4)));
typedef unsigned u32x2 __attribute__((ext_vector_type(2)));
#define DI __device__ __forceinline__

constexpr int NB = 16, SEQ = 2048, T = NB * SEQ, D = 1024, DEPTH = 4, PE_DIM = 256;
constexpr int NIN = 3212, NINP = 3328, DFF = 2816, NH2 = 2 * DFF, NE = 8;
constexpr int OFF_M = 0, OFF_G = 1032, OFF_R = 1544, OFF_S = 2440;
constexpr float ALPHA = 1.6817928305074290f;
constexpr int MOE_ROWS = 2 * T + NE * 256;

DI float bf2f(bf16_t b) { return __uint_as_float(((unsigned)b) << 16); }
DI bf16_t f2bf(float f) { unsigned u = __float_as_uint(f); u += 0x7FFFu + ((u >> 16) & 1u); return (bf16_t)(u >> 16); }
DI unsigned pack_bf16(float lo, float hi) { return (unsigned)f2bf(lo) | ((unsigned)f2bf(hi) << 16); }
DI float sigmoidf_(float x) { return 1.0f / (1.0f + __expf(-x)); }
DI float softplusf_(float x) { return fmaxf(x, 0.f) + log1pf(__expf(-fabsf(x))); }
DI float siluf_(float x) { return x * sigmoidf_(x); }
DI float gelu_tanhf_(float x) { const float u = 0.7978845608028654f * (x + 0.044715f * x * x * x); return 0.5f * x * (1.0f + tanhf(u)); }
DI float wave_sum(float v) {
#pragma unroll
    for (int o = 32; o >= 1; o >>= 1) v += __shfl_xor(v, o);
    return v;
}
DI float grp16_sum(float v) {
#pragma unroll
    for (int o = 8; o >= 1; o >>= 1) v += __shfl_xor(v, o);
    return v;
}
DI unsigned long long rfl64(unsigned long long v) { const unsigned lo = __builtin_amdgcn_readfirstlane((unsigned)v), hi = __builtin_amdgcn_readfirstlane((unsigned)(v >> 32)); return ((unsigned long long)hi << 32) | lo; }
#define XB_TMO      128
#define XB_XCNT(j)  (256  + 64 * (j))
#define XB_XSUB(j)  (1280 + 64 * (j))
#define XB_XGEN(j)  (2304 + 64 * (j))
#define XB_TOP      3328
#define XB_TOPGEN   3392
#define XCD_BAR_WORDS 3456
#define XB_SPIN_CAP (1u << 18)

__device__ __forceinline__ unsigned xb_ld(unsigned* p)              { return __hip_atomic_load(p, __ATOMIC_RELAXED, __HIP_MEMORY_SCOPE_AGENT); }
__device__ __forceinline__ unsigned xb_add(unsigned* p, unsigned v) { return __hip_atomic_fetch_add(p, v, __ATOMIC_RELAXED, __HIP_MEMORY_SCOPE_AGENT); }
__device__ __forceinline__ unsigned xb_xcc_id() { return (unsigned)__builtin_amdgcn_s_getreg((3 << 11) | 20) & 0xFu; }
#define XB_SPIN(cond, bar) do { unsigned _sp = 0; while (cond) { __builtin_amdgcn_s_sleep(1); \
    if ((++_sp & 255u) == 0u) { if (xb_ld(&(bar)[XB_TMO])) break; if (_sp > XB_SPIN_CAP) { atomicAdd(&(bar)[XB_TMO], 1u); break; } } } } while (0)

struct XcdBarrier {
    unsigned* bar; unsigned x;
    volatile LAS unsigned* st;
};

__device__ __forceinline__ XcdBarrier xcd_barrier_post(unsigned* bar, volatile LAS unsigned* st) {
    XcdBarrier b; b.bar = bar; b.x = xb_xcc_id(); b.st = st;
    if (threadIdx.x == 0) (void)xb_add(&bar[XB_XCNT(b.x)], 1u);
    return b;
}
__device__ __forceinline__ void xcd_barrier_complete(unsigned* bar, unsigned x, unsigned& nloc, unsigned& nx) {
    const unsigned G = gridDim.x * gridDim.y * gridDim.z;
    unsigned sum, cnt, mine, sp = 0u;
    for (;;) {
        sum = 0u; cnt = 0u; mine = 0u;
#pragma unroll
        for (unsigned j = 0; j < 16; ++j) { const unsigned c = xb_ld(&bar[XB_XCNT(j)]); sum += c; cnt += (c > 0u) ? 1u : 0u; mine = (j == x) ? c : mine; }
        if (sum == G) break;
        __builtin_amdgcn_s_sleep(1);
        if ((++sp & 255u) == 0u) { if (xb_ld(&bar[XB_TMO])) break; if (sp > XB_SPIN_CAP) { atomicAdd(&bar[XB_TMO], 1u); break; } }
    }
    nloc = mine > 0u ? mine : 1u; nx = cnt > 0u ? cnt : 1u;
}

__device__ __forceinline__ void xcd_barrier(const XcdBarrier& b) {
    asm volatile("s_waitcnt vmcnt(0)" ::: "memory");
    __syncthreads();
    if (threadIdx.x == 0) {
        unsigned* bar = b.bar;
        __builtin_amdgcn_s_waitcnt(0);
        unsigned nloc = b.st[0], nx = b.st[1];
        if (nloc == 0u) { xcd_barrier_complete(bar, b.x, nloc, nx); b.st[0] = nloc; b.st[1] = nx; }
        const unsigned old = xb_add(&bar[XB_XSUB(b.x)], 1u);
        const unsigned gen = old / nloc;
        if (old + 1u == (gen + 1u) * nloc) {
            __builtin_amdgcn_fence(__ATOMIC_RELEASE, "agent");
            asm volatile("s_waitcnt vmcnt(0)" ::: "memory");
            const unsigned og = xb_add(&bar[XB_TOP], 1u);
            const unsigned tg = og / nx;
            if (og + 1u == (tg + 1u) * nx) xb_add(&bar[XB_TOPGEN], 1u);
            else XB_SPIN(xb_ld(&bar[XB_TOPGEN]) == tg, bar);
            __builtin_amdgcn_fence(__ATOMIC_ACQUIRE, "agent");
            xb_add(&bar[XB_XGEN(b.x)], 1u);
            asm volatile("s_waitcnt vmcnt(0)" ::: "memory");
        } else {
            XB_SPIN(xb_ld(&bar[XB_XGEN(b.x)]) == gen, bar);
            __builtin_amdgcn_fence(__ATOMIC_ACQUIRE, "agent");
            asm volatile("s_waitcnt vmcnt(0)" ::: "memory");
        }
    }
    __syncthreads();
}
namespace pg8 {
typedef short bf16x8 __attribute__((ext_vector_type(8)));
typedef float f32x4 __attribute__((ext_vector_type(4)));
typedef unsigned u32x4 __attribute__((ext_vector_type(4)));
constexpr int BM = 256, BK = 64, HALF = 128, HTB = HALF * BK * 2  , STAGE_BYTES = 8 * HTB, NXCD = 8, WGM = 8;

__host__ __device__ __forceinline__ int lds_byte(int r, int c) { const int st = (r >> 4) * 2 + (c >> 5), rr = r & 15, cc = c & 31, ob = rr * 64 + cc * 2; return st * 1024 + (ob ^ (((ob >> 9) & 1) << 5)); }
__host__ __device__ __forceinline__ void stage_rc(int b, int& R, int& C) { const int st = b / 1024, sb = b % 1024, swz = sb ^ (((sb >> 9) & 1) << 5); R = (st >> 1) * 16 + swz / 64; C = (st & 1) * 32 + (swz % 64) / 2; }
__host__ __device__ __forceinline__ int perm32(int rho) { const int n = rho >> 4, i = rho & 15; return 8 * (i >> 2) + 4 * n + (i & 3); }

#define PG8_LAS __attribute__((address_space(3)))
struct Unit { int pm, pn; size_t boff; };
struct Gemm { const bf16_t* A; const bf16_t* Bt; int M, N, K; };

struct StaticOrder {
    int nM, nN, nwg, G, c;
    __device__ void init(int M, int N, int G_, int c_) { nM = M / BM; nN = N / BM; nwg = nM * nN; G = G_; c = c_; }
    __device__ bool next(int i, Unit& u) const {
        const long L = (long)i * G + c; if (L >= nwg) return false;
        int wgid = (int)L; { const int q = nwg / NXCD, r = nwg % NXCD, xcd = wgid % NXCD, off = wgid / NXCD; wgid = (xcd < r ? xcd * (q + 1) : r * (q + 1) + (xcd - r) * q) + off; }
        const int nig = WGM * nN, gid = wgid / nig, fm = gid * WGM, gsz = (nM - fm) < WGM ? (nM - fm) : WGM;
        u.pm = fm + ((wgid % nig) % gsz); u.pn = (wgid % nig) / gsz; u.boff = 0; return true;
    }
    __device__ __forceinline__ void a_ready(const Unit&) const {}
    __device__ __forceinline__ void done(const Unit&) const {}
};
struct MoeOrder : StaticOrder {
    int tstart[NE + 1]; size_t estride;
    __device__ void init_moe(const unsigned* counts, int nN_, int G_, int c_, size_t estride_) {
        int acc = 0;
#pragma unroll
        for (int e = 0; e < NE; ++e) { tstart[e] = acc; acc += __builtin_amdgcn_readfirstlane(((int)counts[e] + 255) >> 8); }
        tstart[NE] = acc; nM = acc; nN = nN_; nwg = nM * nN; G = G_; c = c_; estride = estride_;
    }
    __device__ bool next(int i, Unit& u) const {
        if (!StaticOrder::next(i, u)) return false;
        int e = 0;
#pragma unroll
        for (int j = 1; j < NE; ++j) e += (u.pm >= tstart[j]) ? 1 : 0;
        u.boff = (size_t)e * estride; return true;
    }
};

__device__ __forceinline__ unsigned cvt_pk_bf16(float lo, float hi) { unsigned r; asm volatile("v_cvt_pk_bf16_f32 %0, %1, %2" : "=v"(r) : "v"(lo), "v"(hi)); return r; }
__device__ __forceinline__ float bflo(unsigned w) { return __uint_as_float(w << 16); }
__device__ __forceinline__ float bfhi(unsigned w) { return __uint_as_float(w & 0xFFFF0000u); }
__device__ __forceinline__ float sigm(float x) { return 1.0f / (1.0f + __expf(-x)); }

struct EpiBf16 {
    static constexpr bool PERM = true, AFTER_DRAIN = false;
    bf16_t* O; int ldc;
    __device__ __forceinline__ void operator()(const f32x4 (&acc)[2][2][4][2], const Unit& u, int wr, int wc, int fr, int fq) const {
        const int row0 = u.pm * BM + wr * 64 + fr, col0 = u.pn * BM + wc * 32 + 8 * fq;
#pragma unroll
        for (int ai = 0; ai < 2; ++ai)
#pragma unroll
            for (int m = 0; m < 4; ++m) { bf16_t* rowp = O + (size_t)(row0 + ai * HALF + m * 16) * ldc + col0;
#pragma unroll
                for (int bj = 0; bj < 2; ++bj) { const f32x4 v0 = acc[ai][bj][m][0], v1 = acc[ai][bj][m][1];
                    u32x4 w; w.x = cvt_pk_bf16(v0[0], v0[1]); w.y = cvt_pk_bf16(v0[2], v0[3]); w.z = cvt_pk_bf16(v1[0], v1[1]); w.w = cvt_pk_bf16(v1[2], v1[3]);
                    *(u32x4*)(rowp + bj * HALF) = w; } }
    }
};
struct EpiSwiglu {
    static constexpr bool PERM = true, AFTER_DRAIN = false;
    bf16_t* H; int ldh;
    __device__ __forceinline__ void operator()(const f32x4 (&acc)[2][2][4][2], const Unit& u, int wr, int wc, int fr, int fq) const {
        const int row0 = u.pm * BM + wr * 64 + fr, col0 = u.pn * HALF + wc * 32 + 8 * fq;
#pragma unroll
        for (int ai = 0; ai < 2; ++ai)
#pragma unroll
            for (int m = 0; m < 4; ++m) { bf16_t* rowp = H + (size_t)(row0 + ai * HALF + m * 16) * ldh + col0;
                float h[8];
#pragma unroll
                for (int n = 0; n < 2; ++n)
#pragma unroll
                    for (int j = 0; j < 4; ++j) { const float a = acc[ai][0][m][n][j], b = acc[ai][1][m][n][j]; h[n * 4 + j] = a * sigm(a) * b; }
                u32x4 w; w.x = cvt_pk_bf16(h[0], h[1]); w.y = cvt_pk_bf16(h[2], h[3]); w.z = cvt_pk_bf16(h[4], h[5]); w.w = cvt_pk_bf16(h[6], h[7]);
                *(u32x4*)rowp = w; }
    }
};
struct EpiResF32 {
    static constexpr bool PERM = false, AFTER_DRAIN = false;
    float* X; const float* R; int ldc; float alpha;
    __device__ __forceinline__ void operator()(const f32x4 (&acc)[2][2][4][2], const Unit& u, int wr, int wc, int fr, int fq) const {
        const int row0 = u.pm * BM + wr * 64 + fr, col0 = u.pn * BM + wc * 32 + 4 * fq;
#pragma unroll
        for (int ai = 0; ai < 2; ++ai)
#pragma unroll
            for (int m = 0; m < 4; ++m) { const size_t ro = (size_t)(row0 + ai * HALF + m * 16) * ldc + col0;
#pragma unroll
                for (int bj = 0; bj < 2; ++bj)
#pragma unroll
                    for (int n = 0; n < 2; ++n) { asm volatile("" ::: "memory"); const f32x4 r = *(const f32x4*)(R + ro + bj * HALF + n * 16); *(f32x4*)(X + ro + bj * HALF + n * 16) = r * alpha + acc[ai][bj][m][n]; } }
    }
};
struct EpiDownRes {
    static constexpr bool PERM = false, AFTER_DRAIN = false;
    float* X; const bf16_t* PEb; int ldc; float alpha;
    __device__ __forceinline__ void operator()(const f32x4 (&acc)[2][2][4][2], const Unit& u, int wr, int wc, int fr, int fq) const {
        const int row0 = u.pm * BM + wr * 64 + fr, col0 = u.pn * BM + wc * 32 + 4 * fq;
#pragma unroll
        for (int ai = 0; ai < 2; ++ai)
#pragma unroll
            for (int m = 0; m < 4; ++m) { const size_t ro = (size_t)(row0 + ai * HALF + m * 16) * ldc + col0;
#pragma unroll
                for (int bj = 0; bj < 2; ++bj)
#pragma unroll
                    for (int n = 0; n < 2; ++n) { asm volatile("" ::: "memory"); const size_t o = ro + bj * HALF + n * 16; const f32x4 r = *(const f32x4*)(X + o); const u32x2 pw = *(const u32x2*)(PEb + o);
                        f32x4 pe; pe[0] = bflo(pw.x); pe[1] = bfhi(pw.x); pe[2] = bflo(pw.y); pe[3] = bfhi(pw.y);
                        *(f32x4*)(X + o) = r * alpha + acc[ai][bj][m][n] + pe; } }
    }
};
struct EpiGate {
    static constexpr bool PERM = true, AFTER_DRAIN = false;
    bf16_t* O; int ldc; const float* bias;
    __device__ __forceinline__ void operator()(const f32x4 (&acc)[2][2][4][2], const Unit& u, int wr, int wc, int fr, int fq) const {
        const int row0 = u.pm * BM + wr * 64 + fr, col0 = u.pn * BM + wc * 32 + 8 * fq;
        f32x4 bv[2][2];
#pragma unroll
        for (int bj = 0; bj < 2; ++bj)
#pragma unroll
            for (int n = 0; n < 2; ++n) bv[bj][n] = *(const f32x4*)(bias + col0 + bj * HALF + 4 * n);
#pragma unroll
        for (int ai = 0; ai < 2; ++ai)
#pragma unroll
            for (int m = 0; m < 4; ++m) { bf16_t* rowp = O + (size_t)(row0 + ai * HALF + m * 16) * ldc + col0;
#pragma unroll
                for (int bj = 0; bj < 2; ++bj) { f32x4 v0 = acc[ai][bj][m][0] + bv[bj][0], v1 = acc[ai][bj][m][1] + bv[bj][1];
#pragma unroll
                    for (int j = 0; j < 4; ++j) { v0[j] = sigm(v0[j]); v1[j] = sigm(v1[j]); }
                    u32x4 w; w.x = cvt_pk_bf16(v0[0], v0[1]); w.y = cvt_pk_bf16(v0[2], v0[3]); w.z = cvt_pk_bf16(v1[0], v1[1]); w.w = cvt_pk_bf16(v1[2], v1[3]);
                    *(u32x4*)(rowp + bj * HALF) = w; } }
    }
};
struct EpiPeMul {
    static constexpr bool PERM = true, AFTER_DRAIN = false;
    bf16_t* O; int ldc;
    __device__ __forceinline__ void operator()(const f32x4 (&acc)[2][2][4][2], const Unit& u, int wr, int wc, int fr, int fq) const {
        const int row0 = u.pm * BM + wr * 64 + fr, col0 = u.pn * BM + wc * 32 + 8 * fq;
#pragma unroll
        for (int ai = 0; ai < 2; ++ai)
#pragma unroll
            for (int m = 0; m < 4; ++m) { bf16_t* rowp = O + (size_t)(row0 + ai * HALF + m * 16) * ldc + col0;
#pragma unroll
                for (int bj = 0; bj < 2; ++bj) { asm volatile("" ::: "memory"); const f32x4 v0 = acc[ai][bj][m][0], v1 = acc[ai][bj][m][1]; const u32x4 g = *(const u32x4*)(rowp + bj * HALF);
                    u32x4 w; w.x = cvt_pk_bf16(v0[0] * bflo(g.x), v0[1] * bfhi(g.x)); w.y = cvt_pk_bf16(v0[2] * bflo(g.y), v0[3] * bfhi(g.y));
                    w.z = cvt_pk_bf16(v1[0] * bflo(g.z), v1[1] * bfhi(g.z)); w.w = cvt_pk_bf16(v1[2] * bflo(g.w), v1[3] * bfhi(g.w));
                    *(u32x4*)(rowp + bj * HALF) = w; } }
    }
};

template <class Epi, class Sched, bool STAMP = false>
__device__ __forceinline__ void gemm_phase(PG8_LAS unsigned char* lds, const Gemm g, const Sched& S, const Epi& E, unsigned long long* stamps) {
    int tid_ = threadIdx.x; asm volatile("" : "+v"(tid_));
    const int tid = tid_, wid = __builtin_amdgcn_readfirstlane(tid >> 6), lane = tid & 63, wr = wid >> 2, wc = wid & 3, fr = lane & 15, fq = lane >> 4;
    const int K = g.K, nt = K / BK;
    int ts_lo = 0, ts_hi = 0, nts = 0; const unsigned long long rt_entry = STAMP ? (unsigned long long)wall_clock64() : 0ull;
#define PG8_STAMP() do { if (STAMP && wid == 0 && nts < 64) { const unsigned long long _c = (unsigned long long)clock64(); \
        ts_lo = (lane == nts) ? (int)(unsigned)_c : ts_lo; ts_hi = (lane == nts) ? (int)(unsigned)(_c >> 32) : ts_hi; ++nts; } } while (0)
    PG8_STAMP();
    unsigned voffA[2], voffB[2];
#pragma unroll
    for (int i = 0; i < 2; ++i) { int R, C; stage_rc(tid * 16 + i * 8192, R, C); const int Rb = Epi::PERM ? ((R & ~31) + perm32(R & 31)) : R;
        voffA[i] = (unsigned)(R * K + C) * 2u; voffB[i] = (unsigned)(Rb * K + C) * 2u; }
    const size_t kstep = (size_t)(BK * 2);
    const size_t hstep = (size_t)HALF * K * 2;
    const size_t tstep = 2 * hstep;
    const unsigned ldsw = (unsigned)wid * 1024u;
    const int aoff = lds_byte(wr * 64 + fr, fq * 8), boff = lds_byte(wc * 32 + fr, fq * 8);
#define PG8_SA(b, h) (((b) * 2 + (h)) * HTB)
#define PG8_SB(b, h) ((4 + (b) * 2 + (h)) * HTB)
#define PG8_STAGE(bufoff, gbase, voff) do { _Pragma("unroll") for (int _i = 0; _i < 2; ++_i) \
        __builtin_amdgcn_global_load_lds((const unsigned*)((const char*)(gbase) + (voff)[_i]), (PG8_LAS unsigned*)(lds + (bufoff) + ldsw + _i * 8192), 16, 0, 0); } while (0)
#define PG8_LDA(dst, b, h) do { _Pragma("unroll") for (int m = 0; m < 4; ++m) _Pragma("unroll") for (int k = 0; k < 2; ++k) dst[m][k] = *(const PG8_LAS bf16x8*)(lds + PG8_SA(b, h) + aoff + m * 2048 + k * 1024); } while (0)
#define PG8_LDB(dst, b, h) do { _Pragma("unroll") for (int n = 0; n < 2; ++n) _Pragma("unroll") for (int k = 0; k < 2; ++k) dst[n][k] = *(const PG8_LAS bf16x8*)(lds + PG8_SB(b, h) + boff + n * 2048 + k * 1024); } while (0)
#define PG8_MMA(ai, bj, At, Bt) do { __builtin_amdgcn_s_setprio(1); _Pragma("unroll") for (int m = 0; m < 4; ++m) _Pragma("unroll") for (int n = 0; n < 2; ++n) _Pragma("unroll") for (int k = 0; k < 2; ++k) \
        acc[ai][bj][m][n] = __builtin_amdgcn_mfma_f32_16x16x32_bf16(Bt[n][k], At[m][k], acc[ai][bj][m][n], 0, 0, 0); __builtin_amdgcn_s_setprio(0); } while (0)
#define PG8_WAIT_V(n) asm volatile("s_waitcnt vmcnt(" #n ")" ::: "memory")
#define PG8_WAIT_L(n) asm volatile("s_waitcnt lgkmcnt(" #n ")" ::: "memory")
#define PG8_BAR __builtin_amdgcn_s_barrier()
#define PG8_SCHED __builtin_amdgcn_sched_barrier(0)
    Unit cur, nxt; int ui = 0;
    if (!S.next(0, cur)) return;
    f32x4 acc[2][2][4][2];
#pragma unroll
    for (int a = 0; a < 2; ++a)
#pragma unroll
        for (int b = 0; b < 2; ++b)
#pragma unroll
            for (int m = 0; m < 4; ++m)
#pragma unroll
                for (int n = 0; n < 2; ++n) acc[a][b][m][n] = (f32x4){0.f, 0.f, 0.f, 0.f};
    bf16x8 At[4][2], B0[2][2], B1[2][2];
    const char* cA = (const char*)g.A + (size_t)cur.pm * tstep; const char* cB = (const char*)g.Bt + cur.boff + (size_t)cur.pn * tstep;
    S.a_ready(cur);
    PG8_STAGE(PG8_SB(0, 0), cB, voffB); PG8_STAGE(PG8_SA(0, 0), cA, voffA); PG8_STAGE(PG8_SB(0, 1), cB + hstep, voffB); PG8_STAGE(PG8_SA(0, 1), cA + hstep, voffA);
    if (wr == 1) PG8_BAR;
    PG8_WAIT_V(4); PG8_BAR;
    PG8_STAGE(PG8_SB(1, 0), cB + kstep, voffB); PG8_STAGE(PG8_SA(1, 0), cA + kstep, voffA); PG8_STAGE(PG8_SB(1, 1), cB + hstep + kstep, voffB);
    PG8_WAIT_V(6); PG8_BAR;
    PG8_STAMP();
    for (;;) {
        const bool has_next = S.next(ui + 1, nxt);
        const char* nA = has_next ? (const char*)g.A + (size_t)nxt.pm * tstep : cA; const char* nB = has_next ? (const char*)g.Bt + nxt.boff + (size_t)nxt.pn * tstep : cB;
#pragma nounroll
        for (int t = 0; t < nt; t += 2) {
            const bool last = (t == nt - 2);
            const char* a1 = cA + (size_t)(t + 1) * kstep;
            const char* a2 = last ? nA : cA + (size_t)(t + 2) * kstep; const char* b2 = last ? nB : cB + (size_t)(t + 2) * kstep;
            const char* a3 = a2 + kstep; const char* b3 = b2 + kstep;
            if (last && has_next) S.a_ready(nxt);
            PG8_LDB(B0, 0, 0); PG8_SCHED; PG8_LDA(At, 0, 0); PG8_STAGE(PG8_SA(1, 1), a1 + hstep, voffA);
            PG8_WAIT_L(8); PG8_BAR; PG8_WAIT_L(0); PG8_MMA(0, 0, At, B0); PG8_BAR; PG8_SCHED;
            PG8_LDB(B1, 0, 1); PG8_STAGE(PG8_SB(0, 0), b2, voffB);
            PG8_BAR; PG8_WAIT_L(0); PG8_MMA(0, 1, At, B1); PG8_BAR;
            PG8_LDA(At, 0, 1); PG8_STAGE(PG8_SA(0, 0), a2, voffA);
            PG8_BAR; PG8_WAIT_L(0); PG8_MMA(1, 0, At, B0); PG8_BAR; PG8_SCHED;
            PG8_STAGE(PG8_SB(0, 1), b2 + hstep, voffB);
            PG8_WAIT_V(6); PG8_BAR; PG8_MMA(1, 1, At, B1); PG8_BAR;
            PG8_LDB(B0, 1, 0); PG8_SCHED; PG8_LDA(At, 1, 0); PG8_STAGE(PG8_SA(0, 1), a2 + hstep, voffA);
            PG8_WAIT_L(8); PG8_BAR; PG8_WAIT_L(0); PG8_MMA(0, 0, At, B0); PG8_BAR; PG8_SCHED;
            PG8_LDB(B1, 1, 1); PG8_STAGE(PG8_SB(1, 0), b3, voffB);
            PG8_BAR; PG8_WAIT_L(0); PG8_MMA(0, 1, At, B1); PG8_BAR;
            PG8_LDA(At, 1, 1); PG8_STAGE(PG8_SA(1, 0), a3, voffA);
            PG8_BAR; PG8_WAIT_L(0); PG8_MMA(1, 0, At, B0); PG8_BAR; PG8_SCHED;
            PG8_STAGE(PG8_SB(1, 1), b3 + hstep, voffB);
            PG8_WAIT_V(6); PG8_BAR; PG8_MMA(1, 1, At, B1); PG8_BAR;
        }
        PG8_STAMP();
        if constexpr (!Epi::AFTER_DRAIN) { E(acc, cur, wr, wc, fr, fq); S.done(cur); }
        PG8_STAMP();
        if (!has_next) break;
#pragma unroll
        for (int a = 0; a < 2; ++a)
#pragma unroll
            for (int b = 0; b < 2; ++b)
#pragma unroll
                for (int m = 0; m < 4; ++m)
#pragma unroll
                    for (int n = 0; n < 2; ++n) acc[a][b][m][n] = (f32x4){0.f, 0.f, 0.f, 0.f};
        cur = nxt; cA = nA; cB = nB; ++ui;
    }
    PG8_WAIT_V(0);
    if (wr == 0) PG8_BAR;
    PG8_BAR;
    if constexpr (Epi::AFTER_DRAIN) { E.fused(acc, cur, wr, wc, fr, fq, lds, wid, lane); S.done(cur); }
    PG8_STAMP();
    if (STAMP && wid == 0) { stamps[lane] = lane < nts ? (((unsigned long long)(unsigned)ts_hi << 32) | (unsigned)ts_lo) : 0ull;
        if (lane == 62) stamps[62] = rt_entry; if (lane == 63) stamps[63] = (unsigned long long)wall_clock64(); }
#undef PG8_STAMP
#undef PG8_SA
#undef PG8_SB
#undef PG8_STAGE
#undef PG8_LDA
#undef PG8_LDB
#undef PG8_MMA
#undef PG8_WAIT_V
#undef PG8_WAIT_L
#undef PG8_BAR
#undef PG8_SCHED
}
}
struct Ctx {
    LAS unsigned char* lds;
    int tid, lane, wave, G, bid;
};

DI void cvt_weight(const Ctx& c, const float* __restrict__ src, bf16_t* __restrict__ dst, int K, int N, int mode, int nb, size_t sstride, size_t dstride, int& rot) {
    LAS float* tile = (LAS float*)c.lds;
    const int ntk = K >> 6, ntn = (N + 63) >> 6, per = ntk * ntn, total = per * nb;
    int first = c.bid - rot; if (first < 0) first += c.G;
    for (int t = first; t < total; t += c.G) {
        const int b = t / per, r = t - b * per, tk = r / ntn, tn = r - tk * ntn, k0 = tk << 6, n0 = tn << 6;
        const float* s = src + (size_t)b * sstride; bf16_t* d = dst + (size_t)b * dstride;
#pragma unroll
        for (int i = 0; i < 8; ++i) { const int row = i * 8 + (c.tid >> 6), col = c.tid & 63, n = n0 + col;
            tile[row * 65 + col] = (n < N) ? s[(size_t)(k0 + row) * N + n] : 0.f; }
        __syncthreads();
        { const int n = c.tid >> 3, kk = (c.tid & 7) * 8, ng = n0 + n;
          int drow = ng; if (mode == 1) drow = (ng >> 7) * 256 + (ng & 127); else if (mode == 2) drow = (ng >> 7) * 256 + 128 + (ng & 127);
          u32x4 w; w.x = pack_bf16(tile[(kk + 0) * 65 + n], tile[(kk + 1) * 65 + n]); w.y = pack_bf16(tile[(kk + 2) * 65 + n], tile[(kk + 3) * 65 + n]);
          w.z = pack_bf16(tile[(kk + 4) * 65 + n], tile[(kk + 5) * 65 + n]); w.w = pack_bf16(tile[(kk + 6) * 65 + n], tile[(kk + 7) * 65 + n]);
          *(u32x4*)(d + (size_t)drow * K + k0 + kk) = w; }
        __syncthreads();
    }
    rot = (rot + total) % c.G;
}
DI void cvt_act(const Ctx& c, const float* __restrict__ src, bf16_t* __restrict__ dst, size_t n) {
    const size_t nv = n >> 3;
    for (size_t i = (size_t)c.bid * 512 + c.tid; i < nv; i += (size_t)c.G * 512) {
        const f32x4 a = *(const f32x4*)(src + i * 8), b = *(const f32x4*)(src + i * 8 + 4);
        u32x4 w; w.x = pack_bf16(a[0], a[1]); w.y = pack_bf16(a[2], a[3]); w.z = pack_bf16(b[0], b[1]); w.w = pack_bf16(b[2], b[3]);
        *(u32x4*)(dst + i * 8) = w;
    }
}

struct Route { int e0, e1; float g0, g1; int s0, s1; int pad0, pad1; };
template <bool COMBINE, bool ROUTE>
DI void ln_phase(const Ctx& c, float* __restrict__ X, bf16_t* __restrict__ XB, const float* __restrict__ gam, const float* __restrict__ bet,
                 const bf16_t* __restrict__ YB, const bf16_t* __restrict__ PEb, Route* __restrict__ route, const float* __restrict__ wr, unsigned* __restrict__ counts) {
    LAS float* wrs = (LAS float*)c.lds;
    LAS unsigned* lcnt = (LAS unsigned*)(c.lds + 32768);
    if (ROUTE) {
        for (int i = c.tid; i < 1024 * 8; i += 512) wrs[i] = wr[i];
        if (c.tid < NE) lcnt[c.tid] = 0u;
        __syncthreads();
    }
    f32x4 gv[4], bv[4];
#pragma unroll
    for (int i = 0; i < 4; ++i) { gv[i] = *(const f32x4*)(gam + i * 256 + c.lane * 4); bv[i] = *(const f32x4*)(bet + i * 256 + c.lane * 4); }
    for (int row = c.bid * 8 + c.wave; row < T; row += c.G * 8) {
        float* xr = X + (size_t)row * D;
        f32x4 v[4];
#pragma unroll
        for (int i = 0; i < 4; ++i) v[i] = *(const f32x4*)(xr + i * 256 + c.lane * 4);
        if (COMBINE) {
            const Route rt = route[row];
            const bf16_t* y0 = YB + (size_t)rt.s0 * D; const bf16_t* y1 = YB + (size_t)rt.s1 * D; const bf16_t* pe = PEb + (size_t)row * D;
#pragma unroll
            for (int i = 0; i < 4; ++i) { const int o = i * 256 + c.lane * 4;
                const u32x2 a = *(const u32x2*)(y0 + o), b = *(const u32x2*)(y1 + o), p = *(const u32x2*)(pe + o);
                v[i][0] = ALPHA * v[i][0] + rt.g0 * pg8::bflo(a.x) + rt.g1 * pg8::bflo(b.x) + pg8::bflo(p.x);
                v[i][1] = ALPHA * v[i][1] + rt.g0 * pg8::bfhi(a.x) + rt.g1 * pg8::bfhi(b.x) + pg8::bfhi(p.x);
                v[i][2] = ALPHA * v[i][2] + rt.g0 * pg8::bflo(a.y) + rt.g1 * pg8::bflo(b.y) + pg8::bflo(p.y);
                v[i][3] = ALPHA * v[i][3] + rt.g0 * pg8::bfhi(a.y) + rt.g1 * pg8::bfhi(b.y) + pg8::bfhi(p.y); }
        }
        float s = 0.f;
#pragma unroll
        for (int i = 0; i < 4; ++i) s += (v[i][0] + v[i][1]) + (v[i][2] + v[i][3]);
        const float mean = wave_sum(s) * (1.0f / D);
        float q = 0.f;
#pragma unroll
        for (int i = 0; i < 4; ++i) { v[i] = v[i] - mean; q += (v[i][0] * v[i][0] + v[i][1] * v[i][1]) + (v[i][2] * v[i][2] + v[i][3] * v[i][3]); }
        const float rstd = rsqrtf(wave_sum(q) * (1.0f / D) + 1e-5f);
#pragma unroll
        for (int i = 0; i < 4; ++i) { v[i] = v[i] * rstd * gv[i] + bv[i];
            *(f32x4*)(xr + i * 256 + c.lane * 4) = v[i];
            u32x2 w; w.x = pack_bf16(v[i][0], v[i][1]); w.y = pack_bf16(v[i][2], v[i][3]);
            *(u32x2*)(XB + (size_t)row * D + i * 256 + c.lane * 4) = w; }
        if (ROUTE) {
            float lg[NE];
#pragma unroll
            for (int e = 0; e < NE; ++e) lg[e] = 0.f;
#pragma unroll
            for (int i = 0; i < 4; ++i)
#pragma unroll
                for (int j = 0; j < 4; ++j) { const int d = i * 256 + c.lane * 4 + j; const f32x4 w0 = *(const LAS f32x4*)(wrs + d * 8), w1 = *(const LAS f32x4*)(wrs + d * 8 + 4);
                    lg[0] += v[i][j] * w0[0]; lg[1] += v[i][j] * w0[1]; lg[2] += v[i][j] * w0[2]; lg[3] += v[i][j] * w0[3];
                    lg[4] += v[i][j] * w1[0]; lg[5] += v[i][j] * w1[1]; lg[6] += v[i][j] * w1[2]; lg[7] += v[i][j] * w1[3]; }
#pragma unroll
            for (int e = 0; e < NE; ++e) lg[e] = wave_sum(lg[e]);
            int e0 = 0; float l0 = lg[0];
#pragma unroll
            for (int e = 1; e < NE; ++e) if (lg[e] > l0) { l0 = lg[e]; e0 = e; }
            int e1 = -1; float l1 = -3.0e38f;
#pragma unroll
            for (int e = 0; e < NE; ++e) if (e != e0 && lg[e] > l1) { l1 = lg[e]; e1 = e; }
            if (c.lane == 0) {
                const float g0 = 1.0f / (1.0f + __expf(l1 - l0));
                u32x4 rw; rw.x = (unsigned)e0; rw.y = (unsigned)e1; rw.z = __float_as_uint(g0); rw.w = __float_as_uint(1.0f - g0);
                *(u32x4*)&route[row] = rw;
                atomicAdd((unsigned*)&lcnt[e0], 1u); atomicAdd((unsigned*)&lcnt[e1], 1u);
            }
        }
    }
    if (ROUTE) {
        __syncthreads();
        if (c.tid < NE) atomicAdd(&counts[c.tid], lcnt[c.tid]);
    }
}

DI void moe_assign_gather(const Ctx& c, Route* __restrict__ route, const unsigned* __restrict__ counts, unsigned* __restrict__ cursor, const bf16_t* __restrict__ XB, bf16_t* __restrict__ XG) {
    LAS unsigned* lcnt = (LAS unsigned*)c.lds;
    LAS unsigned* lbase = lcnt + 8;
    LAS int* lslot = (LAS int*)(lcnt + 16);
    unsigned pstart[NE]; { unsigned acc = 0;
#pragma unroll
        for (int e = 0; e < NE; ++e) { pstart[e] = acc; acc += ((counts[e] + 255u) >> 8) << 8; } }
    for (int chunk = c.bid; chunk < T / 128; chunk += c.G) {
        if (c.tid < NE) lcnt[c.tid] = 0u;
        __syncthreads();
        const int tok = chunk * 128 + c.tid; int e0 = 0, e1 = 0; unsigned r0 = 0, r1 = 0;
        if (c.tid < 128) { e0 = route[tok].e0; e1 = route[tok].e1; r0 = atomicAdd((unsigned*)&lcnt[e0], 1u); r1 = atomicAdd((unsigned*)&lcnt[e1], 1u); }
        __syncthreads();
        if (c.tid < NE) lbase[c.tid] = atomicAdd(&cursor[c.tid], lcnt[c.tid]);
        __syncthreads();
        if (c.tid < 128) {
            unsigned p0 = 0, p1 = 0;
#pragma unroll
            for (int e = 0; e < NE; ++e) { if (e == e0) p0 = pstart[e]; if (e == e1) p1 = pstart[e]; }
            const int s0 = (int)(p0 + lbase[e0] + r0), s1 = (int)(p1 + lbase[e1] + r1);
            route[tok].s0 = s0; route[tok].s1 = s1; lslot[c.tid * 2] = s0; lslot[c.tid * 2 + 1] = s1;
        }
        __syncthreads();
        for (int pr = c.tid >> 7; pr < 256; pr += 4) {
            const int tk = chunk * 128 + (pr >> 1); const int slot = lslot[pr]; const int o = (c.tid & 127) * 8;
            *(u32x4*)(XG + (size_t)slot * D + o) = *(const u32x4*)(XB + (size_t)tk * D + o);
        }
        __syncthreads();
    }
}
struct MixP {
    const bf16_t* proj; bf16_t* mix; int layer;
    const float *m_i_bias, *m_f_bias, *m_norm_w;
    const float *g_conv_w, *g_conv_b, *g_w_a, *g_b_a, *g_w_x, *g_b_x, *g_lambda;
    const float *r_mu, *r_w0, *r_w2, *r_a0, *r_a2, *r_g2, *r_k_k, *r_k_a, *r_r_k, *r_ln_w, *r_ln_b;
    const float *s_conv_w, *s_conv_b, *s_dt_bias, *s_a_log, *s_d, *s_norm_w;
};
constexpr int TC = 32;
DI float ldp(const bf16_t* proj, int t, int col) { return bf2f(proj[(size_t)t * NINP + col]); }

DI void mix_mlstm_naive(const Ctx& c, const MixP& P, int b, int h) {
    LAS float* Qs = (LAS float*)c.lds; LAS float* Ks = Qs + TC * 64; LAS float* Vs = Ks + TC * 64; LAS float* Og = Vs + TC * 64; LAS float* Hb = Og + TC * 64;
    LAS float* Li = Hb + TC * 64; LAS float* Lf = Li + TC;
    const int L = P.layer; const float ib = P.m_i_bias[L * 4 + h], fb = P.m_f_bias[L * 4 + h];
    const int tt = c.tid >> 4, part = c.tid & 15;
    float Cst[64]; float nst = 0.f, m = 0.f;
#pragma unroll
    for (int j = 0; j < 64; ++j) Cst[j] = 0.f;
    for (int s0 = 0; s0 < SEQ; s0 += TC) {
        const int t = b * SEQ + s0 + tt;
#pragma unroll
        for (int jj = 0; jj < 4; ++jj) { const int j = part * 4 + jj, hj = h * 64 + j;
            Qs[tt * 64 + j] = ldp(P.proj, t, OFF_M + hj); Ks[tt * 64 + j] = ldp(P.proj, t, OFF_M + 256 + hj) * 0.125f;
            Vs[tt * 64 + j] = ldp(P.proj, t, OFF_M + 512 + hj); Og[tt * 64 + j] = sigmoidf_(ldp(P.proj, t, OFF_M + 768 + hj)); }
        if (part == 0) { Li[tt] = ldp(P.proj, t, OFF_M + 1024 + h) + ib; Lf[tt] = -softplusf_(-(ldp(P.proj, t, OFF_M + 1028 + h) + fb)); }
        __syncthreads();
        if (c.wave == 0) {
            for (int x = 0; x < TC; ++x) {
                const float li = Li[x], lf = Lf[x];
                const float mn = fmaxf(lf + m, li), fs = __expf(lf + m - mn), is = __expf(li - mn);
                const float vi = is * Vs[x * 64 + c.lane];
                nst = fs * nst + is * Ks[x * 64 + c.lane];
                float num = 0.f;
#pragma unroll
                for (int j4 = 0; j4 < 16; ++j4) { asm volatile("" ::: "memory"); const f32x4 kv = *(const LAS f32x4*)(Ks + x * 64 + j4 * 4), qv = *(const LAS f32x4*)(Qs + x * 64 + j4 * 4);
#pragma unroll
                    for (int e = 0; e < 4; ++e) { Cst[j4 * 4 + e] = fs * Cst[j4 * 4 + e] + vi * kv[e]; num += Cst[j4 * 4 + e] * qv[e]; } }
                const float dn = wave_sum(nst * Qs[x * 64 + c.lane]);
                const float den = fmaxf(fabsf(dn), __expf(-mn));
                Hb[x * 64 + c.lane] = num / den; m = mn;
            }
        }
        __syncthreads();
        { float hv[4], ss = 0.f;
#pragma unroll
          for (int jj = 0; jj < 4; ++jj) { hv[jj] = Hb[tt * 64 + part * 4 + jj]; ss += hv[jj] * hv[jj]; }
          ss = grp16_sum(ss); const float rs = rsqrtf(ss * (1.0f / 64.0f) + 1e-6f);
          float o[4];
#pragma unroll
          for (int jj = 0; jj < 4; ++jj) { const int j = part * 4 + jj, hj = h * 64 + j; o[jj] = hv[jj] * rs * P.m_norm_w[L * 256 + hj] * Og[tt * 64 + j]; }
          u32x2 w; w.x = pack_bf16(o[0], o[1]); w.y = pack_bf16(o[2], o[3]);
          *(u32x2*)(P.mix + (size_t)t * D + 0 + h * 64 + part * 4) = w; }
        __syncthreads();
    }
}

DI void mix_rglru_naive(const Ctx& c, const MixP& P, int b, int h) {
    LAS float* Was = (LAS float*)c.lds; LAS float* Wxs = Was + 4096; LAS float* XC = Wxs + 4096; LAS float* Av = XC + TC * 64; LAS float* Uv = Av + TC * 64;
    LAS float* Gt = Uv + TC * 64; LAS float* Hb = Gt + TC * 64;
    const int L = P.layer; const int tt = c.tid >> 4, part = c.tid & 15;
    for (int i = c.tid; i < 4096; i += 512) { Was[i] = P.g_w_a[(size_t)(L * 4 + h) * 4096 + i]; Wxs[i] = P.g_w_x[(size_t)(L * 4 + h) * 4096 + i]; }
    float hst = 0.f;
    __syncthreads();
    for (int s0 = 0; s0 < SEQ; s0 += TC) {
        const int s = s0 + tt, t = b * SEQ + s;
#pragma unroll
        for (int jj = 0; jj < 4; ++jj) { const int j = part * 4 + jj, hj = h * 64 + j;
            float acc = P.g_conv_b[L * 256 + hj];
#pragma unroll
            for (int k = 0; k < 4; ++k) { const int sp = s - 3 + k; if (sp >= 0) acc += P.g_conv_w[(L * 4 + k) * 256 + hj] * ldp(P.proj, t - 3 + k, OFF_G + hj); }
            XC[tt * 64 + j] = acc; Gt[tt * 64 + j] = gelu_tanhf_(ldp(P.proj, t, OFF_G + 256 + hj)); }
        __syncthreads();
        { float ra[4], rx[4];
#pragma unroll
          for (int jj = 0; jj < 4; ++jj) { const int hj = h * 64 + part * 4 + jj; ra[jj] = P.g_b_a[L * 256 + hj]; rx[jj] = P.g_b_x[L * 256 + hj]; }
          for (int i = 0; i < 64; ++i) { const float xv = XC[tt * 64 + i]; const f32x4 wa = *(const LAS f32x4*)(Was + i * 64 + part * 4), wx = *(const LAS f32x4*)(Wxs + i * 64 + part * 4);
#pragma unroll
              for (int jj = 0; jj < 4; ++jj) { ra[jj] += xv * wa[jj]; rx[jj] += xv * wx[jj]; } }
#pragma unroll
          for (int jj = 0; jj < 4; ++jj) { const int j = part * 4 + jj, hj = h * 64 + j;
              const float r = sigmoidf_(ra[jj]), ig = sigmoidf_(rx[jj]); const float la = -8.0f * softplusf_(-P.g_lambda[L * 256 + hj]) * r;
              Av[tt * 64 + j] = __expf(la); Uv[tt * 64 + j] = sqrtf(-expm1f(2.0f * la)) * (ig * XC[tt * 64 + j]); } }
        __syncthreads();
        if (c.wave == 0) { for (int x = 0; x < TC; ++x) { hst = Av[x * 64 + c.lane] * hst + Uv[x * 64 + c.lane]; Hb[x * 64 + c.lane] = hst; } }
        __syncthreads();
        { float o[4];
#pragma unroll
          for (int jj = 0; jj < 4; ++jj) { const int j = part * 4 + jj; o[jj] = Hb[tt * 64 + j] * Gt[tt * 64 + j]; }
          u32x2 w; w.x = pack_bf16(o[0], o[1]); w.y = pack_bf16(o[2], o[3]);
          *(u32x2*)(P.mix + (size_t)t * D + 256 + h * 64 + part * 4) = w; }
        __syncthreads();
    }
}

DI float rshift(const MixP& P, int t, int s, int colrel) {
    const float cur = ldp(P.proj, t, OFF_R + colrel), prev = (s > 0) ? ldp(P.proj, t - 1, OFF_R + colrel) : 0.f;
    return cur + (prev - cur) * P.r_mu[P.layer * 896 + colrel];
}
DI void mix_rwkv_naive(const Ctx& c, const MixP& P, int b, int h) {
    LAS float* W2 = (LAS float*)c.lds; LAS float* A2 = W2 + 2048; LAS float* G2 = A2 + 2048; LAS float* Lo = G2 + 4096;
    LAS float* Rr = Lo + TC * 128; LAS float* Dd = Rr + TC * 64; LAS float* Kx = Dd + TC * 64; LAS float* Kk = Kx + TC * 64; LAS float* Kb = Kk + TC * 64;
    LAS float* Vv = Kb + TC * 64; LAS float* Gg = Vv + TC * 64; LAS float* Yb = Gg + TC * 64; LAS float* Bo = Yb + TC * 64;
    const int L = P.layer; const int tt = c.tid >> 4, part = c.tid & 15;
    for (int i = c.tid; i < 2048; i += 512) { const int r = i >> 6, j = i & 63; W2[i] = P.r_w2[(size_t)(L * 32 + r) * 256 + h * 64 + j]; A2[i] = P.r_a2[(size_t)(L * 32 + r) * 256 + h * 64 + j]; }
    for (int i = c.tid; i < 4096; i += 512) { const int r = i >> 6, j = i & 63; G2[i] = P.r_g2[(size_t)(L * 64 + r) * 256 + h * 64 + j]; }
    float St[64];
#pragma unroll
    for (int j = 0; j < 64; ++j) St[j] = 0.f;
    __syncthreads();
    for (int s0 = 0; s0 < SEQ; s0 += TC) {
        const int s = s0 + tt, t = b * SEQ + s;
#pragma unroll
        for (int jj = 0; jj < 8; ++jj) { const int idx = part * 8 + jj; const float xs = rshift(P, t, s, 768 + idx);
            Lo[tt * 128 + idx] = (idx < 32) ? tanhf(xs) : ((idx < 64) ? xs : sigmoidf_(xs)); }
        __syncthreads();
        { float wl[4], al[4], gg[4];
#pragma unroll
          for (int jj = 0; jj < 4; ++jj) { const int hj = h * 64 + part * 4 + jj; wl[jj] = P.r_w0[L * 256 + hj]; al[jj] = P.r_a0[L * 256 + hj]; gg[jj] = 0.f; }
          for (int i = 0; i < 32; ++i) { const float lw = Lo[tt * 128 + i], la = Lo[tt * 128 + 32 + i]; const f32x4 w2 = *(const LAS f32x4*)(W2 + i * 64 + part * 4), a2 = *(const LAS f32x4*)(A2 + i * 64 + part * 4);
#pragma unroll
              for (int jj = 0; jj < 4; ++jj) { wl[jj] += lw * w2[jj]; al[jj] += la * a2[jj]; } }
          for (int i = 0; i < 64; ++i) { const float lg = Lo[tt * 128 + 64 + i]; const f32x4 g2 = *(const LAS f32x4*)(G2 + i * 64 + part * 4);
#pragma unroll
              for (int jj = 0; jj < 4; ++jj) gg[jj] += lg * g2[jj]; }
          float rv[4], kv[4], vv[4], kkr[4], av[4], ss = 0.f;
#pragma unroll
          for (int jj = 0; jj < 4; ++jj) { const int hj = h * 64 + part * 4 + jj;
              rv[jj] = rshift(P, t, s, hj); kv[jj] = rshift(P, t, s, 256 + hj); vv[jj] = rshift(P, t, s, 512 + hj);
              kkr[jj] = kv[jj] * P.r_k_k[L * 256 + hj]; ss += kkr[jj] * kkr[jj]; av[jj] = sigmoidf_(al[jj]); }
          ss = grp16_sum(ss); const float inv = rsqrtf(fmaxf(ss, 1e-24f));
          float bsum = 0.f;
#pragma unroll
          for (int jj = 0; jj < 4; ++jj) { const int j = part * 4 + jj, hj = h * 64 + j;
              const float wlog = -softplusf_(-wl[jj]) - 0.5f; const float dec = __expf(-__expf(wlog));
              const float kk = kkr[jj] * inv; const float kx = kv[jj] * (1.0f + (av[jj] - 1.0f) * P.r_k_a[L * 256 + hj]);
              Rr[tt * 64 + j] = rv[jj]; Dd[tt * 64 + j] = dec; Kx[tt * 64 + j] = kx; Kk[tt * 64 + j] = kk; Kb[tt * 64 + j] = kk * av[jj]; Vv[tt * 64 + j] = vv[jj]; Gg[tt * 64 + j] = gg[jj];
              bsum += rv[jj] * kx * P.r_r_k[L * 256 + hj]; }
          bsum = grp16_sum(bsum); if (part == 0) Bo[tt] = bsum; }
        __syncthreads();
        if (c.wave == 0) {
            for (int x = 0; x < TC; ++x) {
                float sa = 0.f;
#pragma unroll
                for (int j4 = 0; j4 < 16; ++j4) { asm volatile("" ::: "memory"); const f32x4 k4 = *(const LAS f32x4*)(Kk + x * 64 + j4 * 4);
#pragma unroll
                    for (int e = 0; e < 4; ++e) sa += St[j4 * 4 + e] * k4[e]; }
                const float vr = Vv[x * 64 + c.lane]; float y = 0.f;
#pragma unroll
                for (int j4 = 0; j4 < 16; ++j4) { asm volatile("" ::: "memory"); const f32x4 d4 = *(const LAS f32x4*)(Dd + x * 64 + j4 * 4), kx4 = *(const LAS f32x4*)(Kx + x * 64 + j4 * 4), kb4 = *(const LAS f32x4*)(Kb + x * 64 + j4 * 4), r4 = *(const LAS f32x4*)(Rr + x * 64 + j4 * 4);
#pragma unroll
                    for (int e = 0; e < 4; ++e) { const float sn = St[j4 * 4 + e] * d4[e] + (vr * kx4[e] - sa * kb4[e]); St[j4 * 4 + e] = sn; y += sn * r4[e]; } }
                Yb[x * 64 + c.lane] = y;
            }
        }
        __syncthreads();
        { float yv[4], sm = 0.f;
#pragma unroll
          for (int jj = 0; jj < 4; ++jj) { yv[jj] = Yb[tt * 64 + part * 4 + jj]; sm += yv[jj]; }
          const float mean = grp16_sum(sm) * (1.0f / 64.0f); float q = 0.f;
#pragma unroll
          for (int jj = 0; jj < 4; ++jj) { yv[jj] -= mean; q += yv[jj] * yv[jj]; }
          const float rs = rsqrtf(grp16_sum(q) * (1.0f / 64.0f) + 64e-5f); const float bo = Bo[tt];
          float o[4];
#pragma unroll
          for (int jj = 0; jj < 4; ++jj) { const int j = part * 4 + jj, hj = h * 64 + j;
              const float yn = yv[jj] * rs * P.r_ln_w[L * 256 + hj] + P.r_ln_b[L * 256 + hj]; o[jj] = (yn + bo * Vv[tt * 64 + j]) * Gg[tt * 64 + j]; }
          u32x2 w; w.x = pack_bf16(o[0], o[1]); w.y = pack_bf16(o[2], o[3]);
          *(u32x2*)(P.mix + (size_t)t * D + 512 + h * 64 + part * 4) = w; }
        __syncthreads();
    }
}

DI void mix_ssd_naive(const Ctx& c, const MixP& P, int b, int g) {
    LAS float* Xs = (LAS float*)c.lds; LAS float* Bm = Xs + TC * 128; LAS float* Cm = Bm + TC * 64; LAS float* Zs = Cm + TC * 64; LAS float* Yb = Zs + TC * 128;
    LAS float* Dt = Yb + TC * 128; LAS float* Da = Dt + TC * 2;
    const int L = P.layer; const int tt = c.tid >> 4, part = c.tid & 15;
    float St[64];
#pragma unroll
    for (int j = 0; j < 64; ++j) St[j] = 0.f;
    const int hw = 2 * g + (c.wave & 1); const float dskip = P.s_d[L * 4 + hw];
    for (int s0 = 0; s0 < SEQ; s0 += TC) {
        const int s = s0 + tt, t = b * SEQ + s;
        for (int jj = 0; jj < 16; ++jj) { const int ch = part * 16 + jj;
            const int xi = (ch < 128) ? (g * 128 + ch) : ((ch < 192) ? (256 + g * 64 + (ch - 128)) : (384 + g * 64 + (ch - 192)));
            float acc = P.s_conv_b[L * 512 + xi];
#pragma unroll
            for (int k = 0; k < 4; ++k) { const int sp = s - 3 + k; if (sp >= 0) acc += P.s_conv_w[(L * 4 + k) * 512 + xi] * ldp(P.proj, t - 3 + k, OFF_S + 256 + xi); }
            acc = siluf_(acc);
            if (ch < 128) Xs[tt * 128 + ch] = acc; else if (ch < 192) Bm[tt * 64 + ch - 128] = acc; else Cm[tt * 64 + ch - 192] = acc; }
#pragma unroll
        for (int jj = 0; jj < 8; ++jj) { const int ch = part * 8 + jj; Zs[tt * 128 + ch] = siluf_(ldp(P.proj, t, OFF_S + g * 128 + ch)); }
        if (part < 2) { const int hh = 2 * g + part; const float dt = softplusf_(ldp(P.proj, t, OFF_S + 768 + hh) + P.s_dt_bias[L * 4 + hh]);
            Dt[tt * 2 + part] = dt; Da[tt * 2 + part] = __expf(-__expf(P.s_a_log[L * 4 + hh]) * dt); }
        __syncthreads();
        if (c.wave < 2) {
            const int w = c.wave;
            for (int x = 0; x < TC; ++x) {
                const float xv = Xs[x * 128 + w * 64 + c.lane], dt = Dt[x * 2 + w], da = Da[x * 2 + w]; const float xd = dt * xv; float y = 0.f;
#pragma unroll
                for (int j4 = 0; j4 < 16; ++j4) { asm volatile("" ::: "memory"); const f32x4 b4 = *(const LAS f32x4*)(Bm + x * 64 + j4 * 4), c4 = *(const LAS f32x4*)(Cm + x * 64 + j4 * 4);
#pragma unroll
                    for (int e = 0; e < 4; ++e) { const float sn = da * St[j4 * 4 + e] + xd * b4[e]; St[j4 * 4 + e] = sn; y += c4[e] * sn; } }
                Yb[x * 128 + w * 64 + c.lane] = y + dskip * xv;
            }
        }
        __syncthreads();
        { float yz[8], ss = 0.f;
#pragma unroll
          for (int jj = 0; jj < 8; ++jj) { const int ch = part * 8 + jj; yz[jj] = Yb[tt * 128 + ch] * Zs[tt * 128 + ch]; ss += yz[jj] * yz[jj]; }
          const float rs = rsqrtf(grp16_sum(ss) * (1.0f / 128.0f) + 1e-6f);
          float o[8];
#pragma unroll
          for (int jj = 0; jj < 8; ++jj) { const int ch = part * 8 + jj; o[jj] = yz[jj] * rs * P.s_norm_w[L * 256 + g * 128 + ch]; }
          u32x4 w; w.x = pack_bf16(o[0], o[1]); w.y = pack_bf16(o[2], o[3]); w.z = pack_bf16(o[4], o[5]); w.w = pack_bf16(o[6], o[7]);
          *(u32x4*)(P.mix + (size_t)t * D + 768 + g * 128 + part * 8) = w; }
        __syncthreads();
    }
}
constexpr size_t al256(size_t x) { return (x + 255) & ~(size_t)255; }
constexpr size_t WS_CTL = 0;
constexpr size_t CTL_BYTES = 65536;
constexpr int CW_BAR = 0;
constexpr int CW_CNT = 4096;
constexpr int CW_CUR = 4096 + 128;
constexpr size_t SZ_WIN = (size_t)NINP * D * 2, SZ_WOUT = (size_t)D * D * 2, SZ_WPE = (size_t)D * PE_DIM * 2, SZ_WG = (size_t)D * D * 2;
constexpr size_t SZ_W13 = (size_t)NH2 * D * 2, SZ_W2 = (size_t)D * DFF * 2;
constexpr size_t WS_WIN = WS_CTL + CTL_BYTES, WS_WOUT = WS_WIN + SZ_WIN, WS_WPE = WS_WOUT + SZ_WOUT, WS_WG = WS_WPE + SZ_WPE, WS_W13 = WS_WG + SZ_WG, WS_W2 = WS_W13 + NE * SZ_W13;
constexpr size_t WS_XB = WS_W2 + NE * SZ_W2;
constexpr size_t WS_PB = WS_XB + (size_t)T * D * 2;
constexpr size_t WS_PE = WS_PB + (size_t)T * PE_DIM * 2;
constexpr size_t WS_H = WS_PE + (size_t)T * D * 2;
constexpr size_t SZ_PROJ = (size_t)T * NINP * 2, SZ_HMOE = (size_t)MOE_ROWS * DFF * 2;
constexpr size_t WS_MIX = WS_H + SZ_PROJ;
constexpr size_t WS_XG = WS_H + SZ_HMOE;
constexpr size_t WS_ROUTE = WS_XG + (size_t)MOE_ROWS * D * 2;
constexpr size_t WS_END = WS_ROUTE + (size_t)T * 32;
static_assert(SZ_PROJ + (size_t)T * D * 2 <= SZ_HMOE, "proj + mix inside the hidden region");
constexpr int LDS_BYTES = 147456;
constexpr int LDS_MISC = 131072;

#ifndef PHMASK
#define PHMASK 0x1FF
#endif
#define PHEN(k) ((PHMASK >> (k)) & 1)

#ifndef PHMASK
#define PHMASK 0x1FF
#endif
#define PHEN(k) ((PHMASK >> (k)) & 1)
struct Args { const float* in[45]; float* out; unsigned char* ws; int ph_lo, ph_hi; };
constexpr int NPH = 9;
constexpr int LDS_ARGS = LDS_MISC + 64;
#define PHASE_FN static __device__ __forceinline__ void
typedef const volatile LAS Args* LArgs;
DI Ctx make_ctx() { Ctx c; c.lds = (LAS unsigned char*)0; int t = threadIdx.x; asm volatile("" : "+v"(t)); int g = gridDim.x, b = blockIdx.x; asm volatile("" : "+s"(g), "+s"(b));
    c.tid = t; c.lane = t & 63; c.wave = __builtin_amdgcn_readfirstlane(t >> 6); c.G = g; c.bid = b; return c; }
DI const float* inp(LArgs a, int i) { return (const float*)rfl64((unsigned long long)a->in[i]); }
DI unsigned char* wsp(LArgs a) { return (unsigned char*)rfl64((unsigned long long)a->ws); }
DI float* outp(LArgs a) { return (float*)rfl64((unsigned long long)a->out); }

PHASE_FN ph_cvt(int L) {
    const Ctx c = make_ctx(); LArgs a = (LArgs)(LDS_ARGS); unsigned char* ws = wsp(a);
    const bool moe = (L & 1) != 0; const int fi = L >> 1;
    bf16_t* WinT = (bf16_t*)(ws + WS_WIN); bf16_t* WoutT = (bf16_t*)(ws + WS_WOUT); bf16_t* WpeT = (bf16_t*)(ws + WS_WPE); bf16_t* WgT = (bf16_t*)(ws + WS_WG);
    bf16_t* W13T = (bf16_t*)(ws + WS_W13); bf16_t* W2T = (bf16_t*)(ws + WS_W2);
    int rot = 0;
    cvt_weight(c, inp(a, 2) + (size_t)L * D * NIN, WinT, D, NIN, 0, 1, 0, 0, rot);
    cvt_weight(c, inp(a, 30) + (size_t)L * D * D, WoutT, D, D, 0, 1, 0, 0, rot);
    cvt_weight(c, inp(a, 42) + (size_t)L * PE_DIM * D, WpeT, PE_DIM, D, 0, 1, 0, 0, rot);
    cvt_weight(c, inp(a, 43) + (size_t)L * D * D, WgT, D, D, 0, 1, 0, 0, rot);
    if (!moe) {
        cvt_weight(c, inp(a, 35) + (size_t)fi * D * DFF, W13T, D, DFF, 1, 1, 0, 0, rot);
        cvt_weight(c, inp(a, 36) + (size_t)fi * D * DFF, W13T, D, DFF, 2, 1, 0, 0, rot);
        cvt_weight(c, inp(a, 37) + (size_t)fi * DFF * D, W2T, DFF, D, 0, 1, 0, 0, rot);
    } else {
        cvt_weight(c, inp(a, 39) + (size_t)fi * NE * D * DFF, W13T, D, DFF, 1, NE, (size_t)D * DFF, (size_t)NH2 * D, rot);
        cvt_weight(c, inp(a, 40) + (size_t)fi * NE * D * DFF, W13T, D, DFF, 2, NE, (size_t)D * DFF, (size_t)NH2 * D, rot);
        cvt_weight(c, inp(a, 41) + (size_t)fi * NE * DFF * D, W2T, DFF, D, 0, NE, (size_t)DFF * D, (size_t)D * DFF, rot);
    }
    cvt_act(c, inp(a, 1) + (size_t)L * T * PE_DIM, (bf16_t*)(ws + WS_PB), (size_t)T * PE_DIM);
    if (L == 0) cvt_act(c, inp(a, 0), (bf16_t*)(ws + WS_XB), (size_t)T * D);
}
PHASE_FN ph_proj(int L) {
    const Ctx c = make_ctx(); LArgs a = (LArgs)(LDS_ARGS); unsigned char* ws = wsp(a);
    pg8::Gemm g{(bf16_t*)(ws + WS_XB), (bf16_t*)(ws + WS_WIN), T, NINP, D}; pg8::StaticOrder S; S.init(T, NINP, c.G, c.bid);
    pg8::EpiBf16 E{(bf16_t*)(ws + WS_H), NINP};
    pg8::gemm_phase<pg8::EpiBf16, pg8::StaticOrder, false>(c.lds, g, S, E, nullptr);
}
DI MixP make_mixp(LArgs a, int L) {
    unsigned char* ws = wsp(a);
    MixP P; P.proj = (bf16_t*)(ws + WS_H); P.mix = (bf16_t*)(ws + WS_MIX); P.layer = L;
    P.m_i_bias = inp(a, 3); P.m_f_bias = inp(a, 4); P.m_norm_w = inp(a, 5);
    P.g_conv_w = inp(a, 6); P.g_conv_b = inp(a, 7); P.g_w_a = inp(a, 8); P.g_b_a = inp(a, 9); P.g_w_x = inp(a, 10); P.g_b_x = inp(a, 11); P.g_lambda = inp(a, 12);
    P.r_mu = inp(a, 13); P.r_w0 = inp(a, 14); P.r_w2 = inp(a, 15); P.r_a0 = inp(a, 16); P.r_a2 = inp(a, 17); P.r_g2 = inp(a, 18); P.r_k_k = inp(a, 19); P.r_k_a = inp(a, 20);
    P.r_r_k = inp(a, 21); P.r_ln_w = inp(a, 22); P.r_ln_b = inp(a, 23);
    P.s_conv_w = inp(a, 24); P.s_conv_b = inp(a, 25); P.s_dt_bias = inp(a, 26); P.s_a_log = inp(a, 27); P.s_d = inp(a, 28); P.s_norm_w = inp(a, 29);
    return P;
}
PHASE_FN ph_mix_rwkv(int L, int b, int h) { const Ctx c = make_ctx(); const MixP P = make_mixp((LArgs)(LDS_ARGS), L); mix_rwkv_naive(c, P, b, h); }
PHASE_FN ph_mix_mlstm(int L, int b, int h) { const Ctx c = make_ctx(); const MixP P = make_mixp((LArgs)(LDS_ARGS), L); mix_mlstm_naive(c, P, b, h); }
PHASE_FN ph_mix_rglru(int L, int b, int h) { const Ctx c = make_ctx(); const MixP P = make_mixp((LArgs)(LDS_ARGS), L); mix_rglru_naive(c, P, b, h); }
PHASE_FN ph_mix_ssd(int L, int b, int g) { const Ctx c = make_ctx(); const MixP P = make_mixp((LArgs)(LDS_ARGS), L); mix_ssd_naive(c, P, b, g); }
PHASE_FN ph_outproj(int L) {
    const Ctx c = make_ctx(); LArgs a = (LArgs)(LDS_ARGS); unsigned char* ws = wsp(a); float* X = outp(a);
    pg8::Gemm g{(bf16_t*)(ws + WS_MIX), (bf16_t*)(ws + WS_WOUT), T, D, D}; pg8::StaticOrder S; S.init(T, D, c.G, c.bid);
    pg8::EpiResF32 E{X, (L == 0) ? inp(a, 0) : X, D, ALPHA};
    pg8::gemm_phase<pg8::EpiResF32, pg8::StaticOrder, false>(c.lds, g, S, E, nullptr);
}
PHASE_FN ph_ln1(int L) {
    const Ctx c = make_ctx(); LArgs a = (LArgs)(LDS_ARGS); unsigned char* ws = wsp(a); float* X = outp(a);
    const bool moe = (L & 1) != 0; const int fi = L >> 1; unsigned* ctl = (unsigned*)(ws + WS_CTL);
    if (moe) ln_phase<false, true>(c, X, (bf16_t*)(ws + WS_XB), inp(a, 31) + L * D, inp(a, 32) + L * D, nullptr, nullptr, (Route*)(ws + WS_ROUTE), inp(a, 38) + (size_t)fi * D * NE, ctl + CW_CNT + 64 * fi);
    else ln_phase<false, false>(c, X, (bf16_t*)(ws + WS_XB), inp(a, 31) + L * D, inp(a, 32) + L * D, nullptr, nullptr, nullptr, nullptr, nullptr);
}
PHASE_FN ph_gate(int L) {
    const Ctx c = make_ctx(); LArgs a = (LArgs)(LDS_ARGS); unsigned char* ws = wsp(a);
    pg8::Gemm g{(bf16_t*)(ws + WS_XB), (bf16_t*)(ws + WS_WG), T, D, D}; pg8::StaticOrder S; S.init(T, D, c.G, c.bid);
    pg8::EpiGate E{(bf16_t*)(ws + WS_PE), D, inp(a, 44) + L * D};
    pg8::gemm_phase<pg8::EpiGate, pg8::StaticOrder, false>(c.lds, g, S, E, nullptr);
}
PHASE_FN ph_pe(int L) {
    const Ctx c = make_ctx(); LArgs a = (LArgs)(LDS_ARGS); unsigned char* ws = wsp(a);
    pg8::Gemm g{(bf16_t*)(ws + WS_PB), (bf16_t*)(ws + WS_WPE), T, D, PE_DIM}; pg8::StaticOrder S; S.init(T, D, c.G, c.bid);
    pg8::EpiPeMul E{(bf16_t*)(ws + WS_PE), D};
    pg8::gemm_phase<pg8::EpiPeMul, pg8::StaticOrder, false>(c.lds, g, S, E, nullptr);
}
PHASE_FN ph_gather(int L) {
    const Ctx c = make_ctx(); LArgs a = (LArgs)(LDS_ARGS); unsigned char* ws = wsp(a); const int fi = L >> 1; unsigned* ctl = (unsigned*)(ws + WS_CTL);
    moe_assign_gather(c, (Route*)(ws + WS_ROUTE), ctl + CW_CNT + 64 * fi, ctl + CW_CUR + 64 * fi, (bf16_t*)(ws + WS_XB), (bf16_t*)(ws + WS_XG));
}
PHASE_FN ph_up_dense(int L) {
    const Ctx c = make_ctx(); LArgs a = (LArgs)(LDS_ARGS); unsigned char* ws = wsp(a);
    pg8::Gemm g{(bf16_t*)(ws + WS_XB), (bf16_t*)(ws + WS_W13), T, NH2, D}; pg8::StaticOrder S; S.init(T, NH2, c.G, c.bid);
    pg8::EpiSwiglu E{(bf16_t*)(ws + WS_H), DFF};
    pg8::gemm_phase<pg8::EpiSwiglu, pg8::StaticOrder, false>(c.lds, g, S, E, nullptr);
}
PHASE_FN ph_up_moe(int L) {
    const Ctx c = make_ctx(); LArgs a = (LArgs)(LDS_ARGS); unsigned char* ws = wsp(a); const int fi = L >> 1; unsigned* ctl = (unsigned*)(ws + WS_CTL);
    pg8::Gemm g{(bf16_t*)(ws + WS_XG), (bf16_t*)(ws + WS_W13), MOE_ROWS, NH2, D}; pg8::MoeOrder S; S.init_moe(ctl + CW_CNT + 64 * fi, NH2 / 256, c.G, c.bid, SZ_W13);
    pg8::EpiSwiglu E{(bf16_t*)(ws + WS_H), DFF};
    pg8::gemm_phase<pg8::EpiSwiglu, pg8::MoeOrder, false>(c.lds, g, S, E, nullptr);
}
PHASE_FN ph_down_dense(int L) {
    const Ctx c = make_ctx(); LArgs a = (LArgs)(LDS_ARGS); unsigned char* ws = wsp(a); float* X = outp(a);
    pg8::Gemm g{(bf16_t*)(ws + WS_H), (bf16_t*)(ws + WS_W2), T, D, DFF}; pg8::StaticOrder S; S.init(T, D, c.G, c.bid);
    pg8::EpiDownRes E{X, (bf16_t*)(ws + WS_PE), D, ALPHA};
    pg8::gemm_phase<pg8::EpiDownRes, pg8::StaticOrder, false>(c.lds, g, S, E, nullptr);
}
PHASE_FN ph_down_moe(int L) {
    const Ctx c = make_ctx(); LArgs a = (LArgs)(LDS_ARGS); unsigned char* ws = wsp(a); const int fi = L >> 1; unsigned* ctl = (unsigned*)(ws + WS_CTL);
    pg8::Gemm g{(bf16_t*)(ws + WS_H), (bf16_t*)(ws + WS_W2), MOE_ROWS, D, DFF}; pg8::MoeOrder S; S.init_moe(ctl + CW_CNT + 64 * fi, D / 256, c.G, c.bid, SZ_W2);
    pg8::EpiBf16 E{(bf16_t*)(ws + WS_XG), D};
    pg8::gemm_phase<pg8::EpiBf16, pg8::MoeOrder, false>(c.lds, g, S, E, nullptr);
}
PHASE_FN ph_ln2(int L) {
    const Ctx c = make_ctx(); LArgs a = (LArgs)(LDS_ARGS); unsigned char* ws = wsp(a); float* X = outp(a);
    const bool moe = (L & 1) != 0;
    if (moe) ln_phase<true, false>(c, X, (bf16_t*)(ws + WS_XB), inp(a, 33) + L * D, inp(a, 34) + L * D, (bf16_t*)(ws + WS_XG), (bf16_t*)(ws + WS_PE), (Route*)(ws + WS_ROUTE), nullptr, nullptr);
    else ln_phase<false, false>(c, X, (bf16_t*)(ws + WS_XB), inp(a, 33) + L * D, inp(a, 34) + L * D, nullptr, nullptr, nullptr, nullptr, nullptr);
}

DI void grid_bar(unsigned* barw, unsigned x, volatile LAS unsigned* st) { asm volatile("" : "+s"(barw), "+s"(x)); XcdBarrier b; b.bar = barw; b.x = x; b.st = st; xcd_barrier(b); }

__global__ void __launch_bounds__(512, 2) fwd_kernel(Args args) {
    extern __shared__ __attribute__((aligned(16))) unsigned char lds_raw[];
    LAS unsigned char* lds = (LAS unsigned char*)lds_raw;
    const int tid = threadIdx.x;
    volatile LAS unsigned* misc = (volatile LAS unsigned*)(lds + LDS_MISC);
    if (tid < 4) misc[tid] = 0u;
    { LAS unsigned long long* la = (LAS unsigned long long*)(lds + LDS_ARGS); const unsigned long long* ga = (const unsigned long long*)&args;
      if (tid < (int)(sizeof(Args) / 8)) la[tid] = ga[tid]; }
    __syncthreads();
    const int ph_lo = args.ph_lo, ph_hi = args.ph_hi;
    const bool multi = !(ph_lo == 0 && ph_hi == DEPTH * NPH);
    unsigned* ctl = (unsigned*)(args.ws + WS_CTL);
    XcdBarrier bar; bar.bar = ctl + CW_BAR; bar.x = 0; bar.st = misc;
    if (!multi) bar = xcd_barrier_post(ctl + CW_BAR, misc);
#define IN(k) (ph_lo <= (k) && (k) < ph_hi)
#define SEAM(k) do { if (IN((k) + 1)) grid_bar(bar.bar, bar.x, bar.st); } while (0)
    for (int L = 0; L < DEPTH; ++L) {
        const int p0 = L * NPH; const bool moe = (L & 1) != 0;
        if (PHEN(0) && IN(p0 + 0)) { ph_cvt(L); SEAM(p0 + 0); }
        if (PHEN(1) && IN(p0 + 1)) { ph_proj(L); SEAM(p0 + 1); }
        if (PHEN(2) && IN(p0 + 2)) {
            for (int task = blockIdx.x; task < 256; task += gridDim.x) {
                const int grp = task & 3, idx = task >> 2;
                if (grp == 0) ph_mix_rwkv(L, idx >> 2, idx & 3);
                else if (grp == 1) ph_mix_mlstm(L, idx >> 2, idx & 3);
                else if (grp == 2) ph_mix_rglru(L, idx >> 2, idx & 3);
                else if (idx < 32) ph_mix_ssd(L, idx >> 1, idx & 1);
                __syncthreads();
            }
            SEAM(p0 + 2);
        }
        if (PHEN(3) && IN(p0 + 3)) { ph_outproj(L); SEAM(p0 + 3); }
        if (PHEN(4) && IN(p0 + 4)) { ph_ln1(L); SEAM(p0 + 4); }
        if (PHEN(5) && IN(p0 + 5)) { ph_gate(L); ph_pe(L); if (moe) { __syncthreads(); ph_gather(L); } SEAM(p0 + 5); }
        if (PHEN(6) && IN(p0 + 6)) { if (moe) ph_up_moe(L); else ph_up_dense(L); SEAM(p0 + 6); }
        if (PHEN(7) && IN(p0 + 7)) { if (moe) ph_down_moe(L); else ph_down_dense(L); SEAM(p0 + 7); }
        if (PHEN(8) && IN(p0 + 8)) { ph_ln2(L); if (L + 1 < DEPTH) SEAM(p0 + 8); }
    }
#undef IN
#undef SEAM
}

#ifndef MK_PER_PHASE
#define MK_PER_PHASE 0
#endif
extern "C" void kernel_launch(void* const* d_in, const int* in_sizes, int n_in, void* d_out, int out_size, void* d_ws, size_t ws_size, hipStream_t stream) {
    static int grid = 0;
    if (grid == 0) {
        if (n_in != 45 || in_sizes[0] != T * D || out_size != T * D || ws_size < WS_END) {
            fprintf(stderr, "kernel_launch: unexpected shapes (n_in %d, in0 %d, out %d, ws %zu < %zu); nothing launched\n", n_in, n_in > 0 ? in_sizes[0] : -1, out_size, ws_size, (size_t)WS_END); grid = -1; return; }
        int dev = 0, cus = 0, per_cu = 0;
        if (hipGetDevice(&dev) != hipSuccess || hipDeviceGetAttribute(&cus, hipDeviceAttributeMultiprocessorCount, dev) != hipSuccess) { grid = -1; return; }
        if (hipFuncSetAttribute((const void*)fwd_kernel, hipFuncAttributeMaxDynamicSharedMemorySize, LDS_BYTES) != hipSuccess) { fprintf(stderr, "kernel_launch: hipFuncSetAttribute failed\n"); grid = -1; return; }
        if (hipOccupancyMaxActiveBlocksPerMultiprocessor(&per_cu, (const void*)fwd_kernel, 512, LDS_BYTES) != hipSuccess || per_cu < 1) { fprintf(stderr, "kernel_launch: occupancy query reports %d\n", per_cu); (void)hipGetLastError(); grid = -1; return; }
        grid = cus;
    }
    if (grid < 0) return;
    (void)hipMemsetAsync((char*)d_ws + WS_CTL, 0, CTL_BYTES, stream);
    Args a{};
    for (int i = 0; i < 45; ++i) a.in[i] = (const float*)d_in[i];
    a.out = (float*)d_out; a.ws = (unsigned char*)d_ws;
#if MK_PER_PHASE
    for (int ph = 0; ph < DEPTH * NPH; ++ph) { a.ph_lo = ph; a.ph_hi = ph + 1; hipLaunchKernelGGL(fwd_kernel, dim3(grid), dim3(512), LDS_BYTES, stream, a); }
#else
    a.ph_lo = 0; a.ph_hi = DEPTH * NPH;
    hipLaunchKernelGGL(fwd_kernel, dim3(grid), dim3(512), LDS_BYTES, stream, a);
#endif
}
```

```cpp
#include <hip/hip_runtime.h>
#include <cstdio>
#include <cstdint>

#define LAS __attribute__((address_space(3)))
typedef unsigned short bf16_t;
typedef short bf16x8 __attribute__((ext_vector_type(8)));
typedef float f32x4 __attribute__((ext_vector_type(4)));
typedef float f32x2 __attribute__((ext_vector_type(2)));
typedef unsigned u32x4 __attribute__((ext_vector_type(4)));
typedef unsigned u32x2 __attribute__((ext_vector_type(2)));
#define DI __device__ __forceinline__
#define GAS __attribute__((address_space(1)))

constexpr int NB = 16, SEQ = 2048, T = NB * SEQ, D = 1024, DEPTH = 4, PE_DIM = 256;
constexpr int NIN = 3212, NINP = 3328, DFF = 2816, NH2 = 2 * DFF, NE = 8;
constexpr int OFF_M = 0, OFF_G = 1032, OFF_R = 1544, OFF_S = 2440;
constexpr float ALPHA = 1.6817928305074290f;
constexpr int MOE_ROWS = 2 * T + NE * 256;

DI float bf2f(bf16_t b) { return __uint_as_float(((unsigned)b) << 16); }
typedef __bf16 bf16x2_t __attribute__((ext_vector_type(2)));
DI bf16_t f2bf(float f) { return __builtin_bit_cast(bf16_t, (__bf16)f); }
DI unsigned pack_bf16(float lo, float hi) { bf16x2_t v; v[0] = (__bf16)lo; v[1] = (__bf16)hi; return __builtin_bit_cast(unsigned, v); }
DI float rcpf_(float x) { return __builtin_amdgcn_rcpf(x); }
DI float sigmoidf_(float x) { return rcpf_(1.0f + __expf(-x)); }
DI float softplusf_(float x) { return fmaxf(x, 0.f) + __logf(1.0f + __expf(-fabsf(x))); }
DI float siluf_(float x) { return x * sigmoidf_(x); }
DI float tanhf_(float x) { const float e = __expf(-2.0f * fabsf(x)); const float r = (1.0f - e) * rcpf_(1.0f + e); return x < 0.f ? -r : r; }
DI float gelu_tanhf_(float x) { const float u = 0.7978845608028654f * (x + 0.044715f * x * x * x); return x * sigmoidf_(2.0f * u); }
DI float grp16_sum(float v) {
#pragma unroll
    for (int o = 8; o >= 1; o >>= 1) v += __shfl_xor(v, o);
    return v;
}
DI unsigned long long rfl64(unsigned long long v) { const unsigned lo = __builtin_amdgcn_readfirstlane((unsigned)v), hi = __builtin_amdgcn_readfirstlane((unsigned)(v >> 32)); return ((unsigned long long)hi << 32) | lo; }
#define XB_TMO      128
#define XB_XCNT(j)  (256  + 64 * (j))
#define XB_XSUB(j)  (1280 + 64 * (j))
#define XB_XGEN(j)  (2304 + 64 * (j))
#define XB_TOP      3328
#define XB_TOPGEN   3392
#define XCD_BAR_WORDS 3456
#define XB_SPIN_CAP (1u << 18)

__device__ __forceinline__ unsigned xb_ld(unsigned* p)              { return __hip_atomic_load(p, __ATOMIC_RELAXED, __HIP_MEMORY_SCOPE_AGENT); }
__device__ __forceinline__ unsigned xb_add(unsigned* p, unsigned v) { return __hip_atomic_fetch_add(p, v, __ATOMIC_RELAXED, __HIP_MEMORY_SCOPE_AGENT); }
__device__ __forceinline__ unsigned xb_xcc_id() { return (unsigned)__builtin_amdgcn_s_getreg((3 << 11) | 20) & 0xFu; }
#define XB_SPIN(cond, bar) do { unsigned _sp = 0; while (cond) { __builtin_amdgcn_s_sleep(1); \
    if ((++_sp & 255u) == 0u) { if (xb_ld(&(bar)[XB_TMO])) break; if (_sp > XB_SPIN_CAP) { atomicAdd(&(bar)[XB_TMO], 1u); break; } } } } while (0)

struct XcdBarrier {
    unsigned* bar; unsigned x;
    volatile LAS unsigned* st;
};

__device__ __forceinline__ XcdBarrier xcd_barrier_post(unsigned* bar, volatile LAS unsigned* st) {
    XcdBarrier b; b.bar = bar; b.x = xb_xcc_id(); b.st = st;
    if (threadIdx.x == 0) (void)xb_add(&bar[XB_XCNT(b.x)], 1u);
    return b;
}
__device__ __forceinline__ void xcd_barrier_complete(unsigned* bar, unsigned x, unsigned& nloc, unsigned& nx) {
    const unsigned G = gridDim.x * gridDim.y * gridDim.z;
    unsigned sum, cnt, mine, sp = 0u;
    for (;;) {
        sum = 0u; cnt = 0u; mine = 0u;
#pragma unroll
        for (unsigned j = 0; j < 16; ++j) { const unsigned c = xb_ld(&bar[XB_XCNT(j)]); sum += c; cnt += (c > 0u) ? 1u : 0u; mine = (j == x) ? c : mine; }
        if (sum == G) break;
        __builtin_amdgcn_s_sleep(1);
        if ((++sp & 255u) == 0u) { if (xb_ld(&bar[XB_TMO])) break; if (sp > XB_SPIN_CAP) { atomicAdd(&bar[XB_TMO], 1u); break; } }
    }
    nloc = mine > 0u ? mine : 1u; nx = cnt > 0u ? cnt : 1u;
}

__device__ __forceinline__ void xcd_barrier(const XcdBarrier& b) {
    asm volatile("s_waitcnt vmcnt(0)" ::: "memory");
    __syncthreads();
    if (threadIdx.x == 0) {
        unsigned* bar = b.bar;
        __builtin_amdgcn_s_waitcnt(0);
        unsigned nloc = b.st[0], nx = b.st[1];
        if (nloc == 0u) { xcd_barrier_complete(bar, b.x, nloc, nx); b.st[0] = nloc; b.st[1] = nx; }
        const unsigned old = xb_add(&bar[XB_XSUB(b.x)], 1u);
        const unsigned gen = old / nloc;
        if (old + 1u == (gen + 1u) * nloc) {
            __builtin_amdgcn_fence(__ATOMIC_RELEASE, "agent");
            asm volatile("s_waitcnt vmcnt(0)" ::: "memory");
            const unsigned og = xb_add(&bar[XB_TOP], 1u);
            const unsigned tg = og / nx;
            if (og + 1u == (tg + 1u) * nx) xb_add(&bar[XB_TOPGEN], 1u);
            else XB_SPIN(xb_ld(&bar[XB_TOPGEN]) == tg, bar);
            __builtin_amdgcn_fence(__ATOMIC_ACQUIRE, "agent");
            xb_add(&bar[XB_XGEN(b.x)], 1u);
            asm volatile("s_waitcnt vmcnt(0)" ::: "memory");
        } else {
            XB_SPIN(xb_ld(&bar[XB_XGEN(b.x)]) == gen, bar);
            __builtin_amdgcn_fence(__ATOMIC_ACQUIRE, "agent");
            asm volatile("s_waitcnt vmcnt(0)" ::: "memory");
        }
    }
    __syncthreads();
}
namespace pg8 {
typedef short bf16x8 __attribute__((ext_vector_type(8)));
typedef float f32x4 __attribute__((ext_vector_type(4)));
typedef unsigned u32x4 __attribute__((ext_vector_type(4)));
constexpr int BM = 256, BK = 64, HALF = 128, HTB = HALF * BK * 2  , STAGE_BYTES = 8 * HTB, NXCD = 8, WGM = 4;

__host__ __device__ __forceinline__ int lds_byte(int r, int c) { const int st = (r >> 4) * 2 + (c >> 5), rr = r & 15, cc = c & 31, ob = rr * 64 + cc * 2; return st * 1024 + (ob ^ (((ob >> 9) & 1) << 5)); }
__host__ __device__ __forceinline__ void stage_rc(int b, int& R, int& C) { const int st = b / 1024, sb = b % 1024, swz = sb ^ (((sb >> 9) & 1) << 5); R = (st >> 1) * 16 + swz / 64; C = (st & 1) * 32 + (swz % 64) / 2; }
__host__ __device__ __forceinline__ int perm32(int rho) { const int n = rho >> 4, i = rho & 15; return 8 * (i >> 2) + 4 * n + (i & 3); }

#define PG8_LAS __attribute__((address_space(3)))
struct Unit { int pm, pn; size_t boff; };
struct Gemm { const bf16_t* A; const bf16_t* Bt; int M, N, K; };

struct StaticOrder {
    int nM, nN, nwg, G, c;
    __device__ void init(int M, int N, int G_, int c_) { nM = M / BM; nN = N / BM; nwg = nM * nN; G = G_; c = c_; }
    __device__ bool next(int i, Unit& u) const {
        const long L = (long)i * G + c; if (L >= nwg) return false;
        int wgid = (int)L; { const int q = nwg / NXCD, r = nwg % NXCD, xcd = wgid % NXCD, off = wgid / NXCD; wgid = (xcd < r ? xcd * (q + 1) : r * (q + 1) + (xcd - r) * q) + off; }
        const int nig = WGM * nN, gid = wgid / nig, fm = gid * WGM, gsz = (nM - fm) < WGM ? (nM - fm) : WGM;
        u.pm = fm + ((wgid % nig) % gsz); u.pn = (wgid % nig) / gsz; u.boff = 0; return true;
    }
    __device__ __forceinline__ void a_ready(const Unit&) const {}
    __device__ __forceinline__ void done(const Unit&) const {}
};
struct MoeOrder : StaticOrder {
    int tstart[NE + 1]; size_t estride;
    __device__ void init_moe(const unsigned* counts, int nN_, int G_, int c_, size_t estride_) {
        int acc = 0;
#pragma unroll
        for (int e = 0; e < NE; ++e) { tstart[e] = acc; acc += __builtin_amdgcn_readfirstlane(((int)counts[e] + 255) >> 8); }
        tstart[NE] = acc; nM = acc; nN = nN_; nwg = nM * nN; G = G_; c = c_; estride = estride_;
    }
    __device__ bool next(int i, Unit& u) const {
        if (!StaticOrder::next(i, u)) return false;
        int e = 0;
#pragma unroll
        for (int j = 1; j < NE; ++j) e += (u.pm >= tstart[j]) ? 1 : 0;
        u.boff = (size_t)e * estride; return true;
    }
};


struct ListOrder {
    int first, stride, total, nN;
    __device__ void init(int first_, int stride_, int total_, int nN_) { first = first_; stride = stride_; total = total_; nN = nN_; }
    __device__ bool next(int i, Unit& u) const { const int idx = first + i * stride; if (first < 0 || idx >= total) return false; u.pm = idx / nN; u.pn = idx - u.pm * nN; u.boff = 0; return true; }
    __device__ __forceinline__ void a_ready(const Unit&) const {}
    __device__ __forceinline__ void done(const Unit&) const {}
};

__device__ __forceinline__ unsigned cvt_pk_bf16(float lo, float hi) { return pack_bf16(lo, hi); }
__device__ __forceinline__ float bflo(unsigned w) { return __uint_as_float(w << 16); }
__device__ __forceinline__ float bfhi(unsigned w) { return __uint_as_float(w & 0xFFFF0000u); }
__device__ __forceinline__ float sigm(float x) { return __builtin_amdgcn_rcpf(1.0f + __expf(-x)); }

struct EpiBf16 {
    static constexpr bool PERM = true, AFTER_DRAIN = false, FP8 = false;
    bf16_t* O; int ldc;
    __device__ __forceinline__ void operator()(const f32x4 (&acc)[2][2][4][2], const Unit& u, int wr, int wc, int fr, int fq) const {
        const int row0 = u.pm * BM + wr * 64 + fr, col0 = u.pn * BM + wc * 32 + 8 * fq;
#pragma unroll
        for (int ai = 0; ai < 2; ++ai)
#pragma unroll
            for (int m = 0; m < 4; ++m) { bf16_t* rowp = O + (size_t)(row0 + ai * HALF + m * 16) * ldc + col0;
#pragma unroll
                for (int bj = 0; bj < 2; ++bj) { const f32x4 v0 = acc[ai][bj][m][0], v1 = acc[ai][bj][m][1];
                    u32x4 w; w.x = cvt_pk_bf16(v0[0], v0[1]); w.y = cvt_pk_bf16(v0[2], v0[3]); w.z = cvt_pk_bf16(v1[0], v1[1]); w.w = cvt_pk_bf16(v1[2], v1[3]);
                    *(GAS u32x4*)(rowp + bj * HALF) = w; } }
    }
};
struct EpiSwiglu {
    static constexpr bool PERM = true, AFTER_DRAIN = false, FP8 = false;
    bf16_t* H; int ldh;
    __device__ __forceinline__ void operator()(const f32x4 (&acc)[2][2][4][2], const Unit& u, int wr, int wc, int fr, int fq) const {
        const int row0 = u.pm * BM + wr * 64 + fr, col0 = u.pn * HALF + wc * 32 + 8 * fq;
#pragma unroll
        for (int ai = 0; ai < 2; ++ai)
#pragma unroll
            for (int m = 0; m < 4; ++m) { bf16_t* rowp = H + (size_t)(row0 + ai * HALF + m * 16) * ldh + col0;
                float h[8];
#pragma unroll
                for (int n = 0; n < 2; ++n)
#pragma unroll
                    for (int j = 0; j < 4; ++j) { const float a = acc[ai][0][m][n][j], b = acc[ai][1][m][n][j]; h[n * 4 + j] = a * sigm(a) * b; }
                u32x4 w; w.x = cvt_pk_bf16(h[0], h[1]); w.y = cvt_pk_bf16(h[2], h[3]); w.z = cvt_pk_bf16(h[4], h[5]); w.w = cvt_pk_bf16(h[6], h[7]);
                *(GAS u32x4*)rowp = w; }
    }
};
typedef int v8i __attribute__((ext_vector_type(8)));
typedef int v4i __attribute__((ext_vector_type(4)));
__device__ __forceinline__ v8i cat8(const bf16x8 lo, const bf16x8 hi) { const v4i a = __builtin_bit_cast(v4i, lo), b = __builtin_bit_cast(v4i, hi); return (v8i){a.x, a.y, a.z, a.w, b.x, b.y, b.z, b.w}; }
__device__ __forceinline__ unsigned pk4_fp8(float a, float b, float c, float d) { unsigned w = 0; w = __builtin_amdgcn_cvt_pk_fp8_f32(a, b, w, false); w = __builtin_amdgcn_cvt_pk_fp8_f32(c, d, w, true); return w; }
template <bool F8IN = true>
struct EpiSwiglu8T {
    static constexpr bool PERM = true, AFTER_DRAIN = false, FP8 = F8IN;
    unsigned char* H; int ldh; float sc;
    __device__ __forceinline__ void operator()(const f32x4 (&acc)[2][2][4][2], const Unit& u, int wr, int wc, int fr, int fq) const {
        const int row0 = u.pm * BM + wr * 64 + fr, col0 = u.pn * HALF + wc * 32 + 8 * fq;
#pragma unroll
        for (int ai = 0; ai < 2; ++ai)
#pragma unroll
            for (int m = 0; m < 4; ++m) { unsigned char* rowp = H + (size_t)(row0 + ai * HALF + m * 16) * ldh + col0;
                float h[8];
#pragma unroll
                for (int n = 0; n < 2; ++n)
#pragma unroll
                    for (int j = 0; j < 4; ++j) { const float a = acc[ai][0][m][n][j] * sc, b = acc[ai][1][m][n][j] * sc; h[n * 4 + j] = a * sigm(a) * b; }
                u32x2 w; w.x = pk4_fp8(h[0], h[1], h[2], h[3]); w.y = pk4_fp8(h[4], h[5], h[6], h[7]);
                *(GAS u32x2*)rowp = w; }
    }
};
typedef EpiSwiglu8T<true> EpiSwiglu8;
struct EpiBf16S8 {
    static constexpr bool PERM = true, AFTER_DRAIN = false, FP8 = true;
    bf16_t* O; int ldc; float sc;
    __device__ __forceinline__ void operator()(const f32x4 (&acc)[2][2][4][2], const Unit& u, int wr, int wc, int fr, int fq) const {
        const int row0 = u.pm * BM + wr * 64 + fr, col0 = u.pn * BM + wc * 32 + 8 * fq;
#pragma unroll
        for (int ai = 0; ai < 2; ++ai)
#pragma unroll
            for (int m = 0; m < 4; ++m) { bf16_t* rowp = O + (size_t)(row0 + ai * HALF + m * 16) * ldc + col0;
#pragma unroll
                for (int bj = 0; bj < 2; ++bj) { const f32x4 v0 = acc[ai][bj][m][0] * sc, v1 = acc[ai][bj][m][1] * sc;
                    u32x4 w; w.x = cvt_pk_bf16(v0[0], v0[1]); w.y = cvt_pk_bf16(v0[2], v0[3]); w.z = cvt_pk_bf16(v1[0], v1[1]); w.w = cvt_pk_bf16(v1[2], v1[3]);
                    *(GAS u32x4*)(rowp + bj * HALF) = w; } }
    }
};
struct EpiResF32 {
    static constexpr bool PERM = false, AFTER_DRAIN = false, FP8 = false;
    float* X; const float* R; int ldc; float alpha;
    __device__ __forceinline__ void operator()(const f32x4 (&acc)[2][2][4][2], const Unit& u, int wr, int wc, int fr, int fq) const {
        const int row0 = u.pm * BM + wr * 64 + fr, col0 = u.pn * BM + wc * 32 + 4 * fq;
#pragma unroll
        for (int ai = 0; ai < 2; ++ai)
#pragma unroll
            for (int m = 0; m < 4; ++m) { const size_t ro = (size_t)(row0 + ai * HALF + m * 16) * ldc + col0;
#pragma unroll
                for (int bj = 0; bj < 2; ++bj)
#pragma unroll
                    for (int n = 0; n < 2; ++n) { asm volatile("" ::: "memory"); const f32x4 r = *(const GAS f32x4*)(R + ro + bj * HALF + n * 16); *(GAS f32x4*)(X + ro + bj * HALF + n * 16) = r * alpha + acc[ai][bj][m][n]; } }
    }
};
struct EpiResBf {
    static constexpr bool PERM = false, AFTER_DRAIN = false, FP8 = false;
    float* X; const bf16_t* RB; int ldc; float alpha;
    __device__ __forceinline__ void operator()(const f32x4 (&acc)[2][2][4][2], const Unit& u, int wr, int wc, int fr, int fq) const {
        const int row0 = u.pm * BM + wr * 64 + fr, col0 = u.pn * BM + wc * 32 + 4 * fq;
#pragma unroll
        for (int ai = 0; ai < 2; ++ai)
#pragma unroll
            for (int m = 0; m < 4; ++m) { const size_t ro = (size_t)(row0 + ai * HALF + m * 16) * ldc + col0;
#pragma unroll
                for (int bj = 0; bj < 2; ++bj)
#pragma unroll
                    for (int n = 0; n < 2; ++n) { asm volatile("" ::: "memory"); const size_t o = ro + bj * HALF + n * 16; const u32x2 rw = *(const GAS u32x2*)(RB + o);
                        f32x4 r; r[0] = bflo(rw.x); r[1] = bfhi(rw.x); r[2] = bflo(rw.y); r[3] = bfhi(rw.y);
                        *(GAS f32x4*)(X + o) = r * alpha + acc[ai][bj][m][n]; } }
    }
};
struct EpiDownRes {
    static constexpr bool PERM = false, AFTER_DRAIN = false, FP8 = false;
    float* X; const bf16_t* RB; const bf16_t* PEb; int ldc; float alpha;
    __device__ __forceinline__ void operator()(const f32x4 (&acc)[2][2][4][2], const Unit& u, int wr, int wc, int fr, int fq) const {
        const int row0 = u.pm * BM + wr * 64 + fr, col0 = u.pn * BM + wc * 32 + 4 * fq;
#pragma unroll
        for (int ai = 0; ai < 2; ++ai)
#pragma unroll
            for (int m = 0; m < 4; ++m) { const size_t ro = (size_t)(row0 + ai * HALF + m * 16) * ldc + col0;
#pragma unroll
                for (int bj = 0; bj < 2; ++bj)
#pragma unroll
                    for (int n = 0; n < 2; ++n) { asm volatile("" ::: "memory"); const size_t o = ro + bj * HALF + n * 16; const u32x2 rw = *(const GAS u32x2*)(RB + o); const u32x2 pw = *(const GAS u32x2*)(PEb + o);
                        f32x4 r; r[0] = bflo(rw.x); r[1] = bfhi(rw.x); r[2] = bflo(rw.y); r[3] = bfhi(rw.y);
                        f32x4 pe; pe[0] = bflo(pw.x); pe[1] = bfhi(pw.x); pe[2] = bflo(pw.y); pe[3] = bfhi(pw.y);
                        *(GAS f32x4*)(X + o) = r * alpha + acc[ai][bj][m][n] + pe; } }
    }
};
__device__ __forceinline__ void unpack8(const u32x4 w, float (&f)[8]) { f[0] = bflo(w.x); f[1] = bfhi(w.x); f[2] = bflo(w.y); f[3] = bfhi(w.y); f[4] = bflo(w.z); f[5] = bfhi(w.z); f[6] = bflo(w.w); f[7] = bfhi(w.w); }
template <int RMODE  , bool HASPE, bool F8 = false>
struct EpiPreLn {
    static constexpr bool PERM = true, AFTER_DRAIN = false, FP8 = F8;
    bf16_t* P; const void* R; const bf16_t* PEb; int ldc; float alpha; float sc = 1.0f;
    __device__ __forceinline__ void operator()(const f32x4 (&acc)[2][2][4][2], const Unit& u, int wr, int wc, int fr, int fq) const {
        const int row0 = u.pm * BM + wr * 64 + fr, col0 = u.pn * BM + wc * 32 + 8 * fq;
#pragma unroll
        for (int ai = 0; ai < 2; ++ai)
#pragma unroll
            for (int m = 0; m < 4; ++m) { const size_t ro = (size_t)(row0 + ai * HALF + m * 16) * ldc + col0;
#pragma unroll
                for (int bj = 0; bj < 2; ++bj) { asm volatile("" ::: "memory"); const size_t o = ro + bj * HALF; float r[8];
                    if (RMODE == 0) { const f32x4 a = *(const GAS f32x4*)((const float*)R + o), b = *(const GAS f32x4*)((const float*)R + o + 4); r[0] = a[0]; r[1] = a[1]; r[2] = a[2]; r[3] = a[3]; r[4] = b[0]; r[5] = b[1]; r[6] = b[2]; r[7] = b[3]; }
                    else unpack8(*(const GAS u32x4*)((const bf16_t*)R + o), r);
                    float v[8];
#pragma unroll
                    for (int j = 0; j < 4; ++j) { v[j] = r[j] * alpha + acc[ai][bj][m][0][j] * (F8 ? sc : 1.0f); v[4 + j] = r[4 + j] * alpha + acc[ai][bj][m][1][j] * (F8 ? sc : 1.0f); }
                    if (HASPE) { float pe[8]; unpack8(*(const GAS u32x4*)(PEb + o), pe);
#pragma unroll
                        for (int j = 0; j < 8; ++j) v[j] += pe[j]; }
                    u32x4 w; w.x = cvt_pk_bf16(v[0], v[1]); w.y = cvt_pk_bf16(v[2], v[3]); w.z = cvt_pk_bf16(v[4], v[5]); w.w = cvt_pk_bf16(v[6], v[7]);
                    *(GAS u32x4*)(P + o) = w; } }
    }
};
struct EpiGate {
    static constexpr bool PERM = true, AFTER_DRAIN = false, FP8 = false;
    bf16_t* O; int ldc; const float* bias;
    __device__ __forceinline__ void operator()(const f32x4 (&acc)[2][2][4][2], const Unit& u, int wr, int wc, int fr, int fq) const {
        const int row0 = u.pm * BM + wr * 64 + fr, col0 = u.pn * BM + wc * 32 + 8 * fq;
        f32x4 bv[2][2];
#pragma unroll
        for (int bj = 0; bj < 2; ++bj)
#pragma unroll
            for (int n = 0; n < 2; ++n) bv[bj][n] = *(const GAS f32x4*)(bias + col0 + bj * HALF + 4 * n);
#pragma unroll
        for (int ai = 0; ai < 2; ++ai)
#pragma unroll
            for (int m = 0; m < 4; ++m) { bf16_t* rowp = O + (size_t)(row0 + ai * HALF + m * 16) * ldc + col0;
#pragma unroll
                for (int bj = 0; bj < 2; ++bj) { f32x4 v0 = acc[ai][bj][m][0] + bv[bj][0], v1 = acc[ai][bj][m][1] + bv[bj][1];
#pragma unroll
                    for (int j = 0; j < 4; ++j) { v0[j] = sigm(v0[j]); v1[j] = sigm(v1[j]); }
                    u32x4 w; w.x = cvt_pk_bf16(v0[0], v0[1]); w.y = cvt_pk_bf16(v0[2], v0[3]); w.z = cvt_pk_bf16(v1[0], v1[1]); w.w = cvt_pk_bf16(v1[2], v1[3]);
                    *(GAS u32x4*)(rowp + bj * HALF) = w; } }
    }
};
struct EpiGateMul {
    static constexpr bool PERM = true, AFTER_DRAIN = false, FP8 = false;
    bf16_t* O; int ldc; const float* bias;
    __device__ __forceinline__ void operator()(const f32x4 (&acc)[2][2][4][2], const Unit& u, int wr, int wc, int fr, int fq) const {
        const int row0 = u.pm * BM + wr * 64 + fr, col0 = u.pn * BM + wc * 32 + 8 * fq;
        f32x4 bv[2][2];
#pragma unroll
        for (int bj = 0; bj < 2; ++bj)
#pragma unroll
            for (int n = 0; n < 2; ++n) bv[bj][n] = *(const GAS f32x4*)(bias + col0 + bj * HALF + 4 * n);
#pragma unroll
        for (int ai = 0; ai < 2; ++ai)
#pragma unroll
            for (int m = 0; m < 4; ++m) { bf16_t* rowp = O + (size_t)(row0 + ai * HALF + m * 16) * ldc + col0;
#pragma unroll
                for (int bj = 0; bj < 2; ++bj) { asm volatile("" ::: "memory"); const f32x4 v0 = acc[ai][bj][m][0] + bv[bj][0], v1 = acc[ai][bj][m][1] + bv[bj][1]; const u32x4 g = *(const GAS u32x4*)(rowp + bj * HALF);
                    u32x4 w; w.x = cvt_pk_bf16(sigm(v0[0]) * bflo(g.x), sigm(v0[1]) * bfhi(g.x)); w.y = cvt_pk_bf16(sigm(v0[2]) * bflo(g.y), sigm(v0[3]) * bfhi(g.y));
                    w.z = cvt_pk_bf16(sigm(v1[0]) * bflo(g.z), sigm(v1[1]) * bfhi(g.z)); w.w = cvt_pk_bf16(sigm(v1[2]) * bflo(g.w), sigm(v1[3]) * bfhi(g.w));
                    *(GAS u32x4*)(rowp + bj * HALF) = w; } }
    }
};
struct EpiPeMul {
    static constexpr bool PERM = true, AFTER_DRAIN = false, FP8 = false;
    bf16_t* O; int ldc;
    __device__ __forceinline__ void operator()(const f32x4 (&acc)[2][2][4][2], const Unit& u, int wr, int wc, int fr, int fq) const {
        const int row0 = u.pm * BM + wr * 64 + fr, col0 = u.pn * BM + wc * 32 + 8 * fq;
#pragma unroll
        for (int ai = 0; ai < 2; ++ai)
#pragma unroll
            for (int m = 0; m < 4; ++m) { bf16_t* rowp = O + (size_t)(row0 + ai * HALF + m * 16) * ldc + col0;
#pragma unroll
                for (int bj = 0; bj < 2; ++bj) { asm volatile("" ::: "memory"); const f32x4 v0 = acc[ai][bj][m][0], v1 = acc[ai][bj][m][1]; const u32x4 g = *(const GAS u32x4*)(rowp + bj * HALF);
                    u32x4 w; w.x = cvt_pk_bf16(v0[0] * bflo(g.x), v0[1] * bfhi(g.x)); w.y = cvt_pk_bf16(v0[2] * bflo(g.y), v0[3] * bfhi(g.y));
                    w.z = cvt_pk_bf16(v1[0] * bflo(g.z), v1[1] * bfhi(g.z)); w.w = cvt_pk_bf16(v1[2] * bflo(g.w), v1[3] * bfhi(g.w));
                    *(GAS u32x4*)(rowp + bj * HALF) = w; } }
    }
};

template <class Epi, class Sched, bool STAMP = false>
__device__ __forceinline__ void gemm_phase(PG8_LAS unsigned char* lds, const Gemm g, const Sched& S, const Epi& E, unsigned long long* stamps) {
    int tid_ = threadIdx.x; asm volatile("" : "+v"(tid_));
    const int tid = tid_, wid = __builtin_amdgcn_readfirstlane(tid >> 6), lane = tid & 63, wr = wid >> 2, wc = wid & 3, fr = lane & 15, fq = lane >> 4;
    const int K = g.K, nt = K / BK;
    int ts_lo = 0, ts_hi = 0, nts = 0; const unsigned long long rt_entry = STAMP ? (unsigned long long)wall_clock64() : 0ull;
#define PG8_STAMP() do { if (STAMP && wid == 0 && nts < 64) { const unsigned long long _c = (unsigned long long)clock64(); \
        ts_lo = (lane == nts) ? (int)(unsigned)_c : ts_lo; ts_hi = (lane == nts) ? (int)(unsigned)(_c >> 32) : ts_hi; ++nts; } } while (0)
    PG8_STAMP();
    unsigned voffA[2], voffB[2];
#pragma unroll
    for (int i = 0; i < 2; ++i) { int R, C; stage_rc(tid * 16 + i * 8192, R, C); const int Rb = Epi::PERM ? ((R & ~31) + perm32(R & 31)) : R;
        voffA[i] = (unsigned)(R * K + C) * 2u; voffB[i] = (unsigned)(Rb * K + C) * 2u; }
    const size_t kstep = (size_t)(BK * 2);
    const size_t hstep = (size_t)HALF * K * 2;
    const size_t tstep = 2 * hstep;
    const unsigned ldsw = (unsigned)wid * 1024u;
    const int aoff = lds_byte(wr * 64 + fr, fq * 8), boff = lds_byte(wc * 32 + fr, fq * 8);
#define PG8_SA(b, h) (((b) * 2 + (h)) * HTB)
#define PG8_SB(b, h) ((4 + (b) * 2 + (h)) * HTB)
#define PG8_STAGE(bufoff, gbase, voff) do { _Pragma("unroll") for (int _i = 0; _i < 2; ++_i) \
        __builtin_amdgcn_global_load_lds((const unsigned*)((const char*)(gbase) + (voff)[_i]), (PG8_LAS unsigned*)(lds + (bufoff) + ldsw + _i * 8192), 16, 0, 0); } while (0)
#define PG8_LDA(dst, b, h) do { _Pragma("unroll") for (int m = 0; m < 4; ++m) { dst[m].lo = *(const PG8_LAS v4i*)(lds + PG8_SA(b, h) + aoff + m * 2048); dst[m].hi = *(const PG8_LAS v4i*)(lds + PG8_SA(b, h) + aoff + m * 2048 + 1024); } } while (0)
#define PG8_LDB(dst, b, h) do { _Pragma("unroll") for (int n = 0; n < 2; ++n) { dst[n].lo = *(const PG8_LAS v4i*)(lds + PG8_SB(b, h) + boff + n * 2048); dst[n].hi = *(const PG8_LAS v4i*)(lds + PG8_SB(b, h) + boff + n * 2048 + 1024); } } while (0)
#define PG8_MMA(ai, bj, At, Bt) do { __builtin_amdgcn_s_setprio(1); \
        if constexpr (Epi::FP8) { _Pragma("unroll") for (int m = 0; m < 4; ++m) _Pragma("unroll") for (int n = 0; n < 2; ++n) \
            asm volatile("v_mfma_f32_16x16x128_f8f6f4 %0, %1, %2, %0" : "+v"(acc[ai][bj][m][n]) : "v"(Bt[n]), "v"(At[m])); } \
        else { _Pragma("unroll") for (int m = 0; m < 4; ++m) _Pragma("unroll") for (int n = 0; n < 2; ++n) { \
            const v4i bl_ = Bt[n].lo, bh_ = Bt[n].hi, al_ = At[m].lo, ah_ = At[m].hi;     \
            acc[ai][bj][m][n] = __builtin_amdgcn_mfma_f32_16x16x32_bf16(__builtin_bit_cast(bf16x8, bl_), __builtin_bit_cast(bf16x8, al_), acc[ai][bj][m][n], 0, 0, 0); \
            acc[ai][bj][m][n] = __builtin_amdgcn_mfma_f32_16x16x32_bf16(__builtin_bit_cast(bf16x8, bh_), __builtin_bit_cast(bf16x8, ah_), acc[ai][bj][m][n], 0, 0, 0); } } \
        __builtin_amdgcn_s_setprio(0); } while (0)
#define PG8_WAIT_V(n) asm volatile("s_waitcnt vmcnt(" #n ")" ::: "memory")
#define PG8_WAIT_L(n) asm volatile("s_waitcnt lgkmcnt(" #n ")" ::: "memory")
#define PG8_BAR __builtin_amdgcn_s_barrier()
#define PG8_SCHED __builtin_amdgcn_sched_barrier(0)
    Unit cur, nxt; int ui = 0;
    if (!S.next(0, cur)) return;
    f32x4 acc[2][2][4][2];
#pragma unroll
    for (int a = 0; a < 2; ++a)
#pragma unroll
        for (int b = 0; b < 2; ++b)
#pragma unroll
            for (int m = 0; m < 4; ++m)
#pragma unroll
                for (int n = 0; n < 2; ++n) acc[a][b][m][n] = (f32x4){0.f, 0.f, 0.f, 0.f};
    v8i At[4], B0[2], B1[2];
    const char* cA = (const char*)g.A + (size_t)cur.pm * tstep; const char* cB = (const char*)g.Bt + cur.boff + (size_t)cur.pn * tstep;
    S.a_ready(cur);
    PG8_STAGE(PG8_SB(0, 0), cB, voffB); PG8_STAGE(PG8_SA(0, 0), cA, voffA); PG8_STAGE(PG8_SB(0, 1), cB + hstep, voffB); PG8_STAGE(PG8_SA(0, 1), cA + hstep, voffA);
    if (wr == 1) PG8_BAR;
    PG8_WAIT_V(4); PG8_BAR;
    PG8_STAGE(PG8_SB(1, 0), cB + kstep, voffB); PG8_STAGE(PG8_SA(1, 0), cA + kstep, voffA); PG8_STAGE(PG8_SB(1, 1), cB + hstep + kstep, voffB);
    PG8_WAIT_V(6); PG8_BAR;
    PG8_STAMP();
    for (;;) {
        const bool has_next = S.next(ui + 1, nxt);
        const char* nA = has_next ? (const char*)g.A + (size_t)nxt.pm * tstep : cA; const char* nB = has_next ? (const char*)g.Bt + nxt.boff + (size_t)nxt.pn * tstep : cB;
#pragma nounroll
        for (int t = 0; t < nt; t += 2) {
            const bool last = (t == nt - 2);
            const char* a1 = cA + (size_t)(t + 1) * kstep;
            const char* a2 = last ? nA : cA + (size_t)(t + 2) * kstep; const char* b2 = last ? nB : cB + (size_t)(t + 2) * kstep;
            const char* a3 = a2 + kstep; const char* b3 = b2 + kstep;
            if (last && has_next) S.a_ready(nxt);
            PG8_LDB(B0, 0, 0); PG8_SCHED; PG8_LDA(At, 0, 0); PG8_STAGE(PG8_SA(1, 1), a1 + hstep, voffA);
            PG8_WAIT_L(8); PG8_BAR; PG8_WAIT_L(0); PG8_MMA(0, 0, At, B0); PG8_BAR; PG8_SCHED;
            PG8_LDB(B1, 0, 1); PG8_STAGE(PG8_SB(0, 0), b2, voffB);
            PG8_BAR; PG8_WAIT_L(0); PG8_MMA(0, 1, At, B1); PG8_BAR;
            PG8_LDA(At, 0, 1); PG8_STAGE(PG8_SA(0, 0), a2, voffA);
            PG8_BAR; PG8_WAIT_L(0); PG8_MMA(1, 0, At, B0); PG8_BAR; PG8_SCHED;
            PG8_STAGE(PG8_SB(0, 1), b2 + hstep, voffB);
            PG8_WAIT_V(6); PG8_BAR; PG8_MMA(1, 1, At, B1); PG8_BAR;
            PG8_LDB(B0, 1, 0); PG8_SCHED; PG8_LDA(At, 1, 0); PG8_STAGE(PG8_SA(0, 1), a2 + hstep, voffA);
            PG8_WAIT_L(8); PG8_BAR; PG8_WAIT_L(0); PG8_MMA(0, 0, At, B0); PG8_BAR; PG8_SCHED;
            PG8_LDB(B1, 1, 1); PG8_STAGE(PG8_SB(1, 0), b3, voffB);
            PG8_BAR; PG8_WAIT_L(0); PG8_MMA(0, 1, At, B1); PG8_BAR;
            PG8_LDA(At, 1, 1); PG8_STAGE(PG8_SA(1, 0), a3, voffA);
            PG8_BAR; PG8_WAIT_L(0); PG8_MMA(1, 0, At, B0); PG8_BAR; PG8_SCHED;
            PG8_STAGE(PG8_SB(1, 1), b3 + hstep, voffB);
            PG8_WAIT_V(6); PG8_BAR; PG8_MMA(1, 1, At, B1); PG8_BAR;
        }
        PG8_STAMP();
        if constexpr (Epi::FP8) { asm volatile("s_nop 15\n\ts_nop 15" : "+v"(acc[0][0][0][0]), "+v"(acc[0][0][0][1]), "+v"(acc[0][0][1][0]), "+v"(acc[0][0][1][1]), "+v"(acc[0][0][2][0]), "+v"(acc[0][0][2][1]), "+v"(acc[0][0][3][0]), "+v"(acc[0][0][3][1]), "+v"(acc[0][1][0][0]), "+v"(acc[0][1][0][1]), "+v"(acc[0][1][1][0]), "+v"(acc[0][1][1][1]), "+v"(acc[0][1][2][0]), "+v"(acc[0][1][2][1]), "+v"(acc[0][1][3][0]), "+v"(acc[0][1][3][1]));
                                  asm volatile("" : "+v"(acc[1][0][0][0]), "+v"(acc[1][0][0][1]), "+v"(acc[1][0][1][0]), "+v"(acc[1][0][1][1]), "+v"(acc[1][0][2][0]), "+v"(acc[1][0][2][1]), "+v"(acc[1][0][3][0]), "+v"(acc[1][0][3][1]), "+v"(acc[1][1][0][0]), "+v"(acc[1][1][0][1]), "+v"(acc[1][1][1][0]), "+v"(acc[1][1][1][1]), "+v"(acc[1][1][2][0]), "+v"(acc[1][1][2][1]), "+v"(acc[1][1][3][0]), "+v"(acc[1][1][3][1])); }
        if constexpr (!Epi::AFTER_DRAIN) { E(acc, cur, wr, wc, fr, fq); S.done(cur); }
        PG8_STAMP();
        if (!has_next) break;
#pragma unroll
        for (int a = 0; a < 2; ++a)
#pragma unroll
            for (int b = 0; b < 2; ++b)
#pragma unroll
                for (int m = 0; m < 4; ++m)
#pragma unroll
                    for (int n = 0; n < 2; ++n) acc[a][b][m][n] = (f32x4){0.f, 0.f, 0.f, 0.f};
        cur = nxt; cA = nA; cB = nB; ++ui;
    }
    PG8_WAIT_V(0);
    if (wr == 0) PG8_BAR;
    PG8_BAR;
    if constexpr (Epi::AFTER_DRAIN) { E.fused(acc, cur, wr, wc, fr, fq, lds, wid, lane); S.done(cur); }
    PG8_STAMP();
    if (STAMP && wid == 0) { stamps[lane] = lane < nts ? (((unsigned long long)(unsigned)ts_hi << 32) | (unsigned)ts_lo) : 0ull;
        if (lane == 62) stamps[62] = rt_entry; if (lane == 63) stamps[63] = (unsigned long long)wall_clock64(); }
#undef PG8_STAMP
#undef PG8_SA
#undef PG8_SB
#undef PG8_STAGE
#undef PG8_LDA
#undef PG8_LDB
#undef PG8_MMA
#undef PG8_WAIT_V
#undef PG8_WAIT_L
#undef PG8_BAR
#undef PG8_SCHED
}
}
template <class F>
DI void mm_lds(const LAS bf16_t* A, int lda, const LAS bf16_t* Bt, int ldb, int M, int N, int K, int wave, int lane, F epi) {
    const int ntn = N >> 4, nt = (M >> 4) * ntn, r = lane & 15, q = lane >> 4;
    for (int t = wave; t < nt; t += 8) {
        const int m0 = (t / ntn) << 4, n0 = (t % ntn) << 4;
        f32x4 acc = {0.f, 0.f, 0.f, 0.f};
        for (int k0 = 0; k0 < K; k0 += 32) {
            const bf16x8 a = *(const LAS bf16x8*)(A + (m0 + r) * lda + k0 + q * 8);
            const bf16x8 b = *(const LAS bf16x8*)(Bt + (n0 + r) * ldb + k0 + q * 8);
            acc = __builtin_amdgcn_mfma_f32_16x16x32_bf16(b, a, acc, 0, 0, 0);
        }
        epi(m0 + r, n0 + 4 * q, acc);
    }
}
template <class F>
DI void mm_lds2(const LAS bf16_t* A1, int lda1, const LAS bf16_t* Bt1, int ldb1, int K1, const LAS bf16_t* A2, int lda2, const LAS bf16_t* Bt2, int ldb2, int K2,
                int M, int N, int wave, int lane, F epi) {
    const int ntn = N >> 4, nt = (M >> 4) * ntn, r = lane & 15, q = lane >> 4;
    for (int t = wave; t < nt; t += 8) {
        const int m0 = (t / ntn) << 4, n0 = (t % ntn) << 4;
        f32x4 acc1 = {0.f, 0.f, 0.f, 0.f}, acc2 = {0.f, 0.f, 0.f, 0.f};
        for (int k0 = 0; k0 < K1; k0 += 32) {
            const bf16x8 a = *(const LAS bf16x8*)(A1 + (m0 + r) * lda1 + k0 + q * 8);
            const bf16x8 b = *(const LAS bf16x8*)(Bt1 + (n0 + r) * ldb1 + k0 + q * 8);
            acc1 = __builtin_amdgcn_mfma_f32_16x16x32_bf16(b, a, acc1, 0, 0, 0);
        }
        for (int k0 = 0; k0 < K2; k0 += 32) {
            const bf16x8 a = *(const LAS bf16x8*)(A2 + (m0 + r) * lda2 + k0 + q * 8);
            const bf16x8 b = *(const LAS bf16x8*)(Bt2 + (n0 + r) * ldb2 + k0 + q * 8);
            acc2 = __builtin_amdgcn_mfma_f32_16x16x32_bf16(b, a, acc2, 0, 0, 0);
        }
        epi(m0 + r, n0 + 4 * q, acc1, acc2);
    }
}
template <int CTRL> DI float dppf(float v) { return __builtin_bit_cast(float, __builtin_amdgcn_update_dpp(0, __builtin_bit_cast(int, v), CTRL, 0xF, 0xF, true)); }
DI float red4(float v) { v += dppf<0xB1>(v); v += dppf<0x4E>(v); return v; }
DI float red8(float v) { v += dppf<0xB1>(v); v += dppf<0x4E>(v); v += dppf<0x141>(v); return v; }
DI void st_bf16x4(LAS bf16_t* p, const f32x4 v) { u32x2 w; w.x = pack_bf16(v[0], v[1]); w.y = pack_bf16(v[2], v[3]); *(LAS u32x2*)p = w; }
template <int NT, class FO>
DI void mm_lds_state(const LAS bf16_t* A, int lda, const LAS bf16_t* Bt, int ldb, int ntn, int K, int wave, int lane, f32x4 (&st)[NT], float decay, FO out) {
    const int r = lane & 15, q = lane >> 4;
#pragma unroll
    for (int i = 0; i < NT; ++i) {
        const int t = wave + 8 * i, m0 = (t / ntn) << 4, n0 = (t % ntn) << 4;
        f32x4 acc = st[i] * decay;
        for (int k0 = 0; k0 < K; k0 += 32) {
            const bf16x8 a = *(const LAS bf16x8*)(A + (m0 + r) * lda + k0 + q * 8);
            const bf16x8 b = *(const LAS bf16x8*)(Bt + (n0 + r) * ldb + k0 + q * 8);
            acc = __builtin_amdgcn_mfma_f32_16x16x32_bf16(b, a, acc, 0, 0, 0);
        }
        st[i] = acc; out(m0 + r, n0 + 4 * q, acc);
    }
}
template <int CTRL, int RM> DI float dppo(float old, float v) { return __builtin_bit_cast(float, __builtin_amdgcn_update_dpp(__builtin_bit_cast(int, old), __builtin_bit_cast(int, v), CTRL, RM, 0xF, false)); }
DI float wave_scan_add(float v, int) {
    v += dppo<0x111, 0xF>(0.f, v); v += dppo<0x112, 0xF>(0.f, v); v += dppo<0x114, 0xF>(0.f, v); v += dppo<0x118, 0xF>(0.f, v);
    v += dppo<0x142, 0xA>(0.f, v); v += dppo<0x143, 0xC>(0.f, v); return v;
}
DI float wave_scan_max(float v, int) {
    const float ni = -3.0e38f;
    v = fmaxf(v, dppo<0x111, 0xF>(ni, v)); v = fmaxf(v, dppo<0x112, 0xF>(ni, v)); v = fmaxf(v, dppo<0x114, 0xF>(ni, v)); v = fmaxf(v, dppo<0x118, 0xF>(ni, v));
    v = fmaxf(v, dppo<0x142, 0xA>(ni, v)); v = fmaxf(v, dppo<0x143, 0xC>(ni, v)); return v;
}
DI float lane63(float v) { return __builtin_bit_cast(float, __builtin_amdgcn_readlane(__builtin_bit_cast(int, v), 63)); }
DI float wave_max(float v) {
#pragma unroll
    for (int o = 32; o >= 1; o >>= 1) v = fmaxf(v, __shfl_xor(v, o));
    return v;
}
DI float red16(float v) { v += dppf<0xB1>(v); v += dppf<0x4E>(v); v += dppf<0x141>(v); v += dppf<0x140>(v); return v; }
template <class F>
DI void mm_lds_w(const LAS bf16_t* A, int lda, const LAS bf16_t* Bt, int ldb, int M, int N, int K, int pw, int nw, int lane, F epi) {
    const int ntn = N >> 4, nt = (M >> 4) * ntn, r = lane & 15, q = lane >> 4;
    for (int t = pw; t < nt; t += nw) {
        const int m0 = (t / ntn) << 4, n0 = (t % ntn) << 4;
        f32x4 acc = {0.f, 0.f, 0.f, 0.f};
        for (int k0 = 0; k0 < K; k0 += 32) {
            const bf16x8 a = *(const LAS bf16x8*)(A + (m0 + r) * lda + k0 + q * 8);
            const bf16x8 b = *(const LAS bf16x8*)(Bt + (n0 + r) * ldb + k0 + q * 8);
            acc = __builtin_amdgcn_mfma_f32_16x16x32_bf16(b, a, acc, 0, 0, 0);
        }
        epi(m0 + r, n0 + 4 * q, acc);
    }
}

DI float wave_sum(float v) { return lane63(wave_scan_add(v, 0)); }
#ifndef MOE_FP8
#define MOE_FP8 1
#endif
struct Ctx {
    LAS unsigned char* lds;
    int tid, lane, wave, G, bid;
};

DI void cvt_tile(const Ctx& c, const float* __restrict__ s, bf16_t* __restrict__ d, int K, int N, int mode, int k0, int n0) {
    LAS float* tile = (LAS float*)c.lds;
#pragma unroll
    for (int i = 0; i < 8; ++i) { const int row = i * 8 + (c.tid >> 6), col = c.tid & 63, n = n0 + col;
        tile[row * 65 + col] = (n < N) ? s[(size_t)(k0 + row) * N + n] : 0.f; }
    __syncthreads();
    { const int n = c.tid >> 3, kk = (c.tid & 7) * 8, ng = n0 + n;
      int drow = ng; if (mode == 1) drow = (ng >> 7) * 256 + (ng & 127); else if (mode == 2) drow = (ng >> 7) * 256 + 128 + (ng & 127);
      u32x4 w; w.x = pack_bf16(tile[(kk + 0) * 65 + n], tile[(kk + 1) * 65 + n]); w.y = pack_bf16(tile[(kk + 2) * 65 + n], tile[(kk + 3) * 65 + n]);
      w.z = pack_bf16(tile[(kk + 4) * 65 + n], tile[(kk + 5) * 65 + n]); w.w = pack_bf16(tile[(kk + 6) * 65 + n], tile[(kk + 7) * 65 + n]);
      *(GAS u32x4*)(d + (size_t)drow * K + k0 + kk) = w; }
    __syncthreads();
}
DI void cvt_weight(const Ctx& c, const float* __restrict__ src, bf16_t* __restrict__ dst, int K, int N, int mode, int nb, size_t sstride, size_t dstride, int& rot) {
    const int ntk = K >> 6, ntn = (N + 63) >> 6, per = ntk * ntn, total = per * nb;
    int first = c.bid - rot; if (first < 0) first += c.G;
    for (int t = first; t < total; t += c.G) {
        const int b = t / per, r = t - b * per, tk = r / ntn, tn = r - tk * ntn;
        cvt_tile(c, src + (size_t)b * sstride, dst + (size_t)b * dstride, K, N, mode, tk << 6, tn << 6);
    }
    rot = (rot + total) % c.G;
}
DI void cvt_act(const Ctx& c, const float* __restrict__ src, bf16_t* __restrict__ dst, size_t n) {
    const size_t nv = n >> 3;
    for (size_t i = (size_t)c.bid * 512 + c.tid; i < nv; i += (size_t)c.G * 512) {
        const f32x4 a = *(const GAS f32x4*)(src + i * 8), b = *(const GAS f32x4*)(src + i * 8 + 4);
        u32x4 w; w.x = pack_bf16(a[0], a[1]); w.y = pack_bf16(a[2], a[3]); w.z = pack_bf16(b[0], b[1]); w.w = pack_bf16(b[2], b[3]);
        *(GAS u32x4*)(dst + i * 8) = w;
    }
}

struct Route { int e0, e1; float g0, g1; int s0, s1; int pad0, pad1; };
template <bool COMBINE, bool ROUTE, bool WRITEX>
DI void ln_phase(const Ctx& c, float* __restrict__ X, const bf16_t* __restrict__ PRE, bf16_t* __restrict__ XB, unsigned char* __restrict__ XB8, const float* __restrict__ gam, const float* __restrict__ bet,
                 const bf16_t* __restrict__ YB, const bf16_t* __restrict__ PEb, Route* __restrict__ route, const float* __restrict__ wr, unsigned* __restrict__ counts) {
    LAS float* wrs = (LAS float*)c.lds;
    LAS unsigned* lcnt = (LAS unsigned*)(c.lds + 32768);
    if (ROUTE) {
        for (int i = c.tid; i < 1024 * 8; i += 512) wrs[i] = wr[i];
        if (c.tid < NE) lcnt[c.tid] = 0u;
        __syncthreads();
    }
    f32x4 gv[4], bv[4];
#pragma unroll
    for (int i = 0; i < 4; ++i) { gv[i] = *(const GAS f32x4*)(gam + i * 256 + c.lane * 4); bv[i] = *(const GAS f32x4*)(bet + i * 256 + c.lane * 4); }
    for (int row = c.bid * 8 + c.wave; row < T; row += c.G * 8) {
        float* xr = X + (size_t)row * D;
        f32x4 v[4];
        if (!COMBINE) {
#pragma unroll
            for (int i = 0; i < 4; ++i) { const u32x2 w = *(const GAS u32x2*)(PRE + (size_t)row * D + i * 256 + c.lane * 4); v[i][0] = pg8::bflo(w.x); v[i][1] = pg8::bfhi(w.x); v[i][2] = pg8::bflo(w.y); v[i][3] = pg8::bfhi(w.y); }
        } else {
#pragma unroll
            for (int i = 0; i < 4; ++i) { const u32x2 w = *(const GAS u32x2*)(XB + (size_t)row * D + i * 256 + c.lane * 4); v[i][0] = pg8::bflo(w.x); v[i][1] = pg8::bfhi(w.x); v[i][2] = pg8::bflo(w.y); v[i][3] = pg8::bfhi(w.y); }
        }
        if (COMBINE) {
            const Route rt = route[row];
            const bf16_t* y0 = YB + (size_t)rt.s0 * D; const bf16_t* y1 = YB + (size_t)rt.s1 * D; const bf16_t* pe = PEb + (size_t)row * D;
#pragma unroll
            for (int i = 0; i < 4; ++i) { const int o = i * 256 + c.lane * 4;
                const u32x2 a = *(const GAS u32x2*)(y0 + o), b = *(const GAS u32x2*)(y1 + o), p = *(const GAS u32x2*)(pe + o);
                v[i][0] = ALPHA * v[i][0] + rt.g0 * pg8::bflo(a.x) + rt.g1 * pg8::bflo(b.x) + pg8::bflo(p.x);
                v[i][1] = ALPHA * v[i][1] + rt.g0 * pg8::bfhi(a.x) + rt.g1 * pg8::bfhi(b.x) + pg8::bfhi(p.x);
                v[i][2] = ALPHA * v[i][2] + rt.g0 * pg8::bflo(a.y) + rt.g1 * pg8::bflo(b.y) + pg8::bflo(p.y);
                v[i][3] = ALPHA * v[i][3] + rt.g0 * pg8::bfhi(a.y) + rt.g1 * pg8::bfhi(b.y) + pg8::bfhi(p.y); }
        }
        float s = 0.f;
#pragma unroll
        for (int i = 0; i < 4; ++i) s += (v[i][0] + v[i][1]) + (v[i][2] + v[i][3]);
        const float mean = wave_sum(s) * (1.0f / D);
        float q = 0.f;
#pragma unroll
        for (int i = 0; i < 4; ++i) { v[i] = v[i] - mean; q += (v[i][0] * v[i][0] + v[i][1] * v[i][1]) + (v[i][2] * v[i][2] + v[i][3] * v[i][3]); }
        const float rstd = rsqrtf(wave_sum(q) * (1.0f / D) + 1e-5f);
#pragma unroll
        for (int i = 0; i < 4; ++i) { v[i] = v[i] * rstd * gv[i] + bv[i];
            if (WRITEX) *(GAS f32x4*)(xr + i * 256 + c.lane * 4) = v[i];
            u32x2 w; w.x = pack_bf16(v[i][0], v[i][1]); w.y = pack_bf16(v[i][2], v[i][3]);
            *(GAS u32x2*)(XB + (size_t)row * D + i * 256 + c.lane * 4) = w;
            if (XB8) *(GAS unsigned*)(XB8 + (size_t)row * D + i * 256 + c.lane * 4) = pg8::pk4_fp8(v[i][0], v[i][1], v[i][2], v[i][3]); }
        if (ROUTE) {
            float lg[NE];
#pragma unroll
            for (int e = 0; e < NE; ++e) lg[e] = 0.f;
#pragma unroll
            for (int i = 0; i < 4; ++i)
#pragma unroll
                for (int j = 0; j < 4; ++j) { const int d = i * 256 + c.lane * 4 + j; const f32x4 w0 = *(const LAS f32x4*)(wrs + d * 8), w1 = *(const LAS f32x4*)(wrs + d * 8 + 4);
                    lg[0] += v[i][j] * w0[0]; lg[1] += v[i][j] * w0[1]; lg[2] += v[i][j] * w0[2]; lg[3] += v[i][j] * w0[3];
                    lg[4] += v[i][j] * w1[0]; lg[5] += v[i][j] * w1[1]; lg[6] += v[i][j] * w1[2]; lg[7] += v[i][j] * w1[3]; }
#pragma unroll
            for (int e = 0; e < NE; ++e) lg[e] = wave_sum(lg[e]);
            int e0 = 0; float l0 = lg[0];
#pragma unroll
            for (int e = 1; e < NE; ++e) if (lg[e] > l0) { l0 = lg[e]; e0 = e; }
            int e1 = -1; float l1 = -3.0e38f;
#pragma unroll
            for (int e = 0; e < NE; ++e) if (e != e0 && lg[e] > l1) { l1 = lg[e]; e1 = e; }
            if (c.lane == 0) {
                const float g0 = 1.0f / (1.0f + __expf(l1 - l0));
                u32x4 rw; rw.x = (unsigned)e0; rw.y = (unsigned)e1; rw.z = __float_as_uint(g0); rw.w = __float_as_uint(1.0f - g0);
                *(GAS u32x4*)&route[row] = rw;
                atomicAdd((unsigned*)&lcnt[e0], 1u); atomicAdd((unsigned*)&lcnt[e1], 1u);
            }
        }
    }
    if (ROUTE) {
        __syncthreads();
        if (c.tid < NE) atomicAdd(&counts[c.tid], lcnt[c.tid]);
    }
}

DI void moe_assign_gather(const Ctx& c, Route* __restrict__ route, const unsigned* __restrict__ counts, unsigned* __restrict__ cursor, const bf16_t* __restrict__ XB, bf16_t* __restrict__ XG) {
    LAS unsigned* lcnt = (LAS unsigned*)c.lds;
    LAS unsigned* lbase = lcnt + 8;
    LAS int* lslot = (LAS int*)(lcnt + 16);
    unsigned pstart[NE]; { unsigned acc = 0;
#pragma unroll
        for (int e = 0; e < NE; ++e) { pstart[e] = acc; acc += ((counts[e] + 255u) >> 8) << 8; } }
    for (int chunk = c.bid; chunk < T / 128; chunk += c.G) {
        if (c.tid < NE) lcnt[c.tid] = 0u;
        __syncthreads();
        const int tok = chunk * 128 + c.tid; int e0 = 0, e1 = 0; unsigned r0 = 0, r1 = 0;
        if (c.tid < 128) { e0 = route[tok].e0; e1 = route[tok].e1; r0 = atomicAdd((unsigned*)&lcnt[e0], 1u); r1 = atomicAdd((unsigned*)&lcnt[e1], 1u); }
        __syncthreads();
        if (c.tid < NE) lbase[c.tid] = atomicAdd(&cursor[c.tid], lcnt[c.tid]);
        __syncthreads();
        if (c.tid < 128) {
            unsigned p0 = 0, p1 = 0;
#pragma unroll
            for (int e = 0; e < NE; ++e) { if (e == e0) p0 = pstart[e]; if (e == e1) p1 = pstart[e]; }
            const int s0 = (int)(p0 + lbase[e0] + r0), s1 = (int)(p1 + lbase[e1] + r1);
            route[tok].s0 = s0; route[tok].s1 = s1; lslot[c.tid * 2] = s0; lslot[c.tid * 2 + 1] = s1;
        }
        __syncthreads();
        for (int pr = c.tid >> 7; pr < 256; pr += 4) {
            const int tk = chunk * 128 + (pr >> 1); const int slot = lslot[pr]; const int o = (c.tid & 127) * 8;
#if !MOE_FP8
            *(GAS u32x4*)(XG + (size_t)slot * D + o) = *(const GAS u32x4*)(XB + (size_t)tk * D + o);
#else
            const u32x4 xw = *(const GAS u32x4*)(XB + (size_t)tk * D + o);
            u32x2 w8; w8.x = pg8::pk4_fp8(pg8::bflo(xw.x), pg8::bfhi(xw.x), pg8::bflo(xw.y), pg8::bfhi(xw.y)); w8.y = pg8::pk4_fp8(pg8::bflo(xw.z), pg8::bfhi(xw.z), pg8::bflo(xw.w), pg8::bfhi(xw.w));
            *(GAS u32x2*)((unsigned char*)XG + (size_t)slot * D + o) = w8;
#endif
        }
        __syncthreads();
    }
}
struct MixP {
    const GAS bf16_t* proj; GAS bf16_t* mix; int layer;
    const GAS float *m_i_bias, *m_f_bias, *m_norm_w;
    const GAS float *g_conv_w, *g_conv_b, *g_w_a, *g_b_a, *g_w_x, *g_b_x, *g_lambda;
    const GAS float *r_mu, *r_w0, *r_w2, *r_a0, *r_a2, *r_g2, *r_k_k, *r_k_a, *r_r_k, *r_ln_w, *r_ln_b;
    const GAS float *s_conv_w, *s_conv_b, *s_dt_bias, *s_a_log, *s_d, *s_norm_w;
};
constexpr int TC = 32;
DI float ldp(const GAS bf16_t* proj, int t, int col) { return bf2f(proj[(size_t)t * NINP + col]); }
DI void stage_rows(const Ctx& c, LAS bf16_t* dst, int ldd, const GAS bf16_t* proj, int b, int srow0, int nrows, int col0, int ncols) {
    const int pc = ncols >> 3, np = nrows * pc;
    for (int p = c.tid; p < np; p += 512) { const int r = p / pc, c8 = p - r * pc, s = srow0 + r;
        u32x4 v = {0u, 0u, 0u, 0u}; if (s >= 0) v = *(const GAS u32x4*)(proj + (size_t)(b * SEQ + s) * NINP + col0 + c8 * 8);
        *(LAS u32x4*)(dst + r * ldd + c8 * 8) = v; }
}
DI void mix_mlstm_v2(const Ctx& c, const MixP& P, int b, int h) {
    constexpr int LD = 72;
    LAS bf16_t* Qs = (LAS bf16_t*)c.lds; LAS bf16_t* Ks = Qs + 64 * LD; LAS bf16_t* KT = Ks + 64 * LD; LAS bf16_t* VT = KT + 64 * LD; LAS bf16_t* VwT = VT + 64 * LD;
    LAS bf16_t* Sb = VwT + 64 * LD; LAS bf16_t* Cb = Sb + 64 * LD;
    LAS float* Hn = (LAS float*)(c.lds + 64512); LAS float* Og = Hn + 64 * 64;
    LAS float* Li = Og + 64 * 64; LAS float* Bc = Li + 64; LAS float* Mt = Bc + 64; LAS float* Iw = Mt + 64; LAS float* Wg = Iw + 64; LAS float* Qn = Wg + 64;
    LAS float* Inv = Qn + 64; LAS float* Nv = Inv + 64; LAS float* Sc = Nv + 64; LAS float* Np = Sc + 64;
    const int L = P.layer; const float ib = P.m_i_bias[L * 4 + h], fb = P.m_f_bias[L * 4 + h];
    const int l = c.tid >> 3, part = c.tid & 7;
    f32x4 Cst[2] = {{0.f, 0.f, 0.f, 0.f}, {0.f, 0.f, 0.f, 0.f}};
    for (int i = c.tid; i < 64 * LD; i += 512) Cb[i] = 0;
    if (c.tid < 64) Nv[c.tid] = 0.f;
    if (c.tid == 0) { Sc[0] = 1.f; Sc[1] = 0.f; }
    __syncthreads();
    u32x4 qw, kw, vw, ow; float gi = 0.f, gf = 0.f;
#define ML_FETCH(S0) do { const int t_ = b * SEQ + (S0) + l; const GAS bf16_t* pr = P.proj + (size_t)t_ * NINP + OFF_M + h * 64 + part * 8; \
        qw = *(const GAS u32x4*)pr; kw = *(const GAS u32x4*)(pr + 256); vw = *(const GAS u32x4*)(pr + 512); ow = *(const GAS u32x4*)(pr + 768); \
        if (part == 0) { gi = ldp(P.proj, t_, OFF_M + 1024 + h); gf = ldp(P.proj, t_, OFF_M + 1028 + h); } } while (0)
    ML_FETCH(0);
    for (int s0 = 0; s0 < SEQ; s0 += 64) {
        const int t = b * SEQ + s0 + l;
        {
          *(LAS u32x4*)(Qs + l * LD + part * 8) = qw;
          const unsigned kk[4] = {kw.x, kw.y, kw.z, kw.w}, vv[4] = {vw.x, vw.y, vw.z, vw.w}, oo[4] = {ow.x, ow.y, ow.z, ow.w};
          u32x4 ks;
#pragma unroll
          for (int j = 0; j < 4; ++j) { const float k0 = pg8::bflo(kk[j]) * 0.125f, k1 = pg8::bfhi(kk[j]) * 0.125f; const unsigned pk = pack_bf16(k0, k1);
              if (j == 0) ks.x = pk; else if (j == 1) ks.y = pk; else if (j == 2) ks.z = pk; else ks.w = pk;
              KT[(part * 8 + 2 * j) * LD + l] = (bf16_t)(pk & 0xFFFFu); KT[(part * 8 + 2 * j + 1) * LD + l] = (bf16_t)(pk >> 16);
              VT[(part * 8 + 2 * j) * LD + l] = (bf16_t)(vv[j] & 0xFFFFu); VT[(part * 8 + 2 * j + 1) * LD + l] = (bf16_t)(vv[j] >> 16);
              Og[l * 64 + part * 8 + 2 * j] = sigmoidf_(pg8::bflo(oo[j])); Og[l * 64 + part * 8 + 2 * j + 1] = sigmoidf_(pg8::bfhi(oo[j])); }
          *(LAS u32x4*)(Ks + l * LD + part * 8) = ks;
          if (part == 0) { Li[l] = gi + ib; Bc[l] = -softplusf_(-(gf + fb)); } }
        if (s0 + 64 < SEQ) ML_FETCH(s0 + 64);
        __syncthreads();
        if (c.wave == 1 && s0 > 0) { float acc = 0.f;
#pragma unroll
            for (int j = 0; j < 8; ++j) acc += Np[j * 64 + c.lane];
            Nv[c.lane] = acc; }
        if (c.wave == 0) {
            const float mprev = Sc[1]; const float li = Li[c.lane];
            const float bb = wave_scan_add(Bc[c.lane], c.lane);
            const float g = lane63(bb);
            const float pm = wave_scan_max(li - bb, c.lane);
            const float a = g - bb + li; const float amax = lane63(wave_scan_max(a, c.lane));
            const float mt = fmaxf(bb + mprev, bb + pm);
            const float mnew = fmaxf(g + mprev, amax);
            Bc[c.lane] = bb; Mt[c.lane] = mt; Iw[c.lane] = __expf(bb + mprev - mt); Wg[c.lane] = __expf(a - mnew);
            if (c.lane == 0) { Sc[0] = __expf(g + mprev - mnew); Sc[1] = mnew; }
        }
        __syncthreads();
        mm_lds(Qs, LD, Ks, LD, 64, 64, 64, c.wave, c.lane, [&](int row, int col0, const f32x4& a) {
            const float bl = Bc[row] - Mt[row]; f32x4 o;
#pragma unroll
            for (int j = 0; j < 4; ++j) { const int sidx = col0 + j; o[j] = (sidx <= row) ? a[j] * __expf(bl - Bc[sidx] + Li[sidx]) : 0.f; }
            st_bf16x4(Sb + row * LD + col0, o); });
        {
          const u32x4 vt = *(const LAS u32x4*)(VT + l * LD + part * 8); const f32x4 w0 = *(const LAS f32x4*)(Wg + part * 8), w1 = *(const LAS f32x4*)(Wg + part * 8 + 4);
          u32x4 o; o.x = pack_bf16(pg8::bflo(vt.x) * w0[0], pg8::bfhi(vt.x) * w0[1]); o.y = pack_bf16(pg8::bflo(vt.y) * w0[2], pg8::bfhi(vt.y) * w0[3]);
          o.z = pack_bf16(pg8::bflo(vt.z) * w1[0], pg8::bfhi(vt.z) * w1[1]); o.w = pack_bf16(pg8::bflo(vt.w) * w1[2], pg8::bfhi(vt.w) * w1[3]);
          *(LAS u32x4*)(VwT + l * LD + part * 8) = o;
          const u32x4 qw = *(const LAS u32x4*)(Qs + l * LD + part * 8); const f32x4 n0 = *(const LAS f32x4*)(Nv + part * 8), n1 = *(const LAS f32x4*)(Nv + part * 8 + 4);
          float d = pg8::bflo(qw.x) * n0[0] + pg8::bfhi(qw.x) * n0[1] + pg8::bflo(qw.y) * n0[2] + pg8::bfhi(qw.y) * n0[3]
                  + pg8::bflo(qw.z) * n1[0] + pg8::bfhi(qw.z) * n1[1] + pg8::bflo(qw.w) * n1[2] + pg8::bfhi(qw.w) * n1[3];
          d = red8(d); if (part == 0) Qn[l] = d; }
        __syncthreads();
        mm_lds2(Sb, LD, VT, LD, 64, Qs, LD, Cb, LD, 64, 64, 64, c.wave, c.lane, [&](int row, int col0, const f32x4& a1, const f32x4& a2) {
            const float iw = Iw[row]; *(LAS f32x4*)(Hn + row * 64 + col0) = a1 + a2 * iw; });
        { const u32x4 sw = *(const LAS u32x4*)(Sb + l * LD + part * 8);
          float rs = (pg8::bflo(sw.x) + pg8::bfhi(sw.x)) + (pg8::bflo(sw.y) + pg8::bfhi(sw.y)) + (pg8::bflo(sw.z) + pg8::bfhi(sw.z)) + (pg8::bflo(sw.w) + pg8::bfhi(sw.w));
          rs = red8(rs);
          if (part == 0) { const float den = rs + Iw[l] * Qn[l]; Inv[l] = rcpf_(fmaxf(fabsf(den), __expf(-Mt[l]))); } }
        __syncthreads();
        { const float dec = Sc[0];
          mm_lds_state<2>(VwT, LD, KT, LD, 4, 64, c.wave, c.lane, Cst, dec, [&](int row, int col0, const f32x4& a) { st_bf16x4(Cb + row * LD + col0, a); });
          { float acc = (c.wave == 0) ? dec * Nv[c.lane] : 0.f;
#pragma unroll
            for (int j = 0; j < 8; ++j) acc += Wg[c.wave * 8 + j] * bf2f(Ks[(c.wave * 8 + j) * LD + c.lane]);
            Np[c.wave * 64 + c.lane] = acc; }
          const float inv = Inv[l]; f32x4 h0 = *(const LAS f32x4*)(Hn + l * 64 + part * 8) * inv, h1 = *(const LAS f32x4*)(Hn + l * 64 + part * 8 + 4) * inv;
          float ss = (h0[0] * h0[0] + h0[1] * h0[1]) + (h0[2] * h0[2] + h0[3] * h0[3]) + (h1[0] * h1[0] + h1[1] * h1[1]) + (h1[2] * h1[2] + h1[3] * h1[3]);
          ss = red8(ss); const float rsn = rsqrtf(ss * (1.0f / 64.0f) + 1e-6f);
          const f32x4 g0 = *(const LAS f32x4*)(Og + l * 64 + part * 8), g1 = *(const LAS f32x4*)(Og + l * 64 + part * 8 + 4);
          const GAS float* nw = P.m_norm_w + L * 256 + h * 64 + part * 8; const f32x4 w0 = *(const GAS f32x4*)nw, w1 = *(const GAS f32x4*)(nw + 4);
          h0 = h0 * rsn * w0 * g0; h1 = h1 * rsn * w1 * g1;
          u32x4 o; o.x = pack_bf16(h0[0], h0[1]); o.y = pack_bf16(h0[2], h0[3]); o.z = pack_bf16(h1[0], h1[1]); o.w = pack_bf16(h1[2], h1[3]);
          *(GAS u32x4*)(P.mix + (size_t)t * D + h * 64 + part * 8) = o; }
        __syncthreads();
    }
}
constexpr size_t RWB_CHUNK = 8 * 16 * 64;
DI GAS float* rw_block(GAS float* ops, int b, int h, int chunk16) { return ops + ((size_t)((b * 4 + h) * (SEQ / 16) + chunk16)) * RWB_CHUNK; }

#define RLX_AGENT __ATOMIC_RELAXED, __HIP_MEMORY_SCOPE_AGENT
DI void rwkv_prep(const Ctx& c, const MixP& P, GAS float* ops, int b, int h, int sp, GAS unsigned* fl, unsigned epoch) {
    constexpr int TC2 = 32;
    LAS bf16_t* W2T = (LAS bf16_t*)c.lds;
    LAS bf16_t* A2T = W2T + 64 * 40;
    LAS bf16_t* G2T = A2T + 64 * 40;
    LAS bf16_t* LoB = G2T + 64 * 72;
    LAS float* WL = (LAS float*)(c.lds + 28160); LAS float* AL = WL + TC2 * 64; LAS float* Gl = AL + TC2 * 64;
    LAS float* MU = Gl + TC2 * 64;
    LAS float* CH = MU + 320;
    const int L = P.layer; const int tt = c.tid >> 4, part = c.tid & 15;
    for (int i = c.tid; i < 2048; i += 512) { const int r = i >> 6, j = i & 63;
        W2T[j * 40 + r] = f2bf(P.r_w2[(size_t)(L * 32 + r) * 256 + h * 64 + j]); A2T[j * 40 + r] = f2bf(P.r_a2[(size_t)(L * 32 + r) * 256 + h * 64 + j]); }
    for (int i = c.tid; i < 4096; i += 512) { const int r = i >> 6, j = i & 63; G2T[j * 72 + r] = f2bf(P.r_g2[(size_t)(L * 64 + r) * 256 + h * 64 + j]); }
    if (c.tid < 320) { const int i = c.tid; MU[i] = P.r_mu[L * 896 + ((i < 192) ? ((i >> 6) * 256 + h * 64 + (i & 63)) : (768 + i - 192))]; }
    if (c.tid < 64) { const int hj = L * 256 + h * 64 + c.tid;
        CH[c.tid] = P.r_w0[hj]; CH[64 + c.tid] = P.r_a0[hj]; CH[128 + c.tid] = P.r_k_k[hj]; CH[192 + c.tid] = P.r_k_a[hj]; CH[256 + c.tid] = P.r_r_k[hj]; }
    u32x4 lc, lp; u32x2 rc, rp, kc, kp, vc, vp;
#define RWKV_FETCH(S0) do { const int s_ = (S0) + tt; const GAS bf16_t* cur_ = P.proj + (size_t)(b * SEQ + s_) * NINP + OFF_R; const GAS bf16_t* prv_ = cur_ - NINP; const bool hp_ = s_ > 0; \
        lc = *(const GAS u32x4*)(cur_ + 768 + part * 8); lp = hp_ ? *(const GAS u32x4*)(prv_ + 768 + part * 8) : (u32x4){0u, 0u, 0u, 0u}; \
        rc = *(const GAS u32x2*)(cur_ + h * 64 + part * 4); rp = hp_ ? *(const GAS u32x2*)(prv_ + h * 64 + part * 4) : (u32x2){0u, 0u}; \
        kc = *(const GAS u32x2*)(cur_ + 256 + h * 64 + part * 4); kp = hp_ ? *(const GAS u32x2*)(prv_ + 256 + h * 64 + part * 4) : (u32x2){0u, 0u}; \
        vc = *(const GAS u32x2*)(cur_ + 512 + h * 64 + part * 4); vp = hp_ ? *(const GAS u32x2*)(prv_ + 512 + h * 64 + part * 4) : (u32x2){0u, 0u}; } while (0)
    const int sbeg = sp * (SEQ / 8), send = sbeg + SEQ / 8;
    const __amdgpu_buffer_rsrc_t rs = __builtin_amdgcn_make_buffer_rsrc((float*)ops, 0, 0x10000000, 0x00020000);
    RWKV_FETCH(sbeg);
    __syncthreads();
    for (int s0 = sbeg; s0 < send; s0 += TC2) {
        const u32x4 lc_ = lc, lp_ = lp; const u32x2 rc_ = rc, rp_ = rp, kc_ = kc, kp_ = kp, vc_ = vc, vp_ = vp;
        if (s0 + TC2 < send) RWKV_FETCH(s0 + TC2);
        { const unsigned cc[4] = {lc_.x, lc_.y, lc_.z, lc_.w}, pp[4] = {lp_.x, lp_.y, lp_.z, lp_.w}; float lo[8];
#pragma unroll
          for (int j = 0; j < 4; ++j) { const float c0 = pg8::bflo(cc[j]), c1 = pg8::bfhi(cc[j]);
              lo[2 * j] = c0 + (pg8::bflo(pp[j]) - c0) * MU[192 + part * 8 + 2 * j]; lo[2 * j + 1] = c1 + (pg8::bfhi(pp[j]) - c1) * MU[192 + part * 8 + 2 * j + 1]; }
#pragma unroll
          for (int j = 0; j < 8; ++j) { if (part < 4) lo[j] = tanhf_(lo[j]); else if (part >= 8) lo[j] = sigmoidf_(lo[j]); }
          u32x4 w; w.x = pack_bf16(lo[0], lo[1]); w.y = pack_bf16(lo[2], lo[3]); w.z = pack_bf16(lo[4], lo[5]); w.w = pack_bf16(lo[6], lo[7]);
          *(LAS u32x4*)(LoB + tt * 136 + part * 8) = w; }
        __syncthreads();
        mm_lds(LoB, 136, W2T, 40, TC2, 64, 32, c.wave, c.lane, [&](int row, int col0, const f32x4& a) { *(LAS f32x4*)(WL + row * 64 + col0) = a; });
        mm_lds(LoB + 32, 136, A2T, 40, TC2, 64, 32, c.wave, c.lane, [&](int row, int col0, const f32x4& a) { *(LAS f32x4*)(AL + row * 64 + col0) = a; });
        mm_lds(LoB + 64, 136, G2T, 72, TC2, 64, 64, c.wave, c.lane, [&](int row, int col0, const f32x4& a) { *(LAS f32x4*)(Gl + row * 64 + col0) = a; });
        __syncthreads();
        { float rv[4], kv[4], vv[4], kkr[4], av[4], wl[4], ss = 0.f;
          const float rcu[4] = {pg8::bflo(rc_.x), pg8::bfhi(rc_.x), pg8::bflo(rc_.y), pg8::bfhi(rc_.y)}, rpr[4] = {pg8::bflo(rp_.x), pg8::bfhi(rp_.x), pg8::bflo(rp_.y), pg8::bfhi(rp_.y)};
          const float kcu[4] = {pg8::bflo(kc_.x), pg8::bfhi(kc_.x), pg8::bflo(kc_.y), pg8::bfhi(kc_.y)}, kpr[4] = {pg8::bflo(kp_.x), pg8::bfhi(kp_.x), pg8::bflo(kp_.y), pg8::bfhi(kp_.y)};
          const float vcu[4] = {pg8::bflo(vc_.x), pg8::bfhi(vc_.x), pg8::bflo(vc_.y), pg8::bfhi(vc_.y)}, vpr[4] = {pg8::bflo(vp_.x), pg8::bfhi(vp_.x), pg8::bflo(vp_.y), pg8::bfhi(vp_.y)};
#pragma unroll
          for (int jj = 0; jj < 4; ++jj) { const int j = part * 4 + jj;
              rv[jj] = rcu[jj] + (rpr[jj] - rcu[jj]) * MU[j]; kv[jj] = kcu[jj] + (kpr[jj] - kcu[jj]) * MU[64 + j]; vv[jj] = vcu[jj] + (vpr[jj] - vcu[jj]) * MU[128 + j];
              kkr[jj] = kv[jj] * CH[128 + j]; ss += kkr[jj] * kkr[jj];
              av[jj] = sigmoidf_(CH[64 + j] + AL[tt * 64 + j]); wl[jj] = CH[j] + WL[tt * 64 + j]; }
          ss = red16(ss); const float inv = rsqrtf(fmaxf(ss, 1e-24f));
          f32x4 ld4;
#pragma unroll
          for (int jj = 0; jj < 4; ++jj) ld4[jj] = -0.60653065971f * sigmoidf_(wl[jj]);
          LAS float* DL = (LAS float*)LoB;
          *(LAS f32x4*)(DL + tt * 64 + part * 4) = ld4;
          __syncthreads();
          f32x4 cs = {0.f, 0.f, 0.f, 0.f};
          for (int t = (tt & ~15); t < tt; ++t) cs += *(const LAS f32x4*)(DL + t * 64 + part * 4);
          f32x4 o_d, o_kx, o_kk, o_kb; float bsum = 0.f;
#pragma unroll
          for (int jj = 0; jj < 4; ++jj) { const int j = part * 4 + jj;
              const float dprev = __expf(cs[jj]), dcur = dprev * __expf(ld4[jj]), dinv = rcpf_(dcur);
              const float kk = kkr[jj] * inv; const float kx = kv[jj] * (1.0f + (av[jj] - 1.0f) * CH[192 + j]);
              o_d[jj] = dcur; o_kx[jj] = kx * dinv; o_kk[jj] = kk * dprev; o_kb[jj] = kk * av[jj] * dinv;
              bsum += rv[jj] * kx * CH[256 + j]; rv[jj] *= dcur; }
          bsum = red16(bsum);
          const size_t blk0 = ((size_t)((b * 4 + h) * (SEQ / 16) + (s0 >> 4) + (tt >> 4))) * RWB_CHUNK;
          const unsigned off = (unsigned)((blk0 + (tt & 15) * 64 + part * 4) * 4);
#define RW_ST16(O, V) __builtin_amdgcn_raw_buffer_store_b128(__builtin_bit_cast(u32x4, V), rs, off + (O) * 4, 0, 16)
          const f32x4 o_r = {rv[0], rv[1], rv[2], rv[3]}, o_v = {vv[0], vv[1], vv[2], vv[3]}, o_g = *(const LAS f32x4*)(Gl + tt * 64 + part * 4);
          RW_ST16(0, o_r); RW_ST16(1024, o_d); RW_ST16(2048, o_kx); RW_ST16(3072, o_kk); RW_ST16(4096, o_kb); RW_ST16(5120, o_v); RW_ST16(6144, o_g);
#undef RW_ST16
          if (part == 0) __hip_atomic_store((GAS unsigned*)(ops + blk0 + 7168 + (tt & 15)), __builtin_bit_cast(unsigned, bsum), RLX_AGENT); }
        if (sp == 0) asm volatile("s_waitcnt vmcnt(0)" ::: "memory");
        __syncthreads();
        if (sp == 0 && c.tid == 0) __hip_atomic_store(fl + ((s0 - sbeg) >> 5), epoch, RLX_AGENT);
    }
    if (sp != 0) { asm volatile("s_waitcnt vmcnt(0)" ::: "memory"); __syncthreads(); if (c.tid == 0) __hip_atomic_store(fl + 7 + sp, epoch, RLX_AGENT); }
#undef RWKV_FETCH
}

DI float red8o(float v) { v += dppf<0xB1>(v); asm("" : "+v"(v)); v += dppf<0x4E>(v); asm("" : "+v"(v)); v += dppf<0x141>(v); asm("" : "+v"(v)); return v; }
DI void mix_rwkv_v5(const Ctx& c, const MixP& P, const GAS float* ops, int b, int h, const GAS unsigned* fl, unsigned epoch) {
    constexpr int CT = 16, NCH = SEQ / CT, BUFB = 8 * CT * 64 * 4 + 64;
    LAS float* CH = (LAS float*)c.lds;
    const int L = P.layer;
    if (c.tid < 64) { const int hj = L * 256 + h * 64 + c.tid; CH[c.tid] = P.r_ln_w[hj]; CH[64 + c.tid] = P.r_ln_b[hj]; }
#define RW_BUF(i) ((LAS float*)(c.lds + 512 + ((i) % 3) * BUFB))
    if (c.wave < 4) {
        const int ks = c.lane & 7, srow = c.wave * 16 + 2 * (c.lane >> 3);
        f32x2 Sa[4], Sb[4];
#pragma unroll
        for (int i = 0; i < 4; ++i) { Sa[i] = (f32x2){0.f, 0.f}; Sb[i] = (f32x2){0.f, 0.f}; }
        __syncthreads();
        __builtin_amdgcn_s_setprio(3);
#define RW_LOAD(Q, X) do { const int o_ = (X) * 64 + ks * 8; Q.k0 = *(const LAS f32x4*)(Kk + o_); Q.k1 = *(const LAS f32x4*)(Kk + o_ + 4); Q.v = *(const LAS f32x2*)(Vv + (X) * 64 + srow); \
            _Pragma("unroll") for (int i_ = 0; i_ < 2; ++i_) { Q.x[i_] = *(const LAS f32x4*)(Kx + o_ + 4 * i_); Q.b[i_] = *(const LAS f32x4*)(Kb + o_ + 4 * i_); Q.r[i_] = *(const LAS f32x4*)(Rr + o_ + 4 * i_); } } while (0)
#define RW_DOT(SS, Q, OUT) do { f32x2 p_ = SS[0] * (f32x2){Q.k0[0], Q.k0[1]}; p_ = SS[1] * (f32x2){Q.k0[2], Q.k0[3]} + p_; p_ = SS[2] * (f32x2){Q.k1[0], Q.k1[1]} + p_; p_ = SS[3] * (f32x2){Q.k1[2], Q.k1[3]} + p_; OUT = p_[0] + p_[1]; } while (0)
#define RW_OPQ(V) asm("" : "+v"(V))
#define RW_RS(V, C) do { V += dppf<C>(V); RW_OPQ(V); } while (0)
#define RW_RED4(A, B, C, D) do { RW_RS(A, 0xB1); RW_RS(B, 0xB1); RW_RS(C, 0xB1); RW_RS(D, 0xB1); RW_RS(A, 0x4E); RW_RS(B, 0x4E); RW_RS(C, 0x4E); RW_RS(D, 0x4E); \
            RW_RS(A, 0x141); RW_RS(B, 0x141); RW_RS(C, 0x141); RW_RS(D, 0x141); } while (0)
#define RW_RED2(A, B) do { RW_RS(A, 0xB1); RW_RS(B, 0xB1); RW_RS(A, 0x4E); RW_RS(B, 0x4E); RW_RS(A, 0x141); RW_RS(B, 0x141); } while (0)
#define RW_UPD(SS, VR, SA, Q, YP) do { const f32x2 vr2_ = {VR, VR}, sa2_ = {SA, SA}; f32x2 y_ = {0.f, 0.f}; \
            _Pragma("unroll") for (int i_ = 0; i_ < 2; ++i_) { \
                { const f32x2 t0_ = vr2_ * (f32x2){Q.x[i_][0], Q.x[i_][1]} + SS[2 * i_], t1_ = vr2_ * (f32x2){Q.x[i_][2], Q.x[i_][3]} + SS[2 * i_ + 1];     \
                  SS[2 * i_] = t0_ - sa2_ * (f32x2){Q.b[i_][0], Q.b[i_][1]}; SS[2 * i_ + 1] = t1_ - sa2_ * (f32x2){Q.b[i_][2], Q.b[i_][3]}; } \
                y_ = SS[2 * i_] * (f32x2){Q.r[i_][0], Q.r[i_][1]} + y_; y_ = SS[2 * i_ + 1] * (f32x2){Q.r[i_][2], Q.r[i_][3]} + y_; } \
            YP = y_[0] + y_[1]; } while (0)
#define RW_STEP(Q, X) do { float sa_, sb_; RW_DOT(Sa, Q, sa_); RW_DOT(Sb, Q, sb_); \
            if ((X) > 0) { RW_RED4(sa_, sb_, ypa, ypb); if (ks == 0) *(LAS f32x2*)(Yb + ((X) - 1) * 64 + srow) = (f32x2){ypa, ypb}; } else { RW_RED2(sa_, sb_); } \
            RW_UPD(Sa, Q.v[0], sa_, Q, ypa); RW_UPD(Sb, Q.v[1], sb_, Q, ypb); } while (0)
#define RW_FLUSH() do { RW_RED2(ypa, ypb); if (ks == 0) *(LAS f32x2*)(Yb + (CT - 1) * 64 + srow) = (f32x2){ypa, ypb}; \
            { const f32x4 e0_ = *(const LAS f32x4*)(Dd + (CT - 1) * 64 + ks * 8), e1_ = *(const LAS f32x4*)(Dd + (CT - 1) * 64 + ks * 8 + 4);     \
              Sa[0] *= (f32x2){e0_[0], e0_[1]}; Sa[1] *= (f32x2){e0_[2], e0_[3]}; Sa[2] *= (f32x2){e1_[0], e1_[1]}; Sa[3] *= (f32x2){e1_[2], e1_[3]}; \
              Sb[0] *= (f32x2){e0_[0], e0_[1]}; Sb[1] *= (f32x2){e0_[2], e0_[3]}; Sb[2] *= (f32x2){e1_[0], e1_[1]}; Sb[3] *= (f32x2){e1_[2], e1_[3]}; } } while (0)
#define RW_PAIR(X) do { RW_LOAD(B, (X) + 1); RW_STEP(A, X); if ((X) + 2 < CT) RW_LOAD(A, (X) + 2); RW_STEP(B, (X) + 1); } while (0)
        struct OpsK { f32x4 k0, k1, x[2], b[2], r[2]; f32x2 v; }; OpsK A, B; float ypa = 0.f, ypb = 0.f;
#pragma unroll 1
        for (int ci = 0; ci < NCH; ++ci) {
            LAS float* Rr = RW_BUF(ci); LAS float* Dd = Rr + CT * 64; LAS float* Kx = Dd + CT * 64; LAS float* Kk = Kx + CT * 64; LAS float* Kb = Kk + CT * 64; LAS float* Vv = Kb + CT * 64;
            LAS float* Yb = Vv + 2 * CT * 64;
            RW_LOAD(A, 0);
            RW_PAIR(0); RW_PAIR(2); RW_PAIR(4); RW_PAIR(6);
            RW_PAIR(8); RW_PAIR(10); RW_PAIR(12); RW_PAIR(14); RW_FLUSH();
            __syncthreads();
        }
        __builtin_amdgcn_s_setprio(0);
        __syncthreads();
#undef RW_LOAD
#undef RW_DOT
#undef RW_RED4
#undef RW_RED2
#undef RW_RS
#undef RW_OPQ
#undef RW_UPD
#undef RW_FLUSH
#undef RW_STEP
#undef RW_PAIR
    } else {
        const int pt = c.tid - 256, tt = pt >> 4, part = pt & 15;
        u32x4 g0[7], g1[7]; float gbo0 = 0.f, gbo1 = 0.f;
#define RW_PVLOAD() do { pv = (c.lane < 15) ? __hip_atomic_load((GAS unsigned*)fl + c.lane, RLX_AGENT) : epoch; } while (0)
#define RW_WAIT(CI) do { if ((CI) >= ready) { for (;;) { const unsigned long long m_ = __ballot(pv == epoch); int np_ = (~m_ != 0ull) ? __builtin_ctzll(~m_) : 15; np_ = np_ > 15 ? 15 : np_; \
              ready = __builtin_amdgcn_readfirstlane(np_ <= 8 ? 2 * np_ : 16 * (np_ - 7)); if ((CI) < ready) break; __builtin_amdgcn_s_sleep(1); RW_PVLOAD(); } \
              __builtin_amdgcn_fence(__ATOMIC_ACQUIRE, "agent"); } } while (0)
#define RW_FETCH(G, GBO, CI) do { RW_WAIT(CI); const GAS float* blk_ = rw_block((GAS float*)ops, b, h, (CI)); _Pragma("unroll") for (int i_ = 0; i_ < 7; ++i_) G[i_] = *(const GAS u32x4*)(blk_ + i_ * 1024 + pt * 4); if (pt < 16) GBO = blk_[7168 + pt]; } while (0)
#define RW_STASH(G, GBO, BUF) do { _Pragma("unroll") for (int i_ = 0; i_ < 7; ++i_) *(LAS u32x4*)((BUF) + i_ * 1024 + pt * 4) = G[i_]; if (pt < 16) (BUF)[8 * CT * 64 + pt] = GBO; } while (0)
#define RW_POST(BUF, CI) do { LAS float* Vv = (BUF) + 5 * CT * 64; LAS float* Gg = Vv + CT * 64; LAS float* Yb = Gg + CT * 64; LAS float* Bo = (BUF) + 8 * CT * 64; \
          float yv[4], sm = 0.f; \
          _Pragma("unroll") for (int jj = 0; jj < 4; ++jj) { yv[jj] = Yb[tt * 64 + part * 4 + jj]; sm += yv[jj]; } \
          const float mean = red16(sm) * (1.0f / 64.0f); float q = 0.f; \
          _Pragma("unroll") for (int jj = 0; jj < 4; ++jj) { yv[jj] -= mean; q += yv[jj] * yv[jj]; } \
          const float rs = rsqrtf(red16(q) * (1.0f / 64.0f) + 64e-5f); const float bo = Bo[tt]; float o[4]; \
          _Pragma("unroll") for (int jj = 0; jj < 4; ++jj) { const int j = part * 4 + jj; \
              const float yn = yv[jj] * rs * CH[j] + CH[64 + j]; o[jj] = (yn + bo * Vv[tt * 64 + j]) * Gg[tt * 64 + j]; } \
          u32x2 w; w.x = pack_bf16(o[0], o[1]); w.y = pack_bf16(o[2], o[3]); \
          *(GAS u32x2*)(P.mix + (size_t)(b * SEQ + (CI) * CT + tt) * D + 512 + h * 64 + part * 4) = w; } while (0)
        unsigned pv; int ready = 0;
        RW_PVLOAD(); RW_FETCH(g0, gbo0, 0); RW_STASH(g0, gbo0, RW_BUF(0)); RW_FETCH(g1, gbo1, 1);
        __syncthreads();
        RW_PVLOAD(); RW_FETCH(g0, gbo0, 2);
#pragma unroll 1
        for (int ci = 0; ci < NCH; ci += 2) {
            if (ci + 3 < NCH && ci + 3 >= ready) RW_PVLOAD();
            if (ci > 0) RW_POST(RW_BUF(ci - 1), ci - 1);
            RW_STASH(g1, gbo1, RW_BUF(ci + 1)); if (ci + 3 < NCH) RW_FETCH(g1, gbo1, ci + 3);
            __syncthreads();
            if (ci + 4 < NCH && ci + 4 >= ready) RW_PVLOAD();
            RW_POST(RW_BUF(ci), ci);
            if (ci + 2 < NCH) { RW_STASH(g0, gbo0, RW_BUF(ci + 2)); if (ci + 4 < NCH) RW_FETCH(g0, gbo0, ci + 4); }
            __syncthreads();
        }
        RW_POST(RW_BUF(NCH - 1), NCH - 1);
        __syncthreads();
#undef RW_FETCH
#undef RW_WAIT
#undef RW_PVLOAD
#undef RW_STASH
#undef RW_POST
    }
#undef RW_BUF
}
DI void mix_ssd_v3(const Ctx& c, const MixP& P, int b, int g) {
    constexpr int LD = 72, RL = 264;
    LAS bf16_t* Cm = (LAS bf16_t*)c.lds; LAS bf16_t* Bm = Cm + 64 * LD; LAS bf16_t* BmT = Bm + 64 * LD;
    LAS bf16_t* XT = BmT + 64 * LD;
    LAS bf16_t* Stb = XT + 128 * LD;
    LAS float* Yz = (LAS float*)(c.lds + 64512);
    LAS bf16_t* Wm = (LAS bf16_t*)(c.lds + 97280); LAS bf16_t* XdT = Wm + 64 * LD;
    LAS bf16_t* Wm1 = XdT + 64 * LD; LAS bf16_t* XdT1 = Wm1 + 64 * LD;
    LAS bf16_t* RAW = (LAS bf16_t*)(c.lds + 64512);
    LAS float* Dt = (LAS float*)(c.lds + 134144); LAS float* Ac = Dt + 128;
    LAS float* CW = Ac + 128;
    const int L = P.layer; const int l = c.tid >> 3, part = c.tid & 7;
    f32x4 St0[2] = {{0.f, 0.f, 0.f, 0.f}, {0.f, 0.f, 0.f, 0.f}}, St1[2] = {{0.f, 0.f, 0.f, 0.f}, {0.f, 0.f, 0.f, 0.f}};
    for (int i = c.tid; i < 128 * LD; i += 512) Stb[i] = 0;
    for (int i = c.tid; i < 1280; i += 512) { const int k = i >> 8, ch = i & 255;
        const int xi = (ch < 128) ? (g * 128 + ch) : ((ch < 192) ? (256 + g * 64 + (ch - 128)) : (384 + g * 64 + (ch - 192)));
        CW[i] = (k < 4) ? P.s_conv_w[(L * 4 + k) * 512 + xi] : P.s_conv_b[L * 512 + xi]; }
    const float dsk0 = P.s_d[L * 4 + 2 * g], dsk1 = P.s_d[L * 4 + 2 * g + 1];
    const float dtb = (part < 2) ? P.s_dt_bias[L * 4 + 2 * g + part] : 0.f, aneg = (part < 2) ? -__expf(P.s_a_log[L * 4 + 2 * g + part]) : 0.f;
    u32x4 rx[3], rbm[2], rcm[2]; float dtr = 0.f;
#define SSD_FETCH(S0) do { \
        _Pragma("unroll") for (int i_ = 0; i_ < 3; ++i_) { const int p_ = c.tid + 512 * i_; if (p_ < 1072) { const int r_ = p_ >> 4, c8_ = p_ & 15, s_ = (S0) - 3 + r_; \
            rx[i_] = (s_ >= 0) ? *(const GAS u32x4*)(P.proj + (size_t)(b * SEQ + s_) * NINP + OFF_S + 256 + g * 128 + c8_ * 8) : (u32x4){0u, 0u, 0u, 0u}; } } \
        _Pragma("unroll") for (int i_ = 0; i_ < 2; ++i_) { const int p_ = c.tid + 512 * i_; if (p_ < 536) { const int r_ = p_ >> 3, c8_ = p_ & 7, s_ = (S0) - 3 + r_; \
            const GAS bf16_t* q_ = P.proj + (size_t)(b * SEQ + (s_ >= 0 ? s_ : 0)) * NINP + OFF_S + 512 + g * 64 + c8_ * 8; \
            rbm[i_] = (s_ >= 0) ? *(const GAS u32x4*)q_ : (u32x4){0u, 0u, 0u, 0u}; rcm[i_] = (s_ >= 0) ? *(const GAS u32x4*)(q_ + 128) : (u32x4){0u, 0u, 0u, 0u}; } } \
        if (part < 2) dtr = ldp(P.proj, b * SEQ + (S0) + l, OFF_S + 768 + 2 * g + part); } while (0)
#define SSD_STASH() do { \
        _Pragma("unroll") for (int i_ = 0; i_ < 3; ++i_) { const int p_ = c.tid + 512 * i_; if (p_ < 1072) *(LAS u32x4*)(RAW + (p_ >> 4) * RL + (p_ & 15) * 8) = rx[i_]; } \
        _Pragma("unroll") for (int i_ = 0; i_ < 2; ++i_) { const int p_ = c.tid + 512 * i_; if (p_ < 536) { *(LAS u32x4*)(RAW + (p_ >> 3) * RL + 128 + (p_ & 7) * 8) = rbm[i_]; *(LAS u32x4*)(RAW + (p_ >> 3) * RL + 192 + (p_ & 7) * 8) = rcm[i_]; } } } while (0)
    SSD_FETCH(0);
    __syncthreads();
    for (int s0 = 0; s0 < SEQ; s0 += 64) {
        const int t = b * SEQ + s0 + l;
        SSD_STASH();
        if (part < 2) { const float dt = softplusf_(dtr + dtb); Dt[l * 2 + part] = dt; Ac[l * 2 + part] = aneg * dt; }
        __syncthreads();
        if (s0 + 64 < SEQ) SSD_FETCH(s0 + 64);
#pragma unroll
        for (int gq = 0; gq < 4; ++gq) { const int ch0 = part * 32 + gq * 8; float acc[8];
#pragma unroll
            for (int j = 0; j < 8; ++j) acc[j] = CW[1024 + ch0 + j];
#pragma unroll
            for (int k = 0; k < 4; ++k) { const u32x4 rw = *(const LAS u32x4*)(RAW + (l + k) * RL + ch0); const f32x4 w0 = *(const LAS f32x4*)(CW + k * 256 + ch0), w1 = *(const LAS f32x4*)(CW + k * 256 + ch0 + 4);
                acc[0] += w0[0] * pg8::bflo(rw.x); acc[1] += w0[1] * pg8::bfhi(rw.x); acc[2] += w0[2] * pg8::bflo(rw.y); acc[3] += w0[3] * pg8::bfhi(rw.y);
                acc[4] += w1[0] * pg8::bflo(rw.z); acc[5] += w1[1] * pg8::bfhi(rw.z); acc[6] += w1[2] * pg8::bflo(rw.w); acc[7] += w1[3] * pg8::bfhi(rw.w); }
            bf16_t v[8];
#pragma unroll
            for (int j = 0; j < 8; ++j) v[j] = f2bf(siluf_(acc[j]));
            if (ch0 < 128) {
#pragma unroll
                for (int j = 0; j < 8; ++j) XT[(ch0 + j) * LD + l] = v[j];
            } else { u32x4 w; w.x = (unsigned)v[0] | ((unsigned)v[1] << 16); w.y = (unsigned)v[2] | ((unsigned)v[3] << 16); w.z = (unsigned)v[4] | ((unsigned)v[5] << 16); w.w = (unsigned)v[6] | ((unsigned)v[7] << 16);
                if (ch0 < 192) { *(LAS u32x4*)(Bm + l * LD + ch0 - 128) = w;
#pragma unroll
                    for (int j = 0; j < 8; ++j) BmT[(ch0 - 128 + j) * LD + l] = v[j]; }
                else *(LAS u32x4*)(Cm + l * LD + ch0 - 192) = w; } }
        if (c.wave < 2) { const float v = wave_scan_add(Ac[c.lane * 2 + c.wave], c.lane); Ac[c.lane * 2 + c.wave] = v; }
        __syncthreads();
        { const float alast0 = Ac[63 * 2], alast1 = Ac[63 * 2 + 1];
          mm_lds(Cm, LD, Bm, LD, 64, 64, 64, c.wave, c.lane, [&](int row, int col0, const f32x4& a) {
              const float al0 = Ac[row * 2], al1 = Ac[row * 2 + 1]; f32x4 o0, o1;
#pragma unroll
              for (int j = 0; j < 4; ++j) { const int sidx = col0 + j; const bool in = sidx <= row;
                  o0[j] = in ? a[j] * __expf(al0 - Ac[sidx * 2]) * Dt[sidx * 2] : 0.f; o1[j] = in ? a[j] * __expf(al1 - Ac[sidx * 2 + 1]) * Dt[sidx * 2 + 1] : 0.f; }
              st_bf16x4(Wm + row * LD + col0, o0); st_bf16x4(Wm1 + row * LD + col0, o1); });
#pragma unroll
          for (int w = 0; w < 2; ++w) { const float alast = w ? alast1 : alast0;
              const u32x4 xt = *(const LAS u32x4*)(XT + (w * 64 + l) * LD + part * 8); float f[8];
#pragma unroll
              for (int j = 0; j < 8; ++j) { const int sidx = part * 8 + j; f[j] = Dt[sidx * 2 + w] * __expf(alast - Ac[sidx * 2 + w]); }
              u32x4 o; o.x = pack_bf16(pg8::bflo(xt.x) * f[0], pg8::bfhi(xt.x) * f[1]); o.y = pack_bf16(pg8::bflo(xt.y) * f[2], pg8::bfhi(xt.y) * f[3]);
              o.z = pack_bf16(pg8::bflo(xt.z) * f[4], pg8::bfhi(xt.z) * f[5]); o.w = pack_bf16(pg8::bflo(xt.w) * f[6], pg8::bfhi(xt.w) * f[7]);
              *(LAS u32x4*)((w ? XdT1 : XdT) + l * LD + part * 8) = o; }
          __syncthreads();
#pragma unroll
          for (int w = 0; w < 2; ++w) { const float dsk = w ? dsk1 : dsk0;
              mm_lds2(w ? Wm1 : Wm, LD, XT + w * 64 * LD, LD, 64, Cm, LD, Stb + w * 64 * LD, LD, 64, 64, 64, c.wave, c.lane, [&](int row, int col0, const f32x4& a1, const f32x4& a2) {
                const float e = __expf(Ac[row * 2 + w]); f32x4 o;
#pragma unroll
                for (int j = 0; j < 4; ++j) o[j] = a1[j] + e * a2[j] + dsk * bf2f(XT[(w * 64 + col0 + j) * LD + row]);
                *(LAS f32x4*)(Yz + row * 128 + w * 64 + col0) = o; }); }
          __syncthreads();
          mm_lds_state<2>(XdT, LD, BmT, LD, 4, 64, c.wave, c.lane, St0, __expf(alast0), [&](int row, int col0, const f32x4& a) { st_bf16x4(Stb + row * LD + col0, a); });
          mm_lds_state<2>(XdT1, LD, BmT, LD, 4, 64, c.wave, c.lane, St1, __expf(alast1), [&](int row, int col0, const f32x4& a) { st_bf16x4(Stb + (64 + row) * LD + col0, a); });
        }
        { const GAS bf16_t* zp = P.proj + (size_t)t * NINP + OFF_S + g * 128 + part * 16; const u32x4 z0 = *(const GAS u32x4*)zp, z1 = *(const GAS u32x4*)(zp + 8);
          const unsigned zz[8] = {z0.x, z0.y, z0.z, z0.w, z1.x, z1.y, z1.z, z1.w};
          float yz[16], ss = 0.f;
#pragma unroll
          for (int j = 0; j < 8; ++j) { const float a = Yz[l * 128 + part * 16 + 2 * j] * siluf_(pg8::bflo(zz[j])), bq = Yz[l * 128 + part * 16 + 2 * j + 1] * siluf_(pg8::bfhi(zz[j]));
              yz[2 * j] = a; yz[2 * j + 1] = bq; ss += a * a + bq * bq; }
          ss = red8(ss); const float rs = rsqrtf(ss * (1.0f / 128.0f) + 1e-6f);
          const GAS float* nw = P.s_norm_w + L * 256 + g * 128 + part * 16;
          unsigned ow[8];
#pragma unroll
          for (int j = 0; j < 8; ++j) ow[j] = pack_bf16(yz[2 * j] * rs * nw[2 * j], yz[2 * j + 1] * rs * nw[2 * j + 1]);
          u32x4 o0, o1; o0.x = ow[0]; o0.y = ow[1]; o0.z = ow[2]; o0.w = ow[3]; o1.x = ow[4]; o1.y = ow[5]; o1.z = ow[6]; o1.w = ow[7];
          GAS bf16_t* mp = P.mix + (size_t)t * D + 768 + g * 128 + part * 16; *(GAS u32x4*)mp = o0; *(GAS u32x4*)(mp + 8) = o1; }
        __syncthreads();
    }
}

DI void mix_rglru_v2(const Ctx& c, const MixP& P, int b, int h) {
    constexpr int LD = 72, RL = 136;
    LAS bf16_t* WaT = (LAS bf16_t*)c.lds; LAS bf16_t* WxT = WaT + 64 * LD; LAS bf16_t* XCb = WxT + 64 * LD;
    LAS bf16_t* RAW = XCb + 64 * LD;
    LAS float* XCf = (LAS float*)(c.lds + 45888); LAS float* Av = XCf + 4096; LAS float* Uv = Av + 4096; LAS float* Gt = Uv + 4096;
    LAS float* CH = Gt + 4096;
    const int L = P.layer; const int l = c.tid >> 3, part = c.tid & 7;
    for (int i = c.tid; i < 4096; i += 512) { const int r = i >> 6, j = i & 63;
        WaT[j * LD + r] = f2bf(P.g_w_a[(size_t)(L * 4 + h) * 4096 + i]); WxT[j * LD + r] = f2bf(P.g_w_x[(size_t)(L * 4 + h) * 4096 + i]); }
    if (c.tid < 64) { const int hj = L * 256 + h * 64 + c.tid;
#pragma unroll
        for (int k = 0; k < 4; ++k) CH[k * 64 + c.tid] = P.g_conv_w[(L * 4 + k) * 256 + h * 64 + c.tid];
        CH[256 + c.tid] = P.g_conv_b[hj]; CH[320 + c.tid] = P.g_b_a[hj]; CH[384 + c.tid] = P.g_b_x[hj]; CH[448 + c.tid] = softplusf_(-P.g_lambda[hj]); }
    float hst = 0.f;
    u32x4 rxb[2], rgt[2];
#define RG_FETCH(S0) do { _Pragma("unroll") for (int i_ = 0; i_ < 2; ++i_) { const int p_ = c.tid + 512 * i_; if (p_ < 536) { const int r_ = p_ >> 3, c8_ = p_ & 7, s_ = (S0) - 3 + r_; \
            const GAS bf16_t* q_ = P.proj + (size_t)(b * SEQ + (s_ >= 0 ? s_ : 0)) * NINP + OFF_G + h * 64 + c8_ * 8; \
            rxb[i_] = (s_ >= 0) ? *(const GAS u32x4*)q_ : (u32x4){0u, 0u, 0u, 0u}; rgt[i_] = (s_ >= 0) ? *(const GAS u32x4*)(q_ + 256) : (u32x4){0u, 0u, 0u, 0u}; } } } while (0)
#define RG_STASH() do { _Pragma("unroll") for (int i_ = 0; i_ < 2; ++i_) { const int p_ = c.tid + 512 * i_; if (p_ < 536) { \
            *(LAS u32x4*)(RAW + (p_ >> 3) * RL + (p_ & 7) * 8) = rxb[i_]; *(LAS u32x4*)(RAW + (p_ >> 3) * RL + 64 + (p_ & 7) * 8) = rgt[i_]; } } } while (0)
    RG_FETCH(0);
    __syncthreads();
    for (int s0 = 0; s0 < SEQ; s0 += 64) {
        const int t = b * SEQ + s0 + l;
        RG_STASH();
        __syncthreads();
        if (s0 + 64 < SEQ) RG_FETCH(s0 + 64);
        { const int ch0 = part * 8; float acc[8];
#pragma unroll
          for (int j = 0; j < 8; ++j) acc[j] = CH[256 + ch0 + j];
#pragma unroll
          for (int k = 0; k < 4; ++k) { const u32x4 rw = *(const LAS u32x4*)(RAW + (l + k) * RL + ch0); const f32x4 w0 = *(const LAS f32x4*)(CH + k * 64 + ch0), w1 = *(const LAS f32x4*)(CH + k * 64 + ch0 + 4);
              acc[0] += w0[0] * pg8::bflo(rw.x); acc[1] += w0[1] * pg8::bfhi(rw.x); acc[2] += w0[2] * pg8::bflo(rw.y); acc[3] += w0[3] * pg8::bfhi(rw.y);
              acc[4] += w1[0] * pg8::bflo(rw.z); acc[5] += w1[1] * pg8::bfhi(rw.z); acc[6] += w1[2] * pg8::bflo(rw.w); acc[7] += w1[3] * pg8::bfhi(rw.w); }
          u32x4 w; w.x = pack_bf16(acc[0], acc[1]); w.y = pack_bf16(acc[2], acc[3]); w.z = pack_bf16(acc[4], acc[5]); w.w = pack_bf16(acc[6], acc[7]);
          *(LAS u32x4*)(XCb + l * LD + ch0) = w;
          *(LAS f32x4*)(XCf + l * 64 + ch0) = (f32x4){acc[0], acc[1], acc[2], acc[3]}; *(LAS f32x4*)(XCf + l * 64 + ch0 + 4) = (f32x4){acc[4], acc[5], acc[6], acc[7]};
          const u32x4 gw = *(const LAS u32x4*)(RAW + (l + 3) * RL + 64 + ch0);
          *(LAS f32x4*)(Gt + l * 64 + ch0) = (f32x4){gelu_tanhf_(pg8::bflo(gw.x)), gelu_tanhf_(pg8::bfhi(gw.x)), gelu_tanhf_(pg8::bflo(gw.y)), gelu_tanhf_(pg8::bfhi(gw.y))};
          *(LAS f32x4*)(Gt + l * 64 + ch0 + 4) = (f32x4){gelu_tanhf_(pg8::bflo(gw.z)), gelu_tanhf_(pg8::bfhi(gw.z)), gelu_tanhf_(pg8::bflo(gw.w)), gelu_tanhf_(pg8::bfhi(gw.w))}; }
        __syncthreads();
        mm_lds2(XCb, LD, WaT, LD, 64, XCb, LD, WxT, LD, 64, 64, 64, c.wave, c.lane, [&](int row, int col0, const f32x4& a1, const f32x4& a2) {
            const f32x4 xc = *(const LAS f32x4*)(XCf + row * 64 + col0); f32x4 av, uv;
#pragma unroll
            for (int j = 0; j < 4; ++j) { const int ch = col0 + j; const float r = sigmoidf_(a1[j] + CH[320 + ch]), ig = sigmoidf_(a2[j] + CH[384 + ch]);
                const float la = -8.0f * CH[448 + ch] * r; av[j] = __expf(la); uv[j] = sqrtf(fmaxf(1.0f - __expf(2.0f * la), 0.f)) * (ig * xc[j]); }
            *(LAS f32x4*)(Av + row * 64 + col0) = av; *(LAS f32x4*)(Uv + row * 64 + col0) = uv; });
        __syncthreads();
        if (c.wave == 0) {
#pragma unroll 1
            for (int x0 = 0; x0 < 64; x0 += 8) { float a[8], u[8];
#pragma unroll
                for (int j = 0; j < 8; ++j) { a[j] = Av[(x0 + j) * 64 + c.lane]; u[j] = Uv[(x0 + j) * 64 + c.lane]; }
#pragma unroll
                for (int j = 0; j < 8; ++j) { hst = a[j] * hst + u[j]; Uv[(x0 + j) * 64 + c.lane] = hst; } }
        }
        __syncthreads();
        { const f32x4 h0 = *(const LAS f32x4*)(Uv + l * 64 + part * 8) * *(const LAS f32x4*)(Gt + l * 64 + part * 8), h1 = *(const LAS f32x4*)(Uv + l * 64 + part * 8 + 4) * *(const LAS f32x4*)(Gt + l * 64 + part * 8 + 4);
          u32x4 o; o.x = pack_bf16(h0[0], h0[1]); o.y = pack_bf16(h0[2], h0[3]); o.z = pack_bf16(h1[0], h1[1]); o.w = pack_bf16(h1[2], h1[3]);
          *(GAS u32x4*)(P.mix + (size_t)t * D + 256 + h * 64 + part * 8) = o; }
        __syncthreads();
    }
}
constexpr size_t al256(size_t x) { return (x + 255) & ~(size_t)255; }
constexpr size_t WS_CTL = 0;
constexpr size_t CTL_BYTES = 65536;
constexpr int CW_BAR = 0;
constexpr int CW_CNT = 4096;
constexpr int CW_CUR = 4096 + 128;
constexpr int CW_Q = 4096 + 256;
constexpr int CW_RDY = 8192;
constexpr size_t SZ_WIN = (size_t)NINP * D * 2, SZ_WOUT = (size_t)D * D * 2, SZ_WPE = (size_t)D * PE_DIM * 2, SZ_WG = (size_t)D * D * 2;
constexpr size_t SZ_W13 = (size_t)NH2 * D * 2, SZ_W2 = (size_t)D * DFF * 2;
constexpr size_t WS_WIN = WS_CTL + CTL_BYTES, WS_WOUT = WS_WIN + SZ_WIN, WS_WPE = WS_WOUT + SZ_WOUT, WS_WG = WS_WPE + SZ_WPE, WS_W13 = WS_WG + SZ_WG, WS_W2 = WS_W13 + NE * SZ_W13;
constexpr size_t WS_XB = WS_W2 + NE * SZ_W2;
constexpr size_t WS_PB = WS_XB + (size_t)T * D * 2;
constexpr size_t WS_PE = WS_PB + (size_t)T * PE_DIM * 2;
constexpr size_t WS_H = WS_PE + (size_t)T * D * 2;
constexpr size_t SZ_PROJ = (size_t)T * NINP * 2, SZ_HMOE = (size_t)MOE_ROWS * DFF * 2;
constexpr size_t WS_MIX = WS_H + SZ_PROJ;
constexpr size_t WS_XG = WS_H + SZ_HMOE;
constexpr size_t WS_ROUTE = WS_XG + (size_t)MOE_ROWS * D * 2;
constexpr size_t WS_RWOPS = WS_XG;
constexpr size_t WS_PRE1 = WS_H;
constexpr size_t WS_PRE2 = WS_XG;
constexpr size_t WS_XB8 = WS_XG + (size_t)T * D * 2;
constexpr size_t WS_NEED = WS_RWOPS + (size_t)T * 4 * 8 * 64 * 4;
constexpr size_t WS_END = WS_ROUTE + (size_t)T * 32;
static_assert(SZ_PROJ + (size_t)T * D * 2 <= SZ_HMOE, "proj + mix inside the hidden region");
constexpr int LDS_BYTES = 147456;
constexpr int LDS_MISC = 146432;

#ifndef PHMASK
#define PHMASK 0x1FF
#endif
#define PHEN(k) ((PHMASK >> (k)) & 1)

#ifndef PHMASK
#define PHMASK 0x1FF
#endif
#define PHEN(k) ((PHMASK >> (k)) & 1)
struct Args { const float* in[45]; float* out; unsigned char* ws; int ph_lo, ph_hi; };
constexpr int NPH = 9;
constexpr int LDS_ARGS = LDS_MISC + 64;
#ifndef MOE_FP8
#define MOE_FP8 1
#endif
#ifndef DENSE_FP8
#define DENSE_FP8 0
#endif
#ifndef DENSE_FP8_DOWN
#define DENSE_FP8_DOWN 1
#endif
constexpr int MOE_EARLY = 4;
constexpr size_t MOE13_OFF = 4 * SZ_W13, MOE2_OFF = 4 * SZ_W2;
static_assert(MOE_FP8 == 1, "the early expert conversion needs the one-byte expert weights (two sets do not fit otherwise)");
constexpr float W13_SCALE = 64.0f, W2_SCALE = 256.0f;
#define PHASE_FN static __device__ __forceinline__ void
typedef const volatile LAS Args* LArgs;
DI Ctx make_ctx() { Ctx c; c.lds = (LAS unsigned char*)0; int t = threadIdx.x; asm volatile("" : "+v"(t)); int g = gridDim.x, b = blockIdx.x; asm volatile("" : "+s"(g), "+s"(b));
    c.tid = t; c.lane = t & 63; c.wave = __builtin_amdgcn_readfirstlane(t >> 6); c.G = g; c.bid = b; return c; }
DI const float* inp(LArgs a, int i) { return (const float*)rfl64((unsigned long long)a->in[i]); }
DI unsigned char* wsp(LArgs a) { return (unsigned char*)rfl64((unsigned long long)a->ws); }
DI float* outp(LArgs a) { return (float*)rfl64((unsigned long long)a->out); }

PHASE_FN ph_cvt_in(int L) {
    const Ctx c = make_ctx(); LArgs a = (LArgs)(LDS_ARGS); unsigned char* ws = wsp(a);
    int rot = 0;
    cvt_weight(c, inp(a, 2) + (size_t)L * D * NIN, (bf16_t*)(ws + WS_WIN), D, NIN, 0, 1, 0, 0, rot);
    cvt_weight(c, inp(a, 42) + (size_t)L * PE_DIM * D, (bf16_t*)(ws + WS_WPE), PE_DIM, D, 0, 1, 0, 0, rot);
    cvt_act(c, inp(a, 1) + (size_t)L * T * PE_DIM, (bf16_t*)(ws + WS_PB), (size_t)T * PE_DIM);
    if (L == 0) cvt_act(c, inp(a, 0), (bf16_t*)(ws + WS_XB), (size_t)T * D);
}
PHASE_FN ph_cvt_queue(int L) {
    const Ctx c = make_ctx(); LArgs a = (LArgs)(LDS_ARGS); unsigned char* ws = wsp(a);
    const bool moe = (L & 1) != 0; const int fi = L >> 1;
    unsigned* q = (unsigned*)(ws + WS_CTL) + CW_Q + 64 * L;
    volatile LAS int* slot = (volatile LAS int*)(c.lds + 67584);
    const int own = moe ? 3 * 704 * (NE - MOE_EARLY) : 3 * 704, total = 576 + own + (moe ? 0 : 3 * 704 * MOE_EARLY);
    struct TileD { const float* s; bf16_t* d; int K, N, mode, k0, n0; float wsc; };
    auto desc = [&](int idx, TileD& t) -> bool {
        if (idx >= total || (idx >= 256 && idx < 320)) return false;
        if (idx < 256) { t.s = inp(a, 30) + (size_t)L * D * D; t.d = (bf16_t*)(ws + WS_WOUT); t.K = D; t.N = D; t.mode = 0; t.wsc = 0.f; t.k0 = (idx >> 4) << 6; t.n0 = (idx & 15) << 6; }
        else if (idx < 576) { const int r = idx - 320; t.s = inp(a, 43) + (size_t)L * D * D; t.d = (bf16_t*)(ws + WS_WG); t.K = D; t.N = D; t.mode = 0; t.wsc = 0.f; t.k0 = (r >> 4) << 6; t.n0 = (r & 15) << 6; }
        else { int r = idx - 576; bool mt = moe; int eo = moe ? MOE_EARLY : 0, nbx = moe ? NE - MOE_EARLY : 1;
            if (!moe && r >= own) { r -= own; mt = true; eo = 0; nbx = MOE_EARLY; }
            const int ffn = 704 * nbx; const int which = r / ffn; r -= which * ffn; const int el = r / 704; r -= el * 704; const int e = eo + el;
            const float* src = inp(a, (mt ? 39 : 35) + which) + (size_t)((mt ? fi * NE : fi) + e) * D * DFF;
            if (which < 2) { t.s = src; t.K = D; t.N = DFF; t.mode = 1 + which; t.k0 = (r / 44) << 6; t.n0 = (r % 44) << 6;
                if (mt) { t.d = (bf16_t*)(ws + WS_W13 + MOE13_OFF + (size_t)e * NH2 * D); t.wsc = W13_SCALE; }
                else if (DENSE_FP8) { t.d = (bf16_t*)(ws + WS_W13); t.wsc = W13_SCALE; } else { t.d = (bf16_t*)(ws + WS_W13); t.wsc = 0.f; } }
            else { t.s = src; t.K = DFF; t.N = D; t.mode = 0; t.k0 = (r >> 4) << 6; t.n0 = (r & 15) << 6;
                if (mt) { t.d = (bf16_t*)(ws + WS_W2 + MOE2_OFF + (size_t)e * D * DFF); t.wsc = W2_SCALE; }
                else if (DENSE_FP8 || DENSE_FP8_DOWN) { t.d = (bf16_t*)(ws + WS_W2); t.wsc = W2_SCALE; } else { t.d = (bf16_t*)(ws + WS_W2); t.wsc = 0.f; } } }
        return true; };
    constexpr int NQ = 4;
    auto loadq = [&](const TileD& t, float (&r)[NQ][8]) {
#pragma unroll
        for (int qd = 0; qd < NQ; ++qd) {
#pragma unroll
            for (int i = 0; i < 8; ++i) r[qd][i] = t.s[(size_t)(t.k0 + i * 8 + (c.tid >> 6)) * t.N + t.n0 + 64 * qd + (c.tid & 63)]; } };
    LAS float* tiles = (LAS float*)c.lds;
    auto stageq = [&](const float (&r)[NQ][8]) {
#pragma unroll
        for (int qd = 0; qd < NQ; ++qd) {
#pragma unroll
            for (int j = 0; j < 8; ++j) tiles[qd * (64 * 65) + (j * 8 + (c.tid >> 6)) * 65 + (c.tid & 63)] = r[qd][j]; } };
    auto emitq = [&](const TileD& cur) {
#pragma unroll
        for (int qd = 0; qd < NQ; ++qd) { const LAS float* tile = tiles + qd * (64 * 65);
            const int n = c.tid >> 3, kk = (c.tid & 7) * 8, ng = cur.n0 + 64 * qd + n;
            int drow = ng; if (cur.mode == 1) drow = (ng >> 7) * 256 + (ng & 127); else if (cur.mode == 2) drow = (ng >> 7) * 256 + 128 + (ng & 127);
            if (cur.wsc == 0.f) { u32x4 w; w.x = pack_bf16(tile[(kk + 0) * 65 + n], tile[(kk + 1) * 65 + n]); w.y = pack_bf16(tile[(kk + 2) * 65 + n], tile[(kk + 3) * 65 + n]);
                w.z = pack_bf16(tile[(kk + 4) * 65 + n], tile[(kk + 5) * 65 + n]); w.w = pack_bf16(tile[(kk + 6) * 65 + n], tile[(kk + 7) * 65 + n]);
                *(u32x4*)(cur.d + (size_t)drow * cur.K + cur.k0 + kk) = w; }
            else { const float s_ = cur.wsc; u32x2 w8;
                w8.x = pg8::pk4_fp8(tile[(kk + 0) * 65 + n] * s_, tile[(kk + 1) * 65 + n] * s_, tile[(kk + 2) * 65 + n] * s_, tile[(kk + 3) * 65 + n] * s_);
                w8.y = pg8::pk4_fp8(tile[(kk + 4) * 65 + n] * s_, tile[(kk + 5) * 65 + n] * s_, tile[(kk + 6) * 65 + n] * s_, tile[(kk + 7) * 65 + n] * s_);
                *(u32x2*)((unsigned char*)cur.d + (size_t)drow * cur.K + cur.k0 + kk) = w8; } } };
    if (c.tid == 0) slot[0] = (int)atomicAdd(q, 8u);
    __syncthreads();
    int base = slot[0], pi = 0;
    __syncthreads();
    TileD cq, nq; float r[NQ][8];
    bool hq = desc(base, cq);
    if (hq) loadq(cq, r);
#pragma unroll 1
    while (base < total) {
        if (hq) stageq(r);
        const bool last = (pi == 1);
        if (last && c.tid == 0) slot[0] = (int)atomicAdd(q, 8u);
        __syncthreads();
        const int nbase = last ? slot[0] : base, npi = last ? 0 : pi + 1;
        const bool gq = desc(nbase + NQ * npi, nq);
        if (gq) loadq(nq, r);
        if (hq) emitq(cq);
        __syncthreads();
        cq = nq; hq = gq; base = nbase; pi = npi;
    }
}
PHASE_FN ph_proj(int L) {
    const Ctx c = make_ctx(); LArgs a = (LArgs)(LDS_ARGS); unsigned char* ws = wsp(a);
    pg8::Gemm g{(bf16_t*)(ws + WS_XB), (bf16_t*)(ws + WS_WIN), T, NINP, D}; pg8::StaticOrder S; S.init(T, NINP, c.G, c.bid);
    pg8::EpiBf16 E{(bf16_t*)(ws + WS_H), NINP};
    pg8::gemm_phase<pg8::EpiBf16, pg8::StaticOrder, false>(c.lds, g, S, E, nullptr);
}
DI MixP make_mixp(LArgs a, int L) {
    unsigned char* ws = wsp(a);
    MixP P; P.proj = (const GAS bf16_t*)(ws + WS_H); P.mix = (GAS bf16_t*)(ws + WS_MIX); P.layer = L;
    P.m_i_bias = (const GAS float*)inp(a, 3); P.m_f_bias = (const GAS float*)inp(a, 4); P.m_norm_w = (const GAS float*)inp(a, 5);
    P.g_conv_w = (const GAS float*)inp(a, 6); P.g_conv_b = (const GAS float*)inp(a, 7); P.g_w_a = (const GAS float*)inp(a, 8); P.g_b_a = (const GAS float*)inp(a, 9); P.g_w_x = (const GAS float*)inp(a, 10); P.g_b_x = (const GAS float*)inp(a, 11); P.g_lambda = (const GAS float*)inp(a, 12);
    P.r_mu = (const GAS float*)inp(a, 13); P.r_w0 = (const GAS float*)inp(a, 14); P.r_w2 = (const GAS float*)inp(a, 15); P.r_a0 = (const GAS float*)inp(a, 16); P.r_a2 = (const GAS float*)inp(a, 17); P.r_g2 = (const GAS float*)inp(a, 18); P.r_k_k = (const GAS float*)inp(a, 19); P.r_k_a = (const GAS float*)inp(a, 20);
    P.r_r_k = (const GAS float*)inp(a, 21); P.r_ln_w = (const GAS float*)inp(a, 22); P.r_ln_b = (const GAS float*)inp(a, 23);
    P.s_conv_w = (const GAS float*)inp(a, 24); P.s_conv_b = (const GAS float*)inp(a, 25); P.s_dt_bias = (const GAS float*)inp(a, 26); P.s_a_log = (const GAS float*)inp(a, 27); P.s_d = (const GAS float*)inp(a, 28); P.s_norm_w = (const GAS float*)inp(a, 29);
    return P;
}
PHASE_FN ph_mix_rwkv(int L, int b, int h) { const Ctx c = make_ctx(); LArgs a = (LArgs)(LDS_ARGS); const MixP P = make_mixp(a, L); unsigned char* ws = wsp(a);
    GAS unsigned* fl = (GAS unsigned*)(ws + WS_CTL) + CW_RDY + (b * 4 + h) * 16;
    rwkv_prep(c, P, (GAS float*)(ws + WS_RWOPS), b, h, 0, fl, (unsigned)(L + 1)); __syncthreads();
    mix_rwkv_v5(c, P, (const GAS float*)(ws + WS_RWOPS), b, h, (const GAS unsigned*)fl, (unsigned)(L + 1)); }
PHASE_FN ph_rwkv_prep(int L, int b, int h, int sp) { const Ctx c = make_ctx(); LArgs a = (LArgs)(LDS_ARGS); const MixP P = make_mixp(a, L); unsigned char* ws = wsp(a);
    rwkv_prep(c, P, (GAS float*)(ws + WS_RWOPS), b, h, sp, (GAS unsigned*)(ws + WS_CTL) + CW_RDY + (b * 4 + h) * 16, (unsigned)(L + 1)); }
PHASE_FN ph_mix_mlstm(int L, int b, int h) { const Ctx c = make_ctx(); const MixP P = make_mixp((LArgs)(LDS_ARGS), L); mix_mlstm_v2(c, P, b, h); }
PHASE_FN ph_mix_rglru(int L, int b, int h) { const Ctx c = make_ctx(); const MixP P = make_mixp((LArgs)(LDS_ARGS), L); mix_rglru_v2(c, P, b, h); }
PHASE_FN ph_mix_ssd(int L, int b, int g) { const Ctx c = make_ctx(); const MixP P = make_mixp((LArgs)(LDS_ARGS), L); mix_ssd_v3(c, P, b, g); }
PHASE_FN ph_outproj(int L) {
    const Ctx c = make_ctx(); LArgs a = (LArgs)(LDS_ARGS); unsigned char* ws = wsp(a); float* X = outp(a);
    pg8::Gemm g{(bf16_t*)(ws + WS_MIX), (bf16_t*)(ws + WS_WOUT), T, D, D}; pg8::StaticOrder S; S.init(T, D, c.G, c.bid);
    if (L == 0) { pg8::EpiPreLn<0, false> E{(bf16_t*)(ws + WS_PRE1), inp(a, 0), nullptr, D, ALPHA}; pg8::gemm_phase<pg8::EpiPreLn<0, false>, pg8::StaticOrder, false>(c.lds, g, S, E, nullptr); }
    else { pg8::EpiPreLn<1, false> E{(bf16_t*)(ws + WS_PRE1), (bf16_t*)(ws + WS_XB), nullptr, D, ALPHA}; pg8::gemm_phase<pg8::EpiPreLn<1, false>, pg8::StaticOrder, false>(c.lds, g, S, E, nullptr); }
}
PHASE_FN ph_ln1(int L) {
    const Ctx c = make_ctx(); LArgs a = (LArgs)(LDS_ARGS); unsigned char* ws = wsp(a); float* X = outp(a);
    const bool moe = (L & 1) != 0; const int fi = L >> 1; unsigned* ctl = (unsigned*)(ws + WS_CTL);
    if (moe) ln_phase<false, true, false>(c, X, (bf16_t*)(ws + WS_PRE1), (bf16_t*)(ws + WS_XB), nullptr, inp(a, 31) + L * D, inp(a, 32) + L * D, nullptr, nullptr, (Route*)(ws + WS_ROUTE), inp(a, 38) + (size_t)fi * D * NE, ctl + CW_CNT + 64 * fi);
    else ln_phase<false, false, false>(c, X, (bf16_t*)(ws + WS_PRE1), (bf16_t*)(ws + WS_XB), DENSE_FP8 ? ws + WS_XB8 : nullptr, inp(a, 31) + L * D, inp(a, 32) + L * D, nullptr, nullptr, nullptr, nullptr, nullptr);
}
PHASE_FN ph_gate(int L) {
    const Ctx c = make_ctx(); LArgs a = (LArgs)(LDS_ARGS); unsigned char* ws = wsp(a);
    pg8::Gemm g{(bf16_t*)(ws + WS_XB), (bf16_t*)(ws + WS_WG), T, D, D}; pg8::StaticOrder S; S.init(T, D, c.G, c.bid);
    pg8::EpiGate E{(bf16_t*)(ws + WS_PE), D, inp(a, 44) + L * D};
    pg8::gemm_phase<pg8::EpiGate, pg8::StaticOrder, false>(c.lds, g, S, E, nullptr);
}
PHASE_FN ph_pe(int L) {
    const Ctx c = make_ctx(); LArgs a = (LArgs)(LDS_ARGS); unsigned char* ws = wsp(a);
    pg8::Gemm g{(bf16_t*)(ws + WS_PB), (bf16_t*)(ws + WS_WPE), T, D, PE_DIM}; pg8::StaticOrder S; S.init(T, D, c.G, c.bid);
    pg8::EpiPeMul E{(bf16_t*)(ws + WS_PE), D};
    pg8::gemm_phase<pg8::EpiPeMul, pg8::StaticOrder, false>(c.lds, g, S, E, nullptr);
}
PHASE_FN ph_pe_raw(int L, int first, int stride) {
    const Ctx c = make_ctx(); LArgs a = (LArgs)(LDS_ARGS); unsigned char* ws = wsp(a);
    pg8::Gemm g{(bf16_t*)(ws + WS_PB), (bf16_t*)(ws + WS_WPE), T, D, PE_DIM}; pg8::ListOrder S; S.init(first, stride, (T / 256) * (D / 256), D / 256);
    pg8::EpiBf16 E{(bf16_t*)(ws + WS_PE), D};
    pg8::gemm_phase<pg8::EpiBf16, pg8::ListOrder, false>(c.lds, g, S, E, nullptr);
}
PHASE_FN ph_gate_mul(int L, int first, int stride) {
    const Ctx c = make_ctx(); LArgs a = (LArgs)(LDS_ARGS); unsigned char* ws = wsp(a);
    pg8::Gemm g{(bf16_t*)(ws + WS_XB), (bf16_t*)(ws + WS_WG), T, D, D}; pg8::ListOrder S; S.init(first, stride, (T / 256) * (D / 256), D / 256);
    pg8::EpiGateMul E{(bf16_t*)(ws + WS_PE), D, inp(a, 44) + L * D};
    pg8::gemm_phase<pg8::EpiGateMul, pg8::ListOrder, false>(c.lds, g, S, E, nullptr);
}
PHASE_FN ph_gate_mul_moe(int L) {
    const Ctx c = make_ctx(); LArgs a = (LArgs)(LDS_ARGS); unsigned char* ws = wsp(a); const int fi = L >> 1; const unsigned* counts = (const unsigned*)(ws + WS_CTL) + CW_CNT + 64 * fi;
    int nt = 0;
#pragma unroll
    for (int e = 0; e < NE; ++e) nt += __builtin_amdgcn_readfirstlane(((int)counts[e] + 255) >> 8);
    const int nwg = nt * (D / 256), rem = nwg % c.G, fast = c.G - rem;
    const int first = (c.bid >= rem) ? c.bid - rem : -1;
    pg8::Gemm g{(bf16_t*)(ws + WS_XB), (bf16_t*)(ws + WS_WG), T, D, D}; pg8::ListOrder S; S.init(first, fast, (T / 256) * (D / 256), D / 256);
    pg8::EpiGateMul E{(bf16_t*)(ws + WS_PE), D, inp(a, 44) + L * D};
    pg8::gemm_phase<pg8::EpiGateMul, pg8::ListOrder, false>(c.lds, g, S, E, nullptr);
}
PHASE_FN ph_cvt_pe(int L) {
    const Ctx c = make_ctx(); LArgs a = (LArgs)(LDS_ARGS); unsigned char* ws = wsp(a);
    int rot = 0;
    cvt_weight(c, inp(a, 42) + (size_t)L * PE_DIM * D, (bf16_t*)(ws + WS_WPE), PE_DIM, D, 0, 1, 0, 0, rot);
}
PHASE_FN ph_gather(int L) {
    const Ctx c = make_ctx(); LArgs a = (LArgs)(LDS_ARGS); unsigned char* ws = wsp(a); const int fi = L >> 1; unsigned* ctl = (unsigned*)(ws + WS_CTL);
    moe_assign_gather(c, (Route*)(ws + WS_ROUTE), ctl + CW_CNT + 64 * fi, ctl + CW_CUR + 64 * fi, (bf16_t*)(ws + WS_XB), (bf16_t*)(ws + WS_XG));
}
PHASE_FN ph_up_dense(int L) {
    const Ctx c = make_ctx(); LArgs a = (LArgs)(LDS_ARGS); unsigned char* ws = wsp(a);
#if DENSE_FP8
    pg8::Gemm g{(bf16_t*)(ws + WS_XB8), (bf16_t*)(ws + WS_W13), T, NH2, D / 2}; pg8::StaticOrder S; S.init(T, NH2, c.G, c.bid);
    pg8::EpiSwiglu8 E{ws + WS_H, DFF, 1.0f / W13_SCALE};
    pg8::gemm_phase<pg8::EpiSwiglu8, pg8::StaticOrder, false>(c.lds, g, S, E, nullptr);
#elif DENSE_FP8_DOWN
    pg8::Gemm g{(bf16_t*)(ws + WS_XB), (bf16_t*)(ws + WS_W13), T, NH2, D}; pg8::StaticOrder S; S.init(T, NH2, c.G, c.bid);
    pg8::EpiSwiglu8T<false> E{ws + WS_H, DFF, 1.0f};
    pg8::gemm_phase<pg8::EpiSwiglu8T<false>, pg8::StaticOrder, false>(c.lds, g, S, E, nullptr);
#else
    pg8::Gemm g{(bf16_t*)(ws + WS_XB), (bf16_t*)(ws + WS_W13), T, NH2, D}; pg8::StaticOrder S; S.init(T, NH2, c.G, c.bid);
    pg8::EpiSwiglu E{(bf16_t*)(ws + WS_H), DFF};
    pg8::gemm_phase<pg8::EpiSwiglu, pg8::StaticOrder, false>(c.lds, g, S, E, nullptr);
#endif
}
PHASE_FN ph_up_moe(int L) {
    const Ctx c = make_ctx(); LArgs a = (LArgs)(LDS_ARGS); unsigned char* ws = wsp(a); const int fi = L >> 1; unsigned* ctl = (unsigned*)(ws + WS_CTL);
#if MOE_FP8
    pg8::Gemm g{(bf16_t*)(ws + WS_XG), (bf16_t*)(ws + WS_W13 + MOE13_OFF), MOE_ROWS, NH2, D / 2}; pg8::MoeOrder S; S.init_moe(ctl + CW_CNT + 64 * fi, NH2 / 256, c.G, c.bid, (size_t)NH2 * D);
    pg8::EpiSwiglu8 E{ws + WS_H, DFF, 1.0f / W13_SCALE};
    pg8::gemm_phase<pg8::EpiSwiglu8, pg8::MoeOrder, false>(c.lds, g, S, E, nullptr);
#else
    pg8::Gemm g{(bf16_t*)(ws + WS_XG), (bf16_t*)(ws + WS_W13), MOE_ROWS, NH2, D}; pg8::MoeOrder S; S.init_moe(ctl + CW_CNT + 64 * fi, NH2 / 256, c.G, c.bid, SZ_W13);
    pg8::EpiSwiglu E{(bf16_t*)(ws + WS_H), DFF};
    pg8::gemm_phase<pg8::EpiSwiglu, pg8::MoeOrder, false>(c.lds, g, S, E, nullptr);
#endif
}
PHASE_FN ph_down_dense(int L) {
    const Ctx c = make_ctx(); LArgs a = (LArgs)(LDS_ARGS); unsigned char* ws = wsp(a); float* X = outp(a);
#if DENSE_FP8 || DENSE_FP8_DOWN
    pg8::Gemm g{(bf16_t*)(ws + WS_H), (bf16_t*)(ws + WS_W2), T, D, DFF / 2}; pg8::StaticOrder S; S.init(T, D, c.G, c.bid);
    pg8::EpiPreLn<1, true, true> E{(bf16_t*)(ws + WS_PRE2), (bf16_t*)(ws + WS_XB), (bf16_t*)(ws + WS_PE), D, ALPHA, 1.0f / W2_SCALE};
    pg8::gemm_phase<pg8::EpiPreLn<1, true, true>, pg8::StaticOrder, false>(c.lds, g, S, E, nullptr);
#else
    pg8::Gemm g{(bf16_t*)(ws + WS_H), (bf16_t*)(ws + WS_W2), T, D, DFF}; pg8::StaticOrder S; S.init(T, D, c.G, c.bid);
    pg8::EpiPreLn<1, true> E{(bf16_t*)(ws + WS_PRE2), (bf16_t*)(ws + WS_XB), (bf16_t*)(ws + WS_PE), D, ALPHA};
    pg8::gemm_phase<pg8::EpiPreLn<1, true>, pg8::StaticOrder, false>(c.lds, g, S, E, nullptr);
#endif
}
PHASE_FN ph_down_moe(int L) {
    const Ctx c = make_ctx(); LArgs a = (LArgs)(LDS_ARGS); unsigned char* ws = wsp(a); const int fi = L >> 1; unsigned* ctl = (unsigned*)(ws + WS_CTL);
#if MOE_FP8
    pg8::Gemm g{(bf16_t*)(ws + WS_H), (bf16_t*)(ws + WS_W2 + MOE2_OFF), MOE_ROWS, D, DFF / 2}; pg8::MoeOrder S; S.init_moe(ctl + CW_CNT + 64 * fi, D / 256, c.G, c.bid, (size_t)D * DFF);
    pg8::EpiBf16S8 E{(bf16_t*)(ws + WS_XG), D, 1.0f / W2_SCALE};
    pg8::gemm_phase<pg8::EpiBf16S8, pg8::MoeOrder, false>(c.lds, g, S, E, nullptr);
#else
    pg8::Gemm g{(bf16_t*)(ws + WS_H), (bf16_t*)(ws + WS_W2), MOE_ROWS, D, DFF}; pg8::MoeOrder S; S.init_moe(ctl + CW_CNT + 64 * fi, D / 256, c.G, c.bid, SZ_W2);
    pg8::EpiBf16 E{(bf16_t*)(ws + WS_XG), D};
    pg8::gemm_phase<pg8::EpiBf16, pg8::MoeOrder, false>(c.lds, g, S, E, nullptr);
#endif
}
PHASE_FN ph_ln2(int L) {
    const Ctx c = make_ctx(); LArgs a = (LArgs)(LDS_ARGS); unsigned char* ws = wsp(a); float* X = outp(a);
    const bool moe = (L & 1) != 0;
    if (moe) { if (L == DEPTH - 1) ln_phase<true, false, true>(c, X, nullptr, (bf16_t*)(ws + WS_XB), nullptr, inp(a, 33) + L * D, inp(a, 34) + L * D, (bf16_t*)(ws + WS_XG), (bf16_t*)(ws + WS_PE), (Route*)(ws + WS_ROUTE), nullptr, nullptr);
               else ln_phase<true, false, false>(c, X, nullptr, (bf16_t*)(ws + WS_XB), nullptr, inp(a, 33) + L * D, inp(a, 34) + L * D, (bf16_t*)(ws + WS_XG), (bf16_t*)(ws + WS_PE), (Route*)(ws + WS_ROUTE), nullptr, nullptr); }
    else ln_phase<false, false, false>(c, X, (bf16_t*)(ws + WS_PRE2), (bf16_t*)(ws + WS_XB), nullptr, inp(a, 33) + L * D, inp(a, 34) + L * D, nullptr, nullptr, nullptr, nullptr, nullptr);
}

DI void grid_bar(unsigned* barw, unsigned x, volatile LAS unsigned* st) { asm volatile("" : "+s"(barw), "+s"(x)); XcdBarrier b; b.bar = barw; b.x = x; b.st = st; xcd_barrier(b); }

#define IN(k) (ph_lo <= (k) && (k) < ph_hi)
#define SEAM(k) do { if (IN((k) + 1)) grid_bar(bar.bar, bar.x, bar.st); } while (0)
template <int L> DI void layer_body(const int ph_lo, const int ph_hi, const XcdBarrier& bar) {
        const int p0 = L * NPH; const bool moe = (L & 1) != 0;
        if (PHEN(0) && IN(p0 + 0)) { if (L == 0) { ph_cvt_in(0); SEAM(p0 + 0); } }
        if (PHEN(1) && IN(p0 + 1)) { ph_proj(L); SEAM(p0 + 1); }
        if (PHEN(2) && IN(p0 + 2)) {
            { const bool handoff = gridDim.x == 256; const int grp = blockIdx.x & 3, idx = blockIdx.x >> 2;
              const int rank = (grp == 2) ? idx : (grp == 1) ? 64 + idx : (grp == 3 && idx >= 32) ? 96 + idx : 512;
              for (int t = 64 + (handoff ? rank : (int)blockIdx.x); t < 512; t += handoff ? 160 : (int)gridDim.x) { ph_rwkv_prep(L, (t & 63) >> 2, t & 3, t >> 6); __syncthreads(); }
              if (!handoff) grid_bar(bar.bar, bar.x, bar.st); }
            for (int task = blockIdx.x; task < 256; task += gridDim.x) {
                const int grp = task & 3, idx = task >> 2;
                if (grp == 0) ph_mix_rwkv(L, idx >> 2, idx & 3);
                else if (grp == 1) ph_mix_mlstm(L, idx >> 2, idx & 3);
                else if (grp == 2) ph_mix_rglru(L, idx >> 2, idx & 3);
                else if (idx < 32) ph_mix_ssd(L, idx >> 1, idx & 1);
                else ph_pe_raw(L, idx - 32, 32);
                __syncthreads();
            }
            ph_cvt_queue(L);
            SEAM(p0 + 2);
        }
        if (PHEN(3) && IN(p0 + 3)) { ph_outproj(L); SEAM(p0 + 3); }
        if (PHEN(4) && IN(p0 + 4)) { ph_ln1(L); SEAM(p0 + 4); }
        if (PHEN(5) && IN(p0 + 5)) { if (moe) { ph_gather(L); SEAM(p0 + 5); } }
        if (PHEN(6) && IN(p0 + 6)) { if (moe) ph_up_moe(L); else { ph_up_dense(L); ph_gate_mul(L, blockIdx.x, gridDim.x); } SEAM(p0 + 6); }
        if (PHEN(7) && IN(p0 + 7)) { if (moe) { ph_down_moe(L); ph_gate_mul_moe(L); } else ph_down_dense(L); SEAM(p0 + 7); }
        if (PHEN(8) && IN(p0 + 8)) { ph_ln2(L); if (L + 1 < DEPTH) { __syncthreads(); ph_cvt_in(L + 1); SEAM(p0 + 8); } }
}

__global__ void __launch_bounds__(512, 2) fwd_kernel(Args args) {
    extern __shared__ __attribute__((aligned(16))) unsigned char lds_raw[];
    LAS unsigned char* lds = (LAS unsigned char*)lds_raw;
    const int tid = threadIdx.x;
    volatile LAS unsigned* misc = (volatile LAS unsigned*)(lds + LDS_MISC);
    if (tid < 4) misc[tid] = 0u;
    { LAS unsigned long long* la = (LAS unsigned long long*)(lds + LDS_ARGS); const unsigned long long* ga = (const unsigned long long*)&args;
      if (tid < (int)(sizeof(Args) / 8)) la[tid] = ga[tid]; }
    __syncthreads();
    const int ph_lo = args.ph_lo, ph_hi = args.ph_hi;
    const bool multi = !(ph_lo == 0 && ph_hi == DEPTH * NPH);
    unsigned* ctl = (unsigned*)(args.ws + WS_CTL);
    XcdBarrier bar; bar.bar = ctl + CW_BAR; bar.x = 0; bar.st = misc;
    if (!multi) bar = xcd_barrier_post(ctl + CW_BAR, misc);
    layer_body<0>(ph_lo, ph_hi, bar); layer_body<1>(ph_lo, ph_hi, bar); layer_body<2>(ph_lo, ph_hi, bar); layer_body<3>(ph_lo, ph_hi, bar);
#undef IN
#undef SEAM
}

#ifndef MK_PER_PHASE
#define MK_PER_PHASE 0
#endif
extern "C" void kernel_launch(void* const* d_in, const int* in_sizes, int n_in, void* d_out, int out_size, void* d_ws, size_t ws_size, hipStream_t stream) {
    static int grid = 0;
    if (grid == 0) {
        if (n_in != 45 || in_sizes[0] != T * D || out_size != T * D || ws_size < (WS_END > WS_NEED ? WS_END : WS_NEED)) {
            fprintf(stderr, "kernel_launch: unexpected shapes (n_in %d, in0 %d, out %d, ws %zu < %zu); nothing launched\n", n_in, n_in > 0 ? in_sizes[0] : -1, out_size, ws_size, (size_t)WS_END); grid = -1; return; }
        int dev = 0, cus = 0, per_cu = 0;
        if (hipGetDevice(&dev) != hipSuccess || hipDeviceGetAttribute(&cus, hipDeviceAttributeMultiprocessorCount, dev) != hipSuccess) { grid = -1; return; }
        if (hipFuncSetAttribute((const void*)fwd_kernel, hipFuncAttributeMaxDynamicSharedMemorySize, LDS_BYTES) != hipSuccess) { fprintf(stderr, "kernel_launch: hipFuncSetAttribute failed\n"); grid = -1; return; }
        if (hipOccupancyMaxActiveBlocksPerMultiprocessor(&per_cu, (const void*)fwd_kernel, 512, LDS_BYTES) != hipSuccess || per_cu < 1) { fprintf(stderr, "kernel_launch: occupancy query reports %d\n", per_cu); (void)hipGetLastError(); grid = -1; return; }
        grid = cus;
    }
    if (grid < 0) return;
    (void)hipMemsetAsync((char*)d_ws + WS_CTL, 0, CTL_BYTES, stream);
    Args a{};
    for (int i = 0; i < 45; ++i) a.in[i] = (const float*)d_in[i];
    a.out = (float*)d_out; a.ws = (unsigned char*)d_ws;
#if MK_PER_PHASE
    for (int ph = 0; ph < DEPTH * NPH; ++ph) { a.ph_lo = ph; a.ph_hi = ph + 1; hipLaunchKernelGGL(fwd_kernel, dim3(grid), dim3(512), LDS_BYTES, stream, a); }
#else
    a.ph_lo = 0; a.ph_hi = DEPTH * NPH;
    hipLaunchKernelGGL(fwd_kernel, dim3(grid), dim3(512), LDS_BYTES, stream, a);
#endif
}
```

```cpp
#include <hip/hip_runtime.h>
#include <cstdio>
#include <cstdint>

#define LAS __attribute__((address_space(3)))
typedef unsigned short bf16_t;
typedef short bf16x8 __attribute__((ext_vector_type(8)));
typedef float f32x4 __attribute__((ext_vector_type(4)));
typedef float f32x2 __attribute__((ext_vector_type(2)));
typedef unsigned u32x4 __attribute__((ext_vector_type(4)));
typedef unsigned u32x2 __attribute__((ext_vector_type(2)));
#define DI __device__ __forceinline__
#define GAS __attribute__((address_space(1)))

constexpr int NB = 16, SEQ = 2048, T = NB * SEQ, D = 1024, DEPTH = 4, PE_DIM = 256;
constexpr int NIN = 3212, NINP = 3328, DFF = 2816, NH2 = 2 * DFF, NE = 8;
constexpr int OFF_M = 0, OFF_G = 1032, OFF_R = 1544, OFF_S = 2440;
constexpr float ALPHA = 1.6817928305074290f;
constexpr int MOE_ROWS = 2 * T + NE * 256;

DI float bf2f(bf16_t b) { return __uint_as_float(((unsigned)b) << 16); }
typedef __bf16 bf16x2_t __attribute__((ext_vector_type(2)));
DI bf16_t f2bf(float f) { return __builtin_bit_cast(bf16_t, (__bf16)f); }
DI unsigned pack_bf16(float lo, float hi) { bf16x2_t v; v[0] = (__bf16)lo; v[1] = (__bf16)hi; return __builtin_bit_cast(unsigned, v); }
DI float rcpf_(float x) { return __builtin_amdgcn_rcpf(x); }
DI float sigmoidf_(float x) { return rcpf_(1.0f + __expf(-x)); }
DI float softplusf_(float x) { return fmaxf(x, 0.f) + __logf(1.0f + __expf(-fabsf(x))); }
DI float siluf_(float x) { return x * sigmoidf_(x); }
DI float tanhf_(float x) { const float e = __expf(-2.0f * fabsf(x)); const float r = (1.0f - e) * rcpf_(1.0f + e); return x < 0.f ? -r : r; }
DI float gelu_tanhf_(float x) { const float u = 0.7978845608028654f * (x + 0.044715f * x * x * x); return x * sigmoidf_(2.0f * u); }
DI float grp16_sum(float v) {
#pragma unroll
    for (int o = 8; o >= 1; o >>= 1) v += __shfl_xor(v, o);
    return v;
}
DI unsigned long long rfl64(unsigned long long v) { const unsigned lo = __builtin_amdgcn_readfirstlane((unsigned)v), hi = __builtin_amdgcn_readfirstlane((unsigned)(v >> 32)); return ((unsigned long long)hi << 32) | lo; }
#define XB_TMO      128
#define XB_XCNT(j)  (256  + 64 * (j))
#define XB_XSUB(j)  (1280 + 64 * (j))
#define XB_XGEN(j)  (2304 + 64 * (j))
#define XB_TOP      3328
#define XB_TOPGEN   3392
#define XCD_BAR_WORDS 3456
#define XB_SPIN_CAP (1u << 18)

__device__ __forceinline__ unsigned xb_ld(unsigned* p)              { return __hip_atomic_load(p, __ATOMIC_RELAXED, __HIP_MEMORY_SCOPE_AGENT); }
__device__ __forceinline__ unsigned xb_add(unsigned* p, unsigned v) { return __hip_atomic_fetch_add(p, v, __ATOMIC_RELAXED, __HIP_MEMORY_SCOPE_AGENT); }
__device__ __forceinline__ unsigned xb_xcc_id() { return (unsigned)__builtin_amdgcn_s_getreg((3 << 11) | 20) & 0xFu; }
#define XB_SPIN(cond, bar) do { unsigned _sp = 0; while (cond) { __builtin_amdgcn_s_sleep(1); \
    if ((++_sp & 255u) == 0u) { if (xb_ld(&(bar)[XB_TMO])) break; if (_sp > XB_SPIN_CAP) { atomicAdd(&(bar)[XB_TMO], 1u); break; } } } } while (0)

struct XcdBarrier {
    unsigned* bar; unsigned x;
    volatile LAS unsigned* st;
};

__device__ __forceinline__ XcdBarrier xcd_barrier_post(unsigned* bar, volatile LAS unsigned* st) {
    XcdBarrier b; b.bar = bar; b.x = xb_xcc_id(); b.st = st;
    if (threadIdx.x == 0) (void)xb_add(&bar[XB_XCNT(b.x)], 1u);
    return b;
}
__device__ __forceinline__ void xcd_barrier_complete(unsigned* bar, unsigned x, unsigned& nloc, unsigned& nx) {
    const unsigned G = gridDim.x * gridDim.y * gridDim.z;
    unsigned sum, cnt, mine, sp = 0u;
    for (;;) {
        sum = 0u; cnt = 0u; mine = 0u;
#pragma unroll
        for (unsigned j = 0; j < 16; ++j) { const unsigned c = xb_ld(&bar[XB_XCNT(j)]); sum += c; cnt += (c > 0u) ? 1u : 0u; mine = (j == x) ? c : mine; }
        if (sum == G) break;
        __builtin_amdgcn_s_sleep(1);
        if ((++sp & 255u) == 0u) { if (xb_ld(&bar[XB_TMO])) break; if (sp > XB_SPIN_CAP) { atomicAdd(&bar[XB_TMO], 1u); break; } }
    }
    nloc = mine > 0u ? mine : 1u; nx = cnt > 0u ? cnt : 1u;
}

__device__ __forceinline__ void xcd_barrier(const XcdBarrier& b) {
    asm volatile("s_waitcnt vmcnt(0)" ::: "memory");
    __syncthreads();
    if (threadIdx.x == 0) {
        unsigned* bar = b.bar;
        __builtin_amdgcn_s_waitcnt(0);
        unsigned nloc = b.st[0], nx = b.st[1];
        if (nloc == 0u) { xcd_barrier_complete(bar, b.x, nloc, nx); b.st[0] = nloc; b.st[1] = nx; }
        const unsigned old = xb_add(&bar[XB_XSUB(b.x)], 1u);
        const unsigned gen = old / nloc;
        if (old + 1u == (gen + 1u) * nloc) {
            __builtin_amdgcn_fence(__ATOMIC_RELEASE, "agent");
            asm volatile("s_waitcnt vmcnt(0)" ::: "memory");
            const unsigned og = xb_add(&bar[XB_TOP], 1u);
            const unsigned tg = og / nx;
            if (og + 1u == (tg + 1u) * nx) xb_add(&bar[XB_TOPGEN], 1u);
            else XB_SPIN(xb_ld(&bar[XB_TOPGEN]) == tg, bar);
            __builtin_amdgcn_fence(__ATOMIC_ACQUIRE, "agent");
            xb_add(&bar[XB_XGEN(b.x)], 1u);
            asm volatile("s_waitcnt vmcnt(0)" ::: "memory");
        } else {
            XB_SPIN(xb_ld(&bar[XB_XGEN(b.x)]) == gen, bar);
            __builtin_amdgcn_fence(__ATOMIC_ACQUIRE, "agent");
            asm volatile("s_waitcnt vmcnt(0)" ::: "memory");
        }
    }
    __syncthreads();
}
namespace pg8 {
typedef short bf16x8 __attribute__((ext_vector_type(8)));
typedef float f32x4 __attribute__((ext_vector_type(4)));
typedef unsigned u32x4 __attribute__((ext_vector_type(4)));
constexpr int BM = 256, BK = 64, HALF = 128, HTB = HALF * BK * 2  , STAGE_BYTES = 8 * HTB, NXCD = 8, WGM = 4;

__host__ __device__ __forceinline__ int lds_byte(int r, int c) { const int st = (r >> 4) * 2 + (c >> 5), rr = r & 15, cc = c & 31, ob = rr * 64 + cc * 2; return st * 1024 + (ob ^ (((ob >> 9) & 1) << 5)); }
__host__ __device__ __forceinline__ void stage_rc(int b, int& R, int& C) { const int st = b / 1024, sb = b % 1024, swz = sb ^ (((sb >> 9) & 1) << 5); R = (st >> 1) * 16 + swz / 64; C = (st & 1) * 32 + (swz % 64) / 2; }
__host__ __device__ __forceinline__ int perm32(int rho) { const int n = rho >> 4, i = rho & 15; return 8 * (i >> 2) + 4 * n + (i & 3); }

#define PG8_LAS __attribute__((address_space(3)))
struct Unit { int pm, pn; size_t boff; };
struct Gemm { const bf16_t* A; const bf16_t* Bt; int M, N, K; };

struct StaticOrder {
    int nM, nN, nwg, G, c;
    __device__ void init(int M, int N, int G_, int c_) { nM = M / BM; nN = N / BM; nwg = nM * nN; G = G_; c = c_; }
    __device__ bool next(int i, Unit& u) const {
        const long L = (long)i * G + c; if (L >= nwg) return false;
        int wgid = (int)L; { const int q = nwg / NXCD, r = nwg % NXCD, xcd = wgid % NXCD, off = wgid / NXCD; wgid = (xcd < r ? xcd * (q + 1) : r * (q + 1) + (xcd - r) * q) + off; }
        const int nig = WGM * nN, gid = wgid / nig, fm = gid * WGM, gsz = (nM - fm) < WGM ? (nM - fm) : WGM;
        u.pm = fm + ((wgid % nig) % gsz); u.pn = (wgid % nig) / gsz; u.boff = 0; return true;
    }
    __device__ __forceinline__ void a_ready(const Unit&) const {}
    __device__ __forceinline__ void done(const Unit&) const {}
};
struct MoeOrder : StaticOrder {
    int tstart[NE + 1]; size_t estride;
    __device__ void init_moe(const unsigned* counts, int nN_, int G_, int c_, size_t estride_) {
        int acc = 0;
#pragma unroll
        for (int e = 0; e < NE; ++e) { tstart[e] = acc; acc += __builtin_amdgcn_readfirstlane(((int)counts[e] + 255) >> 8); }
        tstart[NE] = acc; nM = acc; nN = nN_; nwg = nM * nN; G = G_; c = c_; estride = estride_;
    }
    __device__ bool next(int i, Unit& u) const {
        if (!StaticOrder::next(i, u)) return false;
        int e = 0;
#pragma unroll
        for (int j = 1; j < NE; ++j) e += (u.pm >= tstart[j]) ? 1 : 0;
        u.boff = (size_t)e * estride; return true;
    }
};


struct ListOrder {
    int first, stride, total, nN;
    __device__ void init(int first_, int stride_, int total_, int nN_) { first = first_; stride = stride_; total = total_; nN = nN_; }
    __device__ bool next(int i, Unit& u) const { const int idx = first + i * stride; if (first < 0 || idx >= total) return false; u.pm = idx / nN; u.pn = idx - u.pm * nN; u.boff = 0; return true; }
    __device__ __forceinline__ void a_ready(const Unit&) const {}
    __device__ __forceinline__ void done(const Unit&) const {}
};

__device__ __forceinline__ unsigned cvt_pk_bf16(float lo, float hi) { return pack_bf16(lo, hi); }
__device__ __forceinline__ float bflo(unsigned w) { return __uint_as_float(w << 16); }
__device__ __forceinline__ float bfhi(unsigned w) { return __uint_as_float(w & 0xFFFF0000u); }
__device__ __forceinline__ float sigm(float x) { return __builtin_amdgcn_rcpf(1.0f + __expf(-x)); }

struct EpiBf16 {
    static constexpr bool PERM = true, AFTER_DRAIN = false, FP8 = false;
    bf16_t* O; int ldc;
    __device__ __forceinline__ void operator()(const f32x4 (&acc)[2][2][4][2], const Unit& u, int wr, int wc, int fr, int fq) const {
        const int row0 = u.pm * BM + wr * 64 + fr, col0 = u.pn * BM + wc * 32 + 8 * fq;
#pragma unroll
        for (int ai = 0; ai < 2; ++ai)
#pragma unroll
            for (int m = 0; m < 4; ++m) { bf16_t* rowp = O + (size_t)(row0 + ai * HALF + m * 16) * ldc + col0;
#pragma unroll
                for (int bj = 0; bj < 2; ++bj) { const f32x4 v0 = acc[ai][bj][m][0], v1 = acc[ai][bj][m][1];
                    u32x4 w; w.x = cvt_pk_bf16(v0[0], v0[1]); w.y = cvt_pk_bf16(v0[2], v0[3]); w.z = cvt_pk_bf16(v1[0], v1[1]); w.w = cvt_pk_bf16(v1[2], v1[3]);
                    *(GAS u32x4*)(rowp + bj * HALF) = w; } }
    }
};
struct EpiSwiglu {
    static constexpr bool PERM = true, AFTER_DRAIN = false, FP8 = false;
    bf16_t* H; int ldh;
    __device__ __forceinline__ void operator()(const f32x4 (&acc)[2][2][4][2], const Unit& u, int wr, int wc, int fr, int fq) const {
        const int row0 = u.pm * BM + wr * 64 + fr, col0 = u.pn * HALF + wc * 32 + 8 * fq;
#pragma unroll
        for (int ai = 0; ai < 2; ++ai)
#pragma unroll
            for (int m = 0; m < 4; ++m) { bf16_t* rowp = H + (size_t)(row0 + ai * HALF + m * 16) * ldh + col0;
                float h[8];
#pragma unroll
                for (int n = 0; n < 2; ++n)
#pragma unroll
                    for (int j = 0; j < 4; ++j) { const float a = acc[ai][0][m][n][j], b = acc[ai][1][m][n][j]; h[n * 4 + j] = a * sigm(a) * b; }
                u32x4 w; w.x = cvt_pk_bf16(h[0], h[1]); w.y = cvt_pk_bf16(h[2], h[3]); w.z = cvt_pk_bf16(h[4], h[5]); w.w = cvt_pk_bf16(h[6], h[7]);
                *(GAS u32x4*)rowp = w; }
    }
};
typedef int v8i __attribute__((ext_vector_type(8)));
typedef int v4i __attribute__((ext_vector_type(4)));
__device__ __forceinline__ v8i cat8(const bf16x8 lo, const bf16x8 hi) { const v4i a = __builtin_bit_cast(v4i, lo), b = __builtin_bit_cast(v4i, hi); return (v8i){a.x, a.y, a.z, a.w, b.x, b.y, b.z, b.w}; }
__device__ __forceinline__ unsigned pk4_fp8(float a, float b, float c, float d) { unsigned w = 0; w = __builtin_amdgcn_cvt_pk_fp8_f32(a, b, w, false); w = __builtin_amdgcn_cvt_pk_fp8_f32(c, d, w, true); return w; }
template <bool F8IN = true>
struct EpiSwiglu8T {
    static constexpr bool PERM = true, AFTER_DRAIN = false, FP8 = F8IN;
    unsigned char* H; int ldh; float sc;
    __device__ __forceinline__ void operator()(const f32x4 (&acc)[2][2][4][2], const Unit& u, int wr, int wc, int fr, int fq) const {
        const int row0 = u.pm * BM + wr * 64 + fr, col0 = u.pn * HALF + wc * 32 + 8 * fq;
#pragma unroll
        for (int ai = 0; ai < 2; ++ai)
#pragma unroll
            for (int m = 0; m < 4; ++m) { unsigned char* rowp = H + (size_t)(row0 + ai * HALF + m * 16) * ldh + col0;
                float h[8];
#pragma unroll
                for (int n = 0; n < 2; ++n)
#pragma unroll
                    for (int j = 0; j < 4; ++j) { const float a = acc[ai][0][m][n][j] * sc, b = acc[ai][1][m][n][j] * sc; h[n * 4 + j] = a * sigm(a) * b; }
                u32x2 w; w.x = pk4_fp8(h[0], h[1], h[2], h[3]); w.y = pk4_fp8(h[4], h[5], h[6], h[7]);
                *(GAS u32x2*)rowp = w; }
    }
};
typedef EpiSwiglu8T<true> EpiSwiglu8;
struct EpiBf16S8 {
    static constexpr bool PERM = true, AFTER_DRAIN = false, FP8 = true;
    bf16_t* O; int ldc; float sc;
    __device__ __forceinline__ void operator()(const f32x4 (&acc)[2][2][4][2], const Unit& u, int wr, int wc, int fr, int fq) const {
        const int row0 = u.pm * BM + wr * 64 + fr, col0 = u.pn * BM + wc * 32 + 8 * fq;
#pragma unroll
        for (int ai = 0; ai < 2; ++ai)
#pragma unroll
            for (int m = 0; m < 4; ++m) { bf16_t* rowp = O + (size_t)(row0 + ai * HALF + m * 16) * ldc + col0;
#pragma unroll
                for (int bj = 0; bj < 2; ++bj) { const f32x4 v0 = acc[ai][bj][m][0] * sc, v1 = acc[ai][bj][m][1] * sc;
                    u32x4 w; w.x = cvt_pk_bf16(v0[0], v0[1]); w.y = cvt_pk_bf16(v0[2], v0[3]); w.z = cvt_pk_bf16(v1[0], v1[1]); w.w = cvt_pk_bf16(v1[2], v1[3]);
                    *(GAS u32x4*)(rowp + bj * HALF) = w; } }
    }
};
struct EpiResF32 {
    static constexpr bool PERM = false, AFTER_DRAIN = false, FP8 = false;
    float* X; const float* R; int ldc; float alpha;
    __device__ __forceinline__ void operator()(const f32x4 (&acc)[2][2][4][2], const Unit& u, int wr, int wc, int fr, int fq) const {
        const int row0 = u.pm * BM + wr * 64 + fr, col0 = u.pn * BM + wc * 32 + 4 * fq;
#pragma unroll
        for (int ai = 0; ai < 2; ++ai)
#pragma unroll
            for (int m = 0; m < 4; ++m) { const size_t ro = (size_t)(row0 + ai * HALF + m * 16) * ldc + col0;
#pragma unroll
                for (int bj = 0; bj < 2; ++bj)
#pragma unroll
                    for (int n = 0; n < 2; ++n) { asm volatile("" ::: "memory"); const f32x4 r = *(const GAS f32x4*)(R + ro + bj * HALF + n * 16); *(GAS f32x4*)(X + ro + bj * HALF + n * 16) = r * alpha + acc[ai][bj][m][n]; } }
    }
};
struct EpiResBf {
    static constexpr bool PERM = false, AFTER_DRAIN = false, FP8 = false;
    float* X; const bf16_t* RB; int ldc; float alpha;
    __device__ __forceinline__ void operator()(const f32x4 (&acc)[2][2][4][2], const Unit& u, int wr, int wc, int fr, int fq) const {
        const int row0 = u.pm * BM + wr * 64 + fr, col0 = u.pn * BM + wc * 32 + 4 * fq;
#pragma unroll
        for (int ai = 0; ai < 2; ++ai)
#pragma unroll
            for (int m = 0; m < 4; ++m) { const size_t ro = (size_t)(row0 + ai * HALF + m * 16) * ldc + col0;
#pragma unroll
                for (int bj = 0; bj < 2; ++bj)
#pragma unroll
                    for (int n = 0; n < 2; ++n) { asm volatile("" ::: "memory"); const size_t o = ro + bj * HALF + n * 16; const u32x2 rw = *(const GAS u32x2*)(RB + o);
                        f32x4 r; r[0] = bflo(rw.x); r[1] = bfhi(rw.x); r[2] = bflo(rw.y); r[3] = bfhi(rw.y);
                        *(GAS f32x4*)(X + o) = r * alpha + acc[ai][bj][m][n]; } }
    }
};
struct EpiDownRes {
    static constexpr bool PERM = false, AFTER_DRAIN = false, FP8 = false;
    float* X; const bf16_t* RB; const bf16_t* PEb; int ldc; float alpha;
    __device__ __forceinline__ void operator()(const f32x4 (&acc)[2][2][4][2], const Unit& u, int wr, int wc, int fr, int fq) const {
        const int row0 = u.pm * BM + wr * 64 + fr, col0 = u.pn * BM + wc * 32 + 4 * fq;
#pragma unroll
        for (int ai = 0; ai < 2; ++ai)
#pragma unroll
            for (int m = 0; m < 4; ++m) { const size_t ro = (size_t)(row0 + ai * HALF + m * 16) * ldc + col0;
#pragma unroll
                for (int bj = 0; bj < 2; ++bj)
#pragma unroll
                    for (int n = 0; n < 2; ++n) { asm volatile("" ::: "memory"); const size_t o = ro + bj * HALF + n * 16; const u32x2 rw = *(const GAS u32x2*)(RB + o); const u32x2 pw = *(const GAS u32x2*)(PEb + o);
                        f32x4 r; r[0] = bflo(rw.x); r[1] = bfhi(rw.x); r[2] = bflo(rw.y); r[3] = bfhi(rw.y);
                        f32x4 pe; pe[0] = bflo(pw.x); pe[1] = bfhi(pw.x); pe[2] = bflo(pw.y); pe[3] = bfhi(pw.y);
                        *(GAS f32x4*)(X + o) = r * alpha + acc[ai][bj][m][n] + pe; } }
    }
};
__device__ __forceinline__ void unpack8(const u32x4 w, float (&f)[8]) { f[0] = bflo(w.x); f[1] = bfhi(w.x); f[2] = bflo(w.y); f[3] = bfhi(w.y); f[4] = bflo(w.z); f[5] = bfhi(w.z); f[6] = bflo(w.w); f[7] = bfhi(w.w); }
template <int RMODE  , bool HASPE, bool F8 = false>
struct EpiPreLn {
    static constexpr bool PERM = true, AFTER_DRAIN = false, FP8 = F8;
    bf16_t* P; const void* R; const bf16_t* PEb; int ldc; float alpha; float sc = 1.0f;
    __device__ __forceinline__ void operator()(const f32x4 (&acc)[2][2][4][2], const Unit& u, int wr, int wc, int fr, int fq) const {
        const int row0 = u.pm * BM + wr * 64 + fr, col0 = u.pn * BM + wc * 32 + 8 * fq;
#pragma unroll
        for (int ai = 0; ai < 2; ++ai)
#pragma unroll
            for (int m = 0; m < 4; ++m) { const size_t ro = (size_t)(row0 + ai * HALF + m * 16) * ldc + col0;
#pragma unroll
                for (int bj = 0; bj < 2; ++bj) { asm volatile("" ::: "memory"); const size_t o = ro + bj * HALF; float r[8];
                    if (RMODE == 0) { const f32x4 a = *(const GAS f32x4*)((const float*)R + o), b = *(const GAS f32x4*)((const float*)R + o + 4); r[0] = a[0]; r[1] = a[1]; r[2] = a[2]; r[3] = a[3]; r[4] = b[0]; r[5] = b[1]; r[6] = b[2]; r[7] = b[3]; }
                    else unpack8(*(const GAS u32x4*)((const bf16_t*)R + o), r);
                    float v[8];
#pragma unroll
                    for (int j = 0; j < 4; ++j) { v[j] = r[j] * alpha + acc[ai][bj][m][0][j] * (F8 ? sc : 1.0f); v[4 + j] = r[4 + j] * alpha + acc[ai][bj][m][1][j] * (F8 ? sc : 1.0f); }
                    if (HASPE) { float pe[8]; unpack8(*(const GAS u32x4*)(PEb + o), pe);
#pragma unroll
                        for (int j = 0; j < 8; ++j) v[j] += pe[j]; }
                    u32x4 w; w.x = cvt_pk_bf16(v[0], v[1]); w.y = cvt_pk_bf16(v[2], v[3]); w.z = cvt_pk_bf16(v[4], v[5]); w.w = cvt_pk_bf16(v[6], v[7]);
                    *(GAS u32x4*)(P + o) = w; } }
    }
};
struct EpiGate {
    static constexpr bool PERM = true, AFTER_DRAIN = false, FP8 = false;
    bf16_t* O; int ldc; const float* bias;
    __device__ __forceinline__ void operator()(const f32x4 (&acc)[2][2][4][2], const Unit& u, int wr, int wc, int fr, int fq) const {
        const int row0 = u.pm * BM + wr * 64 + fr, col0 = u.pn * BM + wc * 32 + 8 * fq;
        f32x4 bv[2][2];
#pragma unroll
        for (int bj = 0; bj < 2; ++bj)
#pragma unroll
            for (int n = 0; n < 2; ++n) bv[bj][n] = *(const GAS f32x4*)(bias + col0 + bj * HALF + 4 * n);
#pragma unroll
        for (int ai = 0; ai < 2; ++ai)
#pragma unroll
            for (int m = 0; m < 4; ++m) { bf16_t* rowp = O + (size_t)(row0 + ai * HALF + m * 16) * ldc + col0;
#pragma unroll
                for (int bj = 0; bj < 2; ++bj) { f32x4 v0 = acc[ai][bj][m][0] + bv[bj][0], v1 = acc[ai][bj][m][1] + bv[bj][1];
#pragma unroll
                    for (int j = 0; j < 4; ++j) { v0[j] = sigm(v0[j]); v1[j] = sigm(v1[j]); }
                    u32x4 w; w.x = cvt_pk_bf16(v0[0], v0[1]); w.y = cvt_pk_bf16(v0[2], v0[3]); w.z = cvt_pk_bf16(v1[0], v1[1]); w.w = cvt_pk_bf16(v1[2], v1[3]);
                    *(GAS u32x4*)(rowp + bj * HALF) = w; } }
    }
};
struct EpiGateMul {
    static constexpr bool PERM = true, AFTER_DRAIN = false, FP8 = false;
    bf16_t* O; int ldc; const float* bias;
    __device__ __forceinline__ void operator()(const f32x4 (&acc)[2][2][4][2], const Unit& u, int wr, int wc, int fr, int fq) const {
        const int row0 = u.pm * BM + wr * 64 + fr, col0 = u.pn * BM + wc * 32 + 8 * fq;
        f32x4 bv[2][2];
#pragma unroll
        for (int bj = 0; bj < 2; ++bj)
#pragma unroll
            for (int n = 0; n < 2; ++n) bv[bj][n] = *(const GAS f32x4*)(bias + col0 + bj * HALF + 4 * n);
#pragma unroll
        for (int ai = 0; ai < 2; ++ai)
#pragma unroll
            for (int m = 0; m < 4; ++m) { bf16_t* rowp = O + (size_t)(row0 + ai * HALF + m * 16) * ldc + col0;
#pragma unroll
                for (int bj = 0; bj < 2; ++bj) { asm volatile("" ::: "memory"); const f32x4 v0 = acc[ai][bj][m][0] + bv[bj][0], v1 = acc[ai][bj][m][1] + bv[bj][1]; const u32x4 g = *(const GAS u32x4*)(rowp + bj * HALF);
                    u32x4 w; w.x = cvt_pk_bf16(sigm(v0[0]) * bflo(g.x), sigm(v0[1]) * bfhi(g.x)); w.y = cvt_pk_bf16(sigm(v0[2]) * bflo(g.y), sigm(v0[3]) * bfhi(g.y));
                    w.z = cvt_pk_bf16(sigm(v1[0]) * bflo(g.z), sigm(v1[1]) * bfhi(g.z)); w.w = cvt_pk_bf16(sigm(v1[2]) * bflo(g.w), sigm(v1[3]) * bfhi(g.w));
                    *(GAS u32x4*)(rowp + bj * HALF) = w; } }
    }
};
struct EpiPeMul {
    static constexpr bool PERM = true, AFTER_DRAIN = false, FP8 = false;
    bf16_t* O; int ldc;
    __device__ __forceinline__ void operator()(const f32x4 (&acc)[2][2][4][2], const Unit& u, int wr, int wc, int fr, int fq) const {
        const int row0 = u.pm * BM + wr * 64 + fr, col0 = u.pn * BM + wc * 32 + 8 * fq;
#pragma unroll
        for (int ai = 0; ai < 2; ++ai)
#pragma unroll
            for (int m = 0; m < 4; ++m) { bf16_t* rowp = O + (size_t)(row0 + ai * HALF + m * 16) * ldc + col0;
#pragma unroll
                for (int bj = 0; bj < 2; ++bj) { asm volatile("" ::: "memory"); const f32x4 v0 = acc[ai][bj][m][0], v1 = acc[ai][bj][m][1]; const u32x4 g = *(const GAS u32x4*)(rowp + bj * HALF);
                    u32x4 w; w.x = cvt_pk_bf16(v0[0] * bflo(g.x), v0[1] * bfhi(g.x)); w.y = cvt_pk_bf16(v0[2] * bflo(g.y), v0[3] * bfhi(g.y));
                    w.z = cvt_pk_bf16(v1[0] * bflo(g.z), v1[1] * bfhi(g.z)); w.w = cvt_pk_bf16(v1[2] * bflo(g.w), v1[3] * bfhi(g.w));
                    *(GAS u32x4*)(rowp + bj * HALF) = w; } }
    }
};

template <class Epi, class Sched, bool STAMP = false>
__device__ __forceinline__ void gemm_phase(PG8_LAS unsigned char* lds, const Gemm g, const Sched& S, const Epi& E, unsigned long long* stamps) {
    int tid_ = threadIdx.x; asm volatile("" : "+v"(tid_));
    const int tid = tid_, wid = __builtin_amdgcn_readfirstlane(tid >> 6), lane = tid & 63, wr = wid >> 2, wc = wid & 3, fr = lane & 15, fq = lane >> 4;
    const int K = g.K, nt = K / BK;
    int ts_lo = 0, ts_hi = 0, nts = 0; const unsigned long long rt_entry = STAMP ? (unsigned long long)wall_clock64() : 0ull;
#define PG8_STAMP() do { if (STAMP && wid == 0 && nts < 64) { const unsigned long long _c = (unsigned long long)clock64(); \
        ts_lo = (lane == nts) ? (int)(unsigned)_c : ts_lo; ts_hi = (lane == nts) ? (int)(unsigned)(_c >> 32) : ts_hi; ++nts; } } while (0)
    PG8_STAMP();
    unsigned voffA[2], voffB[2];
#pragma unroll
    for (int i = 0; i < 2; ++i) { int R, C; stage_rc(tid * 16 + i * 8192, R, C); const int Rb = Epi::PERM ? ((R & ~31) + perm32(R & 31)) : R;
        voffA[i] = (unsigned)(R * K + C) * 2u; voffB[i] = (unsigned)(Rb * K + C) * 2u; }
    const size_t kstep = (size_t)(BK * 2);
    const size_t hstep = (size_t)HALF * K * 2;
    const size_t tstep = 2 * hstep;
    const unsigned ldsw = (unsigned)wid * 1024u;
    const int aoff = lds_byte(wr * 64 + fr, fq * 8), boff = lds_byte(wc * 32 + fr, fq * 8);
#define PG8_SA(b, h) (((b) * 2 + (h)) * HTB)
#define PG8_SB(b, h) ((4 + (b) * 2 + (h)) * HTB)
#define PG8_STAGE(bufoff, gbase, voff) do { _Pragma("unroll") for (int _i = 0; _i < 2; ++_i) \
        __builtin_amdgcn_global_load_lds((const unsigned*)((const char*)(gbase) + (voff)[_i]), (PG8_LAS unsigned*)(lds + (bufoff) + ldsw + _i * 8192), 16, 0, 0); } while (0)
#define PG8_LDA(dst, b, h) do { _Pragma("unroll") for (int m = 0; m < 4; ++m) { dst[m].lo = *(const PG8_LAS v4i*)(lds + PG8_SA(b, h) + aoff + m * 2048); dst[m].hi = *(const PG8_LAS v4i*)(lds + PG8_SA(b, h) + aoff + m * 2048 + 1024); } } while (0)
#define PG8_LDB(dst, b, h) do { _Pragma("unroll") for (int n = 0; n < 2; ++n) { dst[n].lo = *(const PG8_LAS v4i*)(lds + PG8_SB(b, h) + boff + n * 2048); dst[n].hi = *(const PG8_LAS v4i*)(lds + PG8_SB(b, h) + boff + n * 2048 + 1024); } } while (0)
#define PG8_MMA(ai, bj, At, Bt) do { __builtin_amdgcn_s_setprio(1); \
        if constexpr (Epi::FP8) { _Pragma("unroll") for (int m = 0; m < 4; ++m) _Pragma("unroll") for (int n = 0; n < 2; ++n) \
            asm volatile("v_mfma_f32_16x16x128_f8f6f4 %0, %1, %2, %0" : "+v"(acc[ai][bj][m][n]) : "v"(Bt[n]), "v"(At[m])); } \
        else { _Pragma("unroll") for (int m = 0; m < 4; ++m) _Pragma("unroll") for (int n = 0; n < 2; ++n) { \
            const v4i bl_ = Bt[n].lo, bh_ = Bt[n].hi, al_ = At[m].lo, ah_ = At[m].hi;     \
            acc[ai][bj][m][n] = __builtin_amdgcn_mfma_f32_16x16x32_bf16(__builtin_bit_cast(bf16x8, bl_), __builtin_bit_cast(bf16x8, al_), acc[ai][bj][m][n], 0, 0, 0); \
            acc[ai][bj][m][n] = __builtin_amdgcn_mfma_f32_16x16x32_bf16(__builtin_bit_cast(bf16x8, bh_), __builtin_bit_cast(bf16x8, ah_), acc[ai][bj][m][n], 0, 0, 0); } } \
        __builtin_amdgcn_s_setprio(0); } while (0)
#define PG8_WAIT_V(n) asm volatile("s_waitcnt vmcnt(" #n ")" ::: "memory")
#define PG8_WAIT_L(n) asm volatile("s_waitcnt lgkmcnt(" #n ")" ::: "memory")
#define PG8_BAR __builtin_amdgcn_s_barrier()
#define PG8_SCHED __builtin_amdgcn_sched_barrier(0)
    Unit cur, nxt; int ui = 0;
    if (!S.next(0, cur)) return;
    f32x4 acc[2][2][4][2];
#pragma unroll
    for (int a = 0; a < 2; ++a)
#pragma unroll
        for (int b = 0; b < 2; ++b)
#pragma unroll
            for (int m = 0; m < 4; ++m)
#pragma unroll
                for (int n = 0; n < 2; ++n) acc[a][b][m][n] = (f32x4){0.f, 0.f, 0.f, 0.f};
    v8i At[4], B0[2], B1[2];
    const char* cA = (const char*)g.A + (size_t)cur.pm * tstep; const char* cB = (const char*)g.Bt + cur.boff + (size_t)cur.pn * tstep;
    S.a_ready(cur);
    PG8_STAGE(PG8_SB(0, 0), cB, voffB); PG8_STAGE(PG8_SA(0, 0), cA, voffA); PG8_STAGE(PG8_SB(0, 1), cB + hstep, voffB); PG8_STAGE(PG8_SA(0, 1), cA + hstep, voffA);
    if (wr == 1) PG8_BAR;
    PG8_WAIT_V(4); PG8_BAR;
    PG8_STAGE(PG8_SB(1, 0), cB + kstep, voffB); PG8_STAGE(PG8_SA(1, 0), cA + kstep, voffA); PG8_STAGE(PG8_SB(1, 1), cB + hstep + kstep, voffB);
    PG8_WAIT_V(6); PG8_BAR;
    PG8_STAMP();
    for (;;) {
        const bool has_next = S.next(ui + 1, nxt);
        const char* nA = has_next ? (const char*)g.A + (size_t)nxt.pm * tstep : cA; const char* nB = has_next ? (const char*)g.Bt + nxt.boff + (size_t)nxt.pn * tstep : cB;
#pragma nounroll
        for (int t = 0; t < nt; t += 2) {
            const bool last = (t == nt - 2);
            const char* a1 = cA + (size_t)(t + 1) * kstep;
            const char* a2 = last ? nA : cA + (size_t)(t + 2) * kstep; const char* b2 = last ? nB : cB + (size_t)(t + 2) * kstep;
            const char* a3 = a2 + kstep; const char* b3 = b2 + kstep;
            if (last && has_next) S.a_ready(nxt);
            PG8_LDB(B0, 0, 0); PG8_SCHED; PG8_LDA(At, 0, 0); PG8_STAGE(PG8_SA(1, 1), a1 + hstep, voffA);
            PG8_WAIT_L(8); PG8_BAR; PG8_WAIT_L(0); PG8_MMA(0, 0, At, B0); PG8_BAR; PG8_SCHED;
            PG8_LDB(B1, 0, 1); PG8_STAGE(PG8_SB(0, 0), b2, voffB);
            PG8_BAR; PG8_WAIT_L(0); PG8_MMA(0, 1, At, B1); PG8_BAR;
            PG8_LDA(At, 0, 1); PG8_STAGE(PG8_SA(0, 0), a2, voffA);
            PG8_BAR; PG8_WAIT_L(0); PG8_MMA(1, 0, At, B0); PG8_BAR; PG8_SCHED;
            PG8_STAGE(PG8_SB(0, 1), b2 + hstep, voffB);
            PG8_WAIT_V(6); PG8_BAR; PG8_MMA(1, 1, At, B1); PG8_BAR;
            PG8_LDB(B0, 1, 0); PG8_SCHED; PG8_LDA(At, 1, 0); PG8_STAGE(PG8_SA(0, 1), a2 + hstep, voffA);
            PG8_WAIT_L(8); PG8_BAR; PG8_WAIT_L(0); PG8_MMA(0, 0, At, B0); PG8_BAR; PG8_SCHED;
            PG8_LDB(B1, 1, 1); PG8_STAGE(PG8_SB(1, 0), b3, voffB);
            PG8_BAR; PG8_WAIT_L(0); PG8_MMA(0, 1, At, B1); PG8_BAR;
            PG8_LDA(At, 1, 1); PG8_STAGE(PG8_SA(1, 0), a3, voffA);
            PG8_BAR; PG8_WAIT_L(0); PG8_MMA(1, 0, At, B0); PG8_BAR; PG8_SCHED;
            PG8_STAGE(PG8_SB(1, 1), b3 + hstep, voffB);
            PG8_WAIT_V(6); PG8_BAR; PG8_MMA(1, 1, At, B1); PG8_BAR;
        }
        PG8_STAMP();
        if constexpr (Epi::FP8) { asm volatile("s_nop 15\n\ts_nop 15" : "+v"(acc[0][0][0][0]), "+v"(acc[0][0][0][1]), "+v"(acc[0][0][1][0]), "+v"(acc[0][0][1][1]), "+v"(acc[0][0][2][0]), "+v"(acc[0][0][2][1]), "+v"(acc[0][0][3][0]), "+v"(acc[0][0][3][1]), "+v"(acc[0][1][0][0]), "+v"(acc[0][1][0][1]), "+v"(acc[0][1][1][0]), "+v"(acc[0][1][1][1]), "+v"(acc[0][1][2][0]), "+v"(acc[0][1][2][1]), "+v"(acc[0][1][3][0]), "+v"(acc[0][1][3][1]));
                                  asm volatile("" : "+v"(acc[1][0][0][0]), "+v"(acc[1][0][0][1]), "+v"(acc[1][0][1][0]), "+v"(acc[1][0][1][1]), "+v"(acc[1][0][2][0]), "+v"(acc[1][0][2][1]), "+v"(acc[1][0][3][0]), "+v"(acc[1][0][3][1]), "+v"(acc[1][1][0][0]), "+v"(acc[1][1][0][1]), "+v"(acc[1][1][1][0]), "+v"(acc[1][1][1][1]), "+v"(acc[1][1][2][0]), "+v"(acc[1][1][2][1]), "+v"(acc[1][1][3][0]), "+v"(acc[1][1][3][1])); }
        if constexpr (!Epi::AFTER_DRAIN) { E(acc, cur, wr, wc, fr, fq); S.done(cur); }
        PG8_STAMP();
        if (!has_next) break;
#pragma unroll
        for (int a = 0; a < 2; ++a)
#pragma unroll
            for (int b = 0; b < 2; ++b)
#pragma unroll
                for (int m = 0; m < 4; ++m)
#pragma unroll
                    for (int n = 0; n < 2; ++n) acc[a][b][m][n] = (f32x4){0.f, 0.f, 0.f, 0.f};
        cur = nxt; cA = nA; cB = nB; ++ui;
    }
    PG8_WAIT_V(0);
    if (wr == 0) PG8_BAR;
    PG8_BAR;
    if constexpr (Epi::AFTER_DRAIN) { E.fused(acc, cur, wr, wc, fr, fq, lds, wid, lane); S.done(cur); }
    PG8_STAMP();
    if (STAMP && wid == 0) { stamps[lane] = lane < nts ? (((unsigned long long)(unsigned)ts_hi << 32) | (unsigned)ts_lo) : 0ull;
        if (lane == 62) stamps[62] = rt_entry; if (lane == 63) stamps[63] = (unsigned long long)wall_clock64(); }
#undef PG8_STAMP
#undef PG8_SA
#undef PG8_SB
#undef PG8_STAGE
#undef PG8_LDA
#undef PG8_LDB
#undef PG8_MMA
#undef PG8_WAIT_V
#undef PG8_WAIT_L
#undef PG8_BAR
#undef PG8_SCHED
}
}
template <class F>
DI void mm_lds(const LAS bf16_t* A, int lda, const LAS bf16_t* Bt, int ldb, int M, int N, int K, int wave, int lane, F epi) {
    const int ntn = N >> 4, nt = (M >> 4) * ntn, r = lane & 15, q = lane >> 4;
    for (int t = wave; t < nt; t += 8) {
        const int m0 = (t / ntn) << 4, n0 = (t % ntn) << 4;
        f32x4 acc = {0.f, 0.f, 0.f, 0.f};
        for (int k0 = 0; k0 < K; k0 += 32) {
            const bf16x8 a = *(const LAS bf16x8*)(A + (m0 + r) * lda + k0 + q * 8);
            const bf16x8 b = *(const LAS bf16x8*)(Bt + (n0 + r) * ldb + k0 + q * 8);
            acc = __builtin_amdgcn_mfma_f32_16x16x32_bf16(b, a, acc, 0, 0, 0);
        }
        epi(m0 + r, n0 + 4 * q, acc);
    }
}
template <class F>
DI void mm_lds2(const LAS bf16_t* A1, int lda1, const LAS bf16_t* Bt1, int ldb1, int K1, const LAS bf16_t* A2, int lda2, const LAS bf16_t* Bt2, int ldb2, int K2,
                int M, int N, int wave, int lane, F epi) {
    const int ntn = N >> 4, nt = (M >> 4) * ntn, r = lane & 15, q = lane >> 4;
    for (int t = wave; t < nt; t += 8) {
        const int m0 = (t / ntn) << 4, n0 = (t % ntn) << 4;
        f32x4 acc1 = {0.f, 0.f, 0.f, 0.f}, acc2 = {0.f, 0.f, 0.f, 0.f};
        for (int k0 = 0; k0 < K1; k0 += 32) {
            const bf16x8 a = *(const LAS bf16x8*)(A1 + (m0 + r) * lda1 + k0 + q * 8);
            const bf16x8 b = *(const LAS bf16x8*)(Bt1 + (n0 + r) * ldb1 + k0 + q * 8);
            acc1 = __builtin_amdgcn_mfma_f32_16x16x32_bf16(b, a, acc1, 0, 0, 0);
        }
        for (int k0 = 0; k0 < K2; k0 += 32) {
            const bf16x8 a = *(const LAS bf16x8*)(A2 + (m0 + r) * lda2 + k0 + q * 8);
            const bf16x8 b = *(const LAS bf16x8*)(Bt2 + (n0 + r) * ldb2 + k0 + q * 8);
            acc2 = __builtin_amdgcn_mfma_f32_16x16x32_bf16(b, a, acc2, 0, 0, 0);
        }
        epi(m0 + r, n0 + 4 * q, acc1, acc2);
    }
}
template <int CTRL> DI float dppf(float v) { return __builtin_bit_cast(float, __builtin_amdgcn_update_dpp(0, __builtin_bit_cast(int, v), CTRL, 0xF, 0xF, true)); }
DI float red4(float v) { v += dppf<0xB1>(v); v += dppf<0x4E>(v); return v; }
DI float red8(float v) { v += dppf<0xB1>(v); v += dppf<0x4E>(v); v += dppf<0x141>(v); return v; }
DI void st_bf16x4(LAS bf16_t* p, const f32x4 v) { u32x2 w; w.x = pack_bf16(v[0], v[1]); w.y = pack_bf16(v[2], v[3]); *(LAS u32x2*)p = w; }
template <int NT, class FO>
DI void mm_lds_state(const LAS bf16_t* A, int lda, const LAS bf16_t* Bt, int ldb, int ntn, int K, int wave, int lane, f32x4 (&st)[NT], float decay, FO out) {
    const int r = lane & 15, q = lane >> 4;
#pragma unroll
    for (int i = 0; i < NT; ++i) {
        const int t = wave + 8 * i, m0 = (t / ntn) << 4, n0 = (t % ntn) << 4;
        f32x4 acc = st[i] * decay;
        for (int k0 = 0; k0 < K; k0 += 32) {
            const bf16x8 a = *(const LAS bf16x8*)(A + (m0 + r) * lda + k0 + q * 8);
            const bf16x8 b = *(const LAS bf16x8*)(Bt + (n0 + r) * ldb + k0 + q * 8);
            acc = __builtin_amdgcn_mfma_f32_16x16x32_bf16(b, a, acc, 0, 0, 0);
        }
        st[i] = acc; out(m0 + r, n0 + 4 * q, acc);
    }
}
template <int CTRL, int RM> DI float dppo(float old, float v) { return __builtin_bit_cast(float, __builtin_amdgcn_update_dpp(__builtin_bit_cast(int, old), __builtin_bit_cast(int, v), CTRL, RM, 0xF, false)); }
DI float wave_scan_add(float v, int) {
    v += dppo<0x111, 0xF>(0.f, v); v += dppo<0x112, 0xF>(0.f, v); v += dppo<0x114, 0xF>(0.f, v); v += dppo<0x118, 0xF>(0.f, v);
    v += dppo<0x142, 0xA>(0.f, v); v += dppo<0x143, 0xC>(0.f, v); return v;
}
DI float wave_scan_max(float v, int) {
    const float ni = -3.0e38f;
    v = fmaxf(v, dppo<0x111, 0xF>(ni, v)); v = fmaxf(v, dppo<0x112, 0xF>(ni, v)); v = fmaxf(v, dppo<0x114, 0xF>(ni, v)); v = fmaxf(v, dppo<0x118, 0xF>(ni, v));
    v = fmaxf(v, dppo<0x142, 0xA>(ni, v)); v = fmaxf(v, dppo<0x143, 0xC>(ni, v)); return v;
}
DI float lane63(float v) { return __builtin_bit_cast(float, __builtin_amdgcn_readlane(__builtin_bit_cast(int, v), 63)); }
DI float wave_max(float v) {
#pragma unroll
    for (int o = 32; o >= 1; o >>= 1) v = fmaxf(v, __shfl_xor(v, o));
    return v;
}
DI float red16(float v) { v += dppf<0xB1>(v); v += dppf<0x4E>(v); v += dppf<0x141>(v); v += dppf<0x140>(v); return v; }
template <class F>
DI void mm_lds_w(const LAS bf16_t* A, int lda, const LAS bf16_t* Bt, int ldb, int M, int N, int K, int pw, int nw, int lane, F epi) {
    const int ntn = N >> 4, nt = (M >> 4) * ntn, r = lane & 15, q = lane >> 4;
    for (int t = pw; t < nt; t += nw) {
        const int m0 = (t / ntn) << 4, n0 = (t % ntn) << 4;
        f32x4 acc = {0.f, 0.f, 0.f, 0.f};
        for (int k0 = 0; k0 < K; k0 += 32) {
            const bf16x8 a = *(const LAS bf16x8*)(A + (m0 + r) * lda + k0 + q * 8);
            const bf16x8 b = *(const LAS bf16x8*)(Bt + (n0 + r) * ldb + k0 + q * 8);
            acc = __builtin_amdgcn_mfma_f32_16x16x32_bf16(b, a, acc, 0, 0, 0);
        }
        epi(m0 + r, n0 + 4 * q, acc);
    }
}

DI float wave_sum(float v) { return lane63(wave_scan_add(v, 0)); }
#ifndef MOE_FP8
#define MOE_FP8 1
#endif
struct Ctx {
    LAS unsigned char* lds;
    int tid, lane, wave, G, bid;
};

DI void cvt_tile(const Ctx& c, const float* __restrict__ s, bf16_t* __restrict__ d, int K, int N, int mode, int k0, int n0) {
    LAS float* tile = (LAS float*)c.lds;
#pragma unroll
    for (int i = 0; i < 8; ++i) { const int row = i * 8 + (c.tid >> 6), col = c.tid & 63, n = n0 + col;
        tile[row * 65 + col] = (n < N) ? s[(size_t)(k0 + row) * N + n] : 0.f; }
    __syncthreads();
    { const int n = c.tid >> 3, kk = (c.tid & 7) * 8, ng = n0 + n;
      int drow = ng; if (mode == 1) drow = (ng >> 7) * 256 + (ng & 127); else if (mode == 2) drow = (ng >> 7) * 256 + 128 + (ng & 127);
      u32x4 w; w.x = pack_bf16(tile[(kk + 0) * 65 + n], tile[(kk + 1) * 65 + n]); w.y = pack_bf16(tile[(kk + 2) * 65 + n], tile[(kk + 3) * 65 + n]);
      w.z = pack_bf16(tile[(kk + 4) * 65 + n], tile[(kk + 5) * 65 + n]); w.w = pack_bf16(tile[(kk + 6) * 65 + n], tile[(kk + 7) * 65 + n]);
      *(GAS u32x4*)(d + (size_t)drow * K + k0 + kk) = w; }
    __syncthreads();
}
DI void cvt_weight(const Ctx& c, const float* __restrict__ src, bf16_t* __restrict__ dst, int K, int N, int mode, int nb, size_t sstride, size_t dstride, int& rot) {
    const int ntk = K >> 6, ntn = (N + 63) >> 6, per = ntk * ntn, total = per * nb;
    int first = c.bid - rot; if (first < 0) first += c.G;
    for (int t = first; t < total; t += c.G) {
        const int b = t / per, r = t - b * per, tk = r / ntn, tn = r - tk * ntn;
        cvt_tile(c, src + (size_t)b * sstride, dst + (size_t)b * dstride, K, N, mode, tk << 6, tn << 6);
    }
    rot = (rot + total) % c.G;
}
DI void cvt_act(const Ctx& c, const float* __restrict__ src, bf16_t* __restrict__ dst, size_t n) {
    const size_t nv = n >> 3;
    for (size_t i = (size_t)c.bid * 512 + c.tid; i < nv; i += (size_t)c.G * 512) {
        const f32x4 a = *(const GAS f32x4*)(src + i * 8), b = *(const GAS f32x4*)(src + i * 8 + 4);
        u32x4 w; w.x = pack_bf16(a[0], a[1]); w.y = pack_bf16(a[2], a[3]); w.z = pack_bf16(b[0], b[1]); w.w = pack_bf16(b[2], b[3]);
        *(GAS u32x4*)(dst + i * 8) = w;
    }
}

struct Route { int e0, e1; float g0, g1; int s0, s1; int pad0, pad1; };
template <bool COMBINE, bool ROUTE, bool WRITEX>
DI void ln_phase(const Ctx& c, float* __restrict__ X, const bf16_t* __restrict__ PRE, bf16_t* __restrict__ XB, unsigned char* __restrict__ XB8, const float* __restrict__ gam, const float* __restrict__ bet,
                 const bf16_t* __restrict__ YB, const bf16_t* __restrict__ PEb, Route* __restrict__ route, const float* __restrict__ wr, unsigned* __restrict__ counts) {
    LAS float* wrs = (LAS float*)c.lds;
    LAS unsigned* lcnt = (LAS unsigned*)(c.lds + 32768);
    if (ROUTE) {
        for (int i = c.tid; i < 1024 * 8; i += 512) wrs[i] = wr[i];
        if (c.tid < NE) lcnt[c.tid] = 0u;
        __syncthreads();
    }
    f32x4 gv[4], bv[4];
#pragma unroll
    for (int i = 0; i < 4; ++i) { gv[i] = *(const GAS f32x4*)(gam + i * 256 + c.lane * 4); bv[i] = *(const GAS f32x4*)(bet + i * 256 + c.lane * 4); }
    for (int row = c.bid * 8 + c.wave; row < T; row += c.G * 8) {
        float* xr = X + (size_t)row * D;
        f32x4 v[4];
        if (!COMBINE) {
#pragma unroll
            for (int i = 0; i < 4; ++i) { const u32x2 w = *(const GAS u32x2*)(PRE + (size_t)row * D + i * 256 + c.lane * 4); v[i][0] = pg8::bflo(w.x); v[i][1] = pg8::bfhi(w.x); v[i][2] = pg8::bflo(w.y); v[i][3] = pg8::bfhi(w.y); }
        } else {
#pragma unroll
            for (int i = 0; i < 4; ++i) { const u32x2 w = *(const GAS u32x2*)(XB + (size_t)row * D + i * 256 + c.lane * 4); v[i][0] = pg8::bflo(w.x); v[i][1] = pg8::bfhi(w.x); v[i][2] = pg8::bflo(w.y); v[i][3] = pg8::bfhi(w.y); }
        }
        if (COMBINE) {
            const Route rt = route[row];
            const bf16_t* y0 = YB + (size_t)rt.s0 * D; const bf16_t* y1 = YB + (size_t)rt.s1 * D; const bf16_t* pe = PEb + (size_t)row * D;
#pragma unroll
            for (int i = 0; i < 4; ++i) { const int o = i * 256 + c.lane * 4;
                const u32x2 a = *(const GAS u32x2*)(y0 + o), b = *(const GAS u32x2*)(y1 + o), p = *(const GAS u32x2*)(pe + o);
                v[i][0] = ALPHA * v[i][0] + rt.g0 * pg8::bflo(a.x) + rt.g1 * pg8::bflo(b.x) + pg8::bflo(p.x);
                v[i][1] = ALPHA * v[i][1] + rt.g0 * pg8::bfhi(a.x) + rt.g1 * pg8::bfhi(b.x) + pg8::bfhi(p.x);
                v[i][2] = ALPHA * v[i][2] + rt.g0 * pg8::bflo(a.y) + rt.g1 * pg8::bflo(b.y) + pg8::bflo(p.y);
                v[i][3] = ALPHA * v[i][3] + rt.g0 * pg8::bfhi(a.y) + rt.g1 * pg8::bfhi(b.y) + pg8::bfhi(p.y); }
        }
        float s = 0.f;
#pragma unroll
        for (int i = 0; i < 4; ++i) s += (v[i][0] + v[i][1]) + (v[i][2] + v[i][3]);
        const float mean = wave_sum(s) * (1.0f / D);
        float q = 0.f;
#pragma unroll
        for (int i = 0; i < 4; ++i) { v[i] = v[i] - mean; q += (v[i][0] * v[i][0] + v[i][1] * v[i][1]) + (v[i][2] * v[i][2] + v[i][3] * v[i][3]); }
        const float rstd = rsqrtf(wave_sum(q) * (1.0f / D) + 1e-5f);
#pragma unroll
        for (int i = 0; i < 4; ++i) { v[i] = v[i] * rstd * gv[i] + bv[i];
            if (WRITEX) *(GAS f32x4*)(xr + i * 256 + c.lane * 4) = v[i];
            u32x2 w; w.x = pack_bf16(v[i][0], v[i][1]); w.y = pack_bf16(v[i][2], v[i][3]);
            *(GAS u32x2*)(XB + (size_t)row * D + i * 256 + c.lane * 4) = w;
            if (XB8) *(GAS unsigned*)(XB8 + (size_t)row * D + i * 256 + c.lane * 4) = pg8::pk4_fp8(v[i][0], v[i][1], v[i][2], v[i][3]); }
        if (ROUTE) {
            float lg[NE];
#pragma unroll
            for (int e = 0; e < NE; ++e) lg[e] = 0.f;
#pragma unroll
            for (int i = 0; i < 4; ++i)
#pragma unroll
                for (int j = 0; j < 4; ++j) { const int d = i * 256 + c.lane * 4 + j; const f32x4 w0 = *(const LAS f32x4*)(wrs + d * 8), w1 = *(const LAS f32x4*)(wrs + d * 8 + 4);
                    lg[0] += v[i][j] * w0[0]; lg[1] += v[i][j] * w0[1]; lg[2] += v[i][j] * w0[2]; lg[3] += v[i][j] * w0[3];
                    lg[4] += v[i][j] * w1[0]; lg[5] += v[i][j] * w1[1]; lg[6] += v[i][j] * w1[2]; lg[7] += v[i][j] * w1[3]; }
#pragma unroll
            for (int e = 0; e < NE; ++e) lg[e] = wave_sum(lg[e]);
            int e0 = 0; float l0 = lg[0];
#pragma unroll
            for (int e = 1; e < NE; ++e) if (lg[e] > l0) { l0 = lg[e]; e0 = e; }
            int e1 = -1; float l1 = -3.0e38f;
#pragma unroll
            for (int e = 0; e < NE; ++e) if (e != e0 && lg[e] > l1) { l1 = lg[e]; e1 = e; }
            if (c.lane == 0) {
                const float g0 = 1.0f / (1.0f + __expf(l1 - l0));
                u32x4 rw; rw.x = (unsigned)e0; rw.y = (unsigned)e1; rw.z = __float_as_uint(g0); rw.w = __float_as_uint(1.0f - g0);
                *(GAS u32x4*)&route[row] = rw;
                atomicAdd((unsigned*)&lcnt[e0], 1u); atomicAdd((unsigned*)&lcnt[e1], 1u);
            }
        }
    }
    if (ROUTE) {
        __syncthreads();
        if (c.tid < NE) atomicAdd(&counts[c.tid], lcnt[c.tid]);
    }
}

DI void moe_assign_gather(const Ctx& c, Route* __restrict__ route, const unsigned* __restrict__ counts, unsigned* __restrict__ cursor, const bf16_t* __restrict__ XB, bf16_t* __restrict__ XG) {
    LAS unsigned* lcnt = (LAS unsigned*)c.lds;
    LAS unsigned* lbase = lcnt + 8;
    LAS int* lslot = (LAS int*)(lcnt + 16);
    unsigned pstart[NE]; { unsigned acc = 0;
#pragma unroll
        for (int e = 0; e < NE; ++e) { pstart[e] = acc; acc += ((counts[e] + 255u) >> 8) << 8; } }
    for (int chunk = c.bid; chunk < T / 128; chunk += c.G) {
        if (c.tid < NE) lcnt[c.tid] = 0u;
        __syncthreads();
        const int tok = chunk * 128 + c.tid; int e0 = 0, e1 = 0; unsigned r0 = 0, r1 = 0;
        if (c.tid < 128) { e0 = route[tok].e0; e1 = route[tok].e1; r0 = atomicAdd((unsigned*)&lcnt[e0], 1u); r1 = atomicAdd((unsigned*)&lcnt[e1], 1u); }
        __syncthreads();
        if (c.tid < NE) lbase[c.tid] = atomicAdd(&cursor[c.tid], lcnt[c.tid]);
        __syncthreads();
        if (c.tid < 128) {
            unsigned p0 = 0, p1 = 0;
#pragma unroll
            for (int e = 0; e < NE; ++e) { if (e == e0) p0 = pstart[e]; if (e == e1) p1 = pstart[e]; }
            const int s0 = (int)(p0 + lbase[e0] + r0), s1 = (int)(p1 + lbase[e1] + r1);
            route[tok].s0 = s0; route[tok].s1 = s1; lslot[c.tid * 2] = s0; lslot[c.tid * 2 + 1] = s1;
        }
        __syncthreads();
        for (int pr = c.tid >> 7; pr < 256; pr += 4) {
            const int tk = chunk * 128 + (pr >> 1); const int slot = lslot[pr]; const int o = (c.tid & 127) * 8;
#if !MOE_FP8
            *(GAS u32x4*)(XG + (size_t)slot * D + o) = *(const GAS u32x4*)(XB + (size_t)tk * D + o);
#else
            const u32x4 xw = *(const GAS u32x4*)(XB + (size_t)tk * D + o);
            u32x2 w8; w8.x = pg8::pk4_fp8(pg8::bflo(xw.x), pg8::bfhi(xw.x), pg8::bflo(xw.y), pg8::bfhi(xw.y)); w8.y = pg8::pk4_fp8(pg8::bflo(xw.z), pg8::bfhi(xw.z), pg8::bflo(xw.w), pg8::bfhi(xw.w));
            *(GAS u32x2*)((unsigned char*)XG + (size_t)slot * D + o) = w8;
#endif
        }
        __syncthreads();
    }
}
struct MixP {
    const GAS bf16_t* proj; GAS bf16_t* mix; int layer;
    const GAS float *m_i_bias, *m_f_bias, *m_norm_w;
    const GAS float *g_conv_w, *g_conv_b, *g_w_a, *g_b_a, *g_w_x, *g_b_x, *g_lambda;
    const GAS float *r_mu, *r_w0, *r_w2, *r_a0, *r_a2, *r_g2, *r_k_k, *r_k_a, *r_r_k, *r_ln_w, *r_ln_b;
    const GAS float *s_conv_w, *s_conv_b, *s_dt_bias, *s_a_log, *s_d, *s_norm_w;
};
constexpr int TC = 32;
DI float ldp(const GAS bf16_t* proj, int t, int col) { return bf2f(proj[(size_t)t * NINP + col]); }
DI void stage_rows(const Ctx& c, LAS bf16_t* dst, int ldd, const GAS bf16_t* proj, int b, int srow0, int nrows, int col0, int ncols) {
    const int pc = ncols >> 3, np = nrows * pc;
    for (int p = c.tid; p < np; p += 512) { const int r = p / pc, c8 = p - r * pc, s = srow0 + r;
        u32x4 v = {0u, 0u, 0u, 0u}; if (s >= 0) v = *(const GAS u32x4*)(proj + (size_t)(b * SEQ + s) * NINP + col0 + c8 * 8);
        *(LAS u32x4*)(dst + r * ldd + c8 * 8) = v; }
}
DI void mix_mlstm_v2(const Ctx& c, const MixP& P, int b, int h) {
    constexpr int LD = 72;
    LAS bf16_t* Qs = (LAS bf16_t*)c.lds; LAS bf16_t* Ks = Qs + 64 * LD; LAS bf16_t* KT = Ks + 64 * LD; LAS bf16_t* VT = KT + 64 * LD; LAS bf16_t* VwT = VT + 64 * LD;
    LAS bf16_t* Sb = VwT + 64 * LD; LAS bf16_t* Cb = Sb + 64 * LD;
    LAS float* Hn = (LAS float*)(c.lds + 64512); LAS float* Og = Hn + 64 * 64;
    LAS float* Li = Og + 64 * 64; LAS float* Bc = Li + 64; LAS float* Mt = Bc + 64; LAS float* Iw = Mt + 64; LAS float* Wg = Iw + 64; LAS float* Qn = Wg + 64;
    LAS float* Inv = Qn + 64; LAS float* Nv = Inv + 64; LAS float* Sc = Nv + 64; LAS float* Np = Sc + 64;
    const int L = P.layer; const float ib = P.m_i_bias[L * 4 + h], fb = P.m_f_bias[L * 4 + h];
    const int l = c.tid >> 3, part = c.tid & 7;
    f32x4 Cst[2] = {{0.f, 0.f, 0.f, 0.f}, {0.f, 0.f, 0.f, 0.f}};
    for (int i = c.tid; i < 64 * LD; i += 512) Cb[i] = 0;
    if (c.tid < 64) Nv[c.tid] = 0.f;
    if (c.tid == 0) { Sc[0] = 1.f; Sc[1] = 0.f; }
    __syncthreads();
    u32x4 qw, kw, vw, ow; float gi = 0.f, gf = 0.f;
#define ML_FETCH(S0) do { const int t_ = b * SEQ + (S0) + l; const GAS bf16_t* pr = P.proj + (size_t)t_ * NINP + OFF_M + h * 64 + part * 8; \
        qw = *(const GAS u32x4*)pr; kw = *(const GAS u32x4*)(pr + 256); vw = *(const GAS u32x4*)(pr + 512); ow = *(const GAS u32x4*)(pr + 768); \
        if (part == 0) { gi = ldp(P.proj, t_, OFF_M + 1024 + h); gf = ldp(P.proj, t_, OFF_M + 1028 + h); } } while (0)
    ML_FETCH(0);
    for (int s0 = 0; s0 < SEQ; s0 += 64) {
        const int t = b * SEQ + s0 + l;
        {
          *(LAS u32x4*)(Qs + l * LD + part * 8) = qw;
          const unsigned kk[4] = {kw.x, kw.y, kw.z, kw.w}, vv[4] = {vw.x, vw.y, vw.z, vw.w}, oo[4] = {ow.x, ow.y, ow.z, ow.w};
          u32x4 ks;
#pragma unroll
          for (int j = 0; j < 4; ++j) { const float k0 = pg8::bflo(kk[j]) * 0.125f, k1 = pg8::bfhi(kk[j]) * 0.125f; const unsigned pk = pack_bf16(k0, k1);
              if (j == 0) ks.x = pk; else if (j == 1) ks.y = pk; else if (j == 2) ks.z = pk; else ks.w = pk;
              KT[(part * 8 + 2 * j) * LD + l] = (bf16_t)(pk & 0xFFFFu); KT[(part * 8 + 2 * j + 1) * LD + l] = (bf16_t)(pk >> 16);
              VT[(part * 8 + 2 * j) * LD + l] = (bf16_t)(vv[j] & 0xFFFFu); VT[(part * 8 + 2 * j + 1) * LD + l] = (bf16_t)(vv[j] >> 16);
              Og[l * 64 + part * 8 + 2 * j] = sigmoidf_(pg8::bflo(oo[j])); Og[l * 64 + part * 8 + 2 * j + 1] = sigmoidf_(pg8::bfhi(oo[j])); }
          *(LAS u32x4*)(Ks + l * LD + part * 8) = ks;
          if (part == 0) { Li[l] = gi + ib; Bc[l] = -softplusf_(-(gf + fb)); } }
        if (s0 + 64 < SEQ) ML_FETCH(s0 + 64);
        __syncthreads();
        if (c.wave == 1 && s0 > 0) { float acc = 0.f;
#pragma unroll
            for (int j = 0; j < 8; ++j) acc += Np[j * 64 + c.lane];
            Nv[c.lane] = acc; }
        if (c.wave == 0) {
            const float mprev = Sc[1]; const float li = Li[c.lane];
            const float bb = wave_scan_add(Bc[c.lane], c.lane);
            const float g = lane63(bb);
            const float pm = wave_scan_max(li - bb, c.lane);
            const float a = g - bb + li; const float amax = lane63(wave_scan_max(a, c.lane));
            const float mt = fmaxf(bb + mprev, bb + pm);
            const float mnew = fmaxf(g + mprev, amax);
            Bc[c.lane] = bb; Mt[c.lane] = mt; Iw[c.lane] = __expf(bb + mprev - mt); Wg[c.lane] = __expf(a - mnew);
            if (c.lane == 0) { Sc[0] = __expf(g + mprev - mnew); Sc[1] = mnew; }
        }
        __syncthreads();
        mm_lds(Qs, LD, Ks, LD, 64, 64, 64, c.wave, c.lane, [&](int row, int col0, const f32x4& a) {
            const float bl = Bc[row] - Mt[row]; f32x4 o;
#pragma unroll
            for (int j = 0; j < 4; ++j) { const int sidx = col0 + j; o[j] = (sidx <= row) ? a[j] * __expf(bl - Bc[sidx] + Li[sidx]) : 0.f; }
            st_bf16x4(Sb + row * LD + col0, o); });
        {
          const u32x4 vt = *(const LAS u32x4*)(VT + l * LD + part * 8); const f32x4 w0 = *(const LAS f32x4*)(Wg + part * 8), w1 = *(const LAS f32x4*)(Wg + part * 8 + 4);
          u32x4 o; o.x = pack_bf16(pg8::bflo(vt.x) * w0[0], pg8::bfhi(vt.x) * w0[1]); o.y = pack_bf16(pg8::bflo(vt.y) * w0[2], pg8::bfhi(vt.y) * w0[3]);
          o.z = pack_bf16(pg8::bflo(vt.z) * w1[0], pg8::bfhi(vt.z) * w1[1]); o.w = pack_bf16(pg8::bflo(vt.w) * w1[2], pg8::bfhi(vt.w) * w1[3]);
          *(LAS u32x4*)(VwT + l * LD + part * 8) = o;
          const u32x4 qw = *(const LAS u32x4*)(Qs + l * LD + part * 8); const f32x4 n0 = *(const LAS f32x4*)(Nv + part * 8), n1 = *(const LAS f32x4*)(Nv + part * 8 + 4);
          float d = pg8::bflo(qw.x) * n0[0] + pg8::bfhi(qw.x) * n0[1] + pg8::bflo(qw.y) * n0[2] + pg8::bfhi(qw.y) * n0[3]
                  + pg8::bflo(qw.z) * n1[0] + pg8::bfhi(qw.z) * n1[1] + pg8::bflo(qw.w) * n1[2] + pg8::bfhi(qw.w) * n1[3];
          d = red8(d); if (part == 0) Qn[l] = d; }
        __syncthreads();
        mm_lds2(Sb, LD, VT, LD, 64, Qs, LD, Cb, LD, 64, 64, 64, c.wave, c.lane, [&](int row, int col0, const f32x4& a1, const f32x4& a2) {
            const float iw = Iw[row]; *(LAS f32x4*)(Hn + row * 64 + col0) = a1 + a2 * iw; });
        { const u32x4 sw = *(const LAS u32x4*)(Sb + l * LD + part * 8);
          float rs = (pg8::bflo(sw.x) + pg8::bfhi(sw.x)) + (pg8::bflo(sw.y) + pg8::bfhi(sw.y)) + (pg8::bflo(sw.z) + pg8::bfhi(sw.z)) + (pg8::bflo(sw.w) + pg8::bfhi(sw.w));
          rs = red8(rs);
          if (part == 0) { const float den = rs + Iw[l] * Qn[l]; Inv[l] = rcpf_(fmaxf(fabsf(den), __expf(-Mt[l]))); } }
        __syncthreads();
        { const float dec = Sc[0];
          mm_lds_state<2>(VwT, LD, KT, LD, 4, 64, c.wave, c.lane, Cst, dec, [&](int row, int col0, const f32x4& a) { st_bf16x4(Cb + row * LD + col0, a); });
          { float acc = (c.wave == 0) ? dec * Nv[c.lane] : 0.f;
#pragma unroll
            for (int j = 0; j < 8; ++j) acc += Wg[c.wave * 8 + j] * bf2f(Ks[(c.wave * 8 + j) * LD + c.lane]);
            Np[c.wave * 64 + c.lane] = acc; }
          const float inv = Inv[l]; f32x4 h0 = *(const LAS f32x4*)(Hn + l * 64 + part * 8) * inv, h1 = *(const LAS f32x4*)(Hn + l * 64 + part * 8 + 4) * inv;
          float ss = (h0[0] * h0[0] + h0[1] * h0[1]) + (h0[2] * h0[2] + h0[3] * h0[3]) + (h1[0] * h1[0] + h1[1] * h1[1]) + (h1[2] * h1[2] + h1[3] * h1[3]);
          ss = red8(ss); const float rsn = rsqrtf(ss * (1.0f / 64.0f) + 1e-6f);
          const f32x4 g0 = *(const LAS f32x4*)(Og + l * 64 + part * 8), g1 = *(const LAS f32x4*)(Og + l * 64 + part * 8 + 4);
          const GAS float* nw = P.m_norm_w + L * 256 + h * 64 + part * 8; const f32x4 w0 = *(const GAS f32x4*)nw, w1 = *(const GAS f32x4*)(nw + 4);
          h0 = h0 * rsn * w0 * g0; h1 = h1 * rsn * w1 * g1;
          u32x4 o; o.x = pack_bf16(h0[0], h0[1]); o.y = pack_bf16(h0[2], h0[3]); o.z = pack_bf16(h1[0], h1[1]); o.w = pack_bf16(h1[2], h1[3]);
          *(GAS u32x4*)(P.mix + (size_t)t * D + h * 64 + part * 8) = o; }
        __syncthreads();
    }
}
constexpr size_t RWB_CHUNK = 8 * 16 * 64;
DI GAS float* rw_block(GAS float* ops, int b, int h, int chunk16) { return ops + ((size_t)((b * 4 + h) * (SEQ / 16) + chunk16)) * RWB_CHUNK; }

#define RLX_AGENT __ATOMIC_RELAXED, __HIP_MEMORY_SCOPE_AGENT
DI void rwkv_prep(const Ctx& c, const MixP& P, GAS float* ops, int b, int h, int sp, GAS unsigned* fl, unsigned epoch) {
    constexpr int TC2 = 32;
    LAS bf16_t* W2T = (LAS bf16_t*)c.lds;
    LAS bf16_t* A2T = W2T + 64 * 40;
    LAS bf16_t* G2T = A2T + 64 * 40;
    LAS bf16_t* LoB = G2T + 64 * 72;
    LAS float* WL = (LAS float*)(c.lds + 28160); LAS float* AL = WL + TC2 * 64; LAS float* Gl = AL + TC2 * 64;
    LAS float* MU = Gl + TC2 * 64;
    LAS float* CH = MU + 320;
    const int L = P.layer; const int tt = c.tid >> 4, part = c.tid & 15;
    for (int i = c.tid; i < 2048; i += 512) { const int r = i >> 6, j = i & 63;
        W2T[j * 40 + r] = f2bf(P.r_w2[(size_t)(L * 32 + r) * 256 + h * 64 + j]); A2T[j * 40 + r] = f2bf(P.r_a2[(size_t)(L * 32 + r) * 256 + h * 64 + j]); }
    for (int i = c.tid; i < 4096; i += 512) { const int r = i >> 6, j = i & 63; G2T[j * 72 + r] = f2bf(P.r_g2[(size_t)(L * 64 + r) * 256 + h * 64 + j]); }
    if (c.tid < 320) { const int i = c.tid; MU[i] = P.r_mu[L * 896 + ((i < 192) ? ((i >> 6) * 256 + h * 64 + (i & 63)) : (768 + i - 192))]; }
    if (c.tid < 64) { const int hj = L * 256 + h * 64 + c.tid;
        CH[c.tid] = P.r_w0[hj]; CH[64 + c.tid] = P.r_a0[hj]; CH[128 + c.tid] = P.r_k_k[hj]; CH[192 + c.tid] = P.r_k_a[hj]; CH[256 + c.tid] = P.r_r_k[hj]; }
    u32x4 lc, lp; u32x2 rc, rp, kc, kp, vc, vp;
#define RWKV_FETCH(S0) do { const int s_ = (S0) + tt; const GAS bf16_t* cur_ = P.proj + (size_t)(b * SEQ + s_) * NINP + OFF_R; const GAS bf16_t* prv_ = cur_ - NINP; const bool hp_ = s_ > 0; \
        lc = *(const GAS u32x4*)(cur_ + 768 + part * 8); lp = hp_ ? *(const GAS u32x4*)(prv_ + 768 + part * 8) : (u32x4){0u, 0u, 0u, 0u}; \
        rc = *(const GAS u32x2*)(cur_ + h * 64 + part * 4); rp = hp_ ? *(const GAS u32x2*)(prv_ + h * 64 + part * 4) : (u32x2){0u, 0u}; \
        kc = *(const GAS u32x2*)(cur_ + 256 + h * 64 + part * 4); kp = hp_ ? *(const GAS u32x2*)(prv_ + 256 + h * 64 + part * 4) : (u32x2){0u, 0u}; \
        vc = *(const GAS u32x2*)(cur_ + 512 + h * 64 + part * 4); vp = hp_ ? *(const GAS u32x2*)(prv_ + 512 + h * 64 + part * 4) : (u32x2){0u, 0u}; } while (0)
    const int sbeg = sp * (SEQ / 8), send = sbeg + SEQ / 8;
    const __amdgpu_buffer_rsrc_t rs = __builtin_amdgcn_make_buffer_rsrc((float*)ops, 0, 0x10000000, 0x00020000);
    RWKV_FETCH(sbeg);
    __syncthreads();
    for (int s0 = sbeg; s0 < send; s0 += TC2) {
        const u32x4 lc_ = lc, lp_ = lp; const u32x2 rc_ = rc, rp_ = rp, kc_ = kc, kp_ = kp, vc_ = vc, vp_ = vp;
        if (s0 + TC2 < send) RWKV_FETCH(s0 + TC2);
        { const unsigned cc[4] = {lc_.x, lc_.y, lc_.z, lc_.w}, pp[4] = {lp_.x, lp_.y, lp_.z, lp_.w}; float lo[8];
#pragma unroll
          for (int j = 0; j < 4; ++j) { const float c0 = pg8::bflo(cc[j]), c1 = pg8::bfhi(cc[j]);
              lo[2 * j] = c0 + (pg8::bflo(pp[j]) - c0) * MU[192 + part * 8 + 2 * j]; lo[2 * j + 1] = c1 + (pg8::bfhi(pp[j]) - c1) * MU[192 + part * 8 + 2 * j + 1]; }
#pragma unroll
          for (int j = 0; j < 8; ++j) { if (part < 4) lo[j] = tanhf_(lo[j]); else if (part >= 8) lo[j] = sigmoidf_(lo[j]); }
          u32x4 w; w.x = pack_bf16(lo[0], lo[1]); w.y = pack_bf16(lo[2], lo[3]); w.z = pack_bf16(lo[4], lo[5]); w.w = pack_bf16(lo[6], lo[7]);
          *(LAS u32x4*)(LoB + tt * 136 + part * 8) = w; }
        __syncthreads();
        mm_lds(LoB, 136, W2T, 40, TC2, 64, 32, c.wave, c.lane, [&](int row, int col0, const f32x4& a) { *(LAS f32x4*)(WL + row * 64 + col0) = a; });
        mm_lds(LoB + 32, 136, A2T, 40, TC2, 64, 32, c.wave, c.lane, [&](int row, int col0, const f32x4& a) { *(LAS f32x4*)(AL + row * 64 + col0) = a; });
        mm_lds(LoB + 64, 136, G2T, 72, TC2, 64, 64, c.wave, c.lane, [&](int row, int col0, const f32x4& a) { *(LAS f32x4*)(Gl + row * 64 + col0) = a; });
        __syncthreads();
        { float rv[4], kv[4], vv[4], kkr[4], av[4], wl[4], ss = 0.f;
          const float rcu[4] = {pg8::bflo(rc_.x), pg8::bfhi(rc_.x), pg8::bflo(rc_.y), pg8::bfhi(rc_.y)}, rpr[4] = {pg8::bflo(rp_.x), pg8::bfhi(rp_.x), pg8::bflo(rp_.y), pg8::bfhi(rp_.y)};
          const float kcu[4] = {pg8::bflo(kc_.x), pg8::bfhi(kc_.x), pg8::bflo(kc_.y), pg8::bfhi(kc_.y)}, kpr[4] = {pg8::bflo(kp_.x), pg8::bfhi(kp_.x), pg8::bflo(kp_.y), pg8::bfhi(kp_.y)};
          const float vcu[4] = {pg8::bflo(vc_.x), pg8::bfhi(vc_.x), pg8::bflo(vc_.y), pg8::bfhi(vc_.y)}, vpr[4] = {pg8::bflo(vp_.x), pg8::bfhi(vp_.x), pg8::bflo(vp_.y), pg8::bfhi(vp_.y)};
#pragma unroll
          for (int jj = 0; jj < 4; ++jj) { const int j = part * 4 + jj;
              rv[jj] = rcu[jj] + (rpr[jj] - rcu[jj]) * MU[j]; kv[jj] = kcu[jj] + (kpr[jj] - kcu[jj]) * MU[64 + j]; vv[jj] = vcu[jj] + (vpr[jj] - vcu[jj]) * MU[128 + j];
              kkr[jj] = kv[jj] * CH[128 + j]; ss += kkr[jj] * kkr[jj];
              av[jj] = sigmoidf_(CH[64 + j] + AL[tt * 64 + j]); wl[jj] = CH[j] + WL[tt * 64 + j]; }
          ss = red16(ss); const float inv = rsqrtf(fmaxf(ss, 1e-24f));
          f32x4 ld4;
#pragma unroll
          for (int jj = 0; jj < 4; ++jj) ld4[jj] = -0.60653065971f * sigmoidf_(wl[jj]);
          LAS float* DL = (LAS float*)LoB;
          *(LAS f32x4*)(DL + tt * 64 + part * 4) = ld4;
          __syncthreads();
          f32x4 cs = {0.f, 0.f, 0.f, 0.f};
          for (int t = (tt & ~15); t < tt; ++t) cs += *(const LAS f32x4*)(DL + t * 64 + part * 4);
          f32x4 o_d, o_kx, o_kk, o_kb; float bsum = 0.f;
#pragma unroll
          for (int jj = 0; jj < 4; ++jj) { const int j = part * 4 + jj;
              const float dprev = __expf(cs[jj]), dcur = dprev * __expf(ld4[jj]), dinv = rcpf_(dcur);
              const float kk = kkr[jj] * inv; const float kx = kv[jj] * (1.0f + (av[jj] - 1.0f) * CH[192 + j]);
              o_d[jj] = dcur; o_kx[jj] = kx * dinv; o_kk[jj] = kk * dprev; o_kb[jj] = kk * av[jj] * dinv;
              bsum += rv[jj] * kx * CH[256 + j]; rv[jj] *= dcur; }
          bsum = red16(bsum);
          const size_t blk0 = ((size_t)((b * 4 + h) * (SEQ / 16) + (s0 >> 4) + (tt >> 4))) * RWB_CHUNK;
          const unsigned off = (unsigned)((blk0 + (tt & 15) * 64 + part * 4) * 4);
#define RW_ST16(O, V) __builtin_amdgcn_raw_buffer_store_b128(__builtin_bit_cast(u32x4, V), rs, off + (O) * 4, 0, 16)
          const f32x4 o_r = {rv[0], rv[1], rv[2], rv[3]}, o_v = {vv[0], vv[1], vv[2], vv[3]}, o_g = *(const LAS f32x4*)(Gl + tt * 64 + part * 4);
          RW_ST16(0, o_r); RW_ST16(1024, o_d); RW_ST16(2048, o_kx); RW_ST16(3072, o_kk); RW_ST16(4096, o_kb); RW_ST16(5120, o_v); RW_ST16(6144, o_g);
#undef RW_ST16
          if (part == 0) __hip_atomic_store((GAS unsigned*)(ops + blk0 + 7168 + (tt & 15)), __builtin_bit_cast(unsigned, bsum), RLX_AGENT); }
        if (sp == 0) asm volatile("s_waitcnt vmcnt(0)" ::: "memory");
        __syncthreads();
        if (sp == 0 && c.tid == 0) __hip_atomic_store(fl + ((s0 - sbeg) >> 5), epoch, RLX_AGENT);
    }
    if (sp != 0) { asm volatile("s_waitcnt vmcnt(0)" ::: "memory"); __syncthreads(); if (c.tid == 0) __hip_atomic_store(fl + 7 + sp, epoch, RLX_AGENT); }
#undef RWKV_FETCH
}

DI float red8o(float v) { v += dppf<0xB1>(v); asm("" : "+v"(v)); v += dppf<0x4E>(v); asm("" : "+v"(v)); v += dppf<0x141>(v); asm("" : "+v"(v)); return v; }
DI void mix_rwkv_v5(const Ctx& c, const MixP& P, const GAS float* ops, int b, int h, const GAS unsigned* fl, unsigned epoch) {
    constexpr int CT = 16, NCH = SEQ / CT, BUFB = 8 * CT * 64 * 4 + 64;
    LAS float* CH = (LAS float*)c.lds;
    const int L = P.layer;
    if (c.tid < 64) { const int hj = L * 256 + h * 64 + c.tid; CH[c.tid] = P.r_ln_w[hj]; CH[64 + c.tid] = P.r_ln_b[hj]; }
#define RW_BUF(i) ((LAS float*)(c.lds + 512 + ((i) % 3) * BUFB))
    if (c.wave < 4) {
        const int ks = c.lane & 7, srow = c.wave * 16 + 2 * (c.lane >> 3);
        f32x2 Sa[4], Sb[4];
#pragma unroll
        for (int i = 0; i < 4; ++i) { Sa[i] = (f32x2){0.f, 0.f}; Sb[i] = (f32x2){0.f, 0.f}; }
        __syncthreads();
        __builtin_amdgcn_s_setprio(3);
#define RW_LOAD(Q, X) do { const int o_ = (X) * 64 + ks * 8; Q.k0 = *(const LAS f32x4*)(Kk + o_); Q.k1 = *(const LAS f32x4*)(Kk + o_ + 4); Q.v = *(const LAS f32x2*)(Vv + (X) * 64 + srow); \
            _Pragma("unroll") for (int i_ = 0; i_ < 2; ++i_) { Q.x[i_] = *(const LAS f32x4*)(Kx + o_ + 4 * i_); Q.b[i_] = *(const LAS f32x4*)(Kb + o_ + 4 * i_); Q.r[i_] = *(const LAS f32x4*)(Rr + o_ + 4 * i_); } } while (0)
#define RW_DOT(SS, Q, OUT) do { f32x2 p_ = SS[0] * (f32x2){Q.k0[0], Q.k0[1]}; p_ = SS[1] * (f32x2){Q.k0[2], Q.k0[3]} + p_; p_ = SS[2] * (f32x2){Q.k1[0], Q.k1[1]} + p_; p_ = SS[3] * (f32x2){Q.k1[2], Q.k1[3]} + p_; OUT = p_[0] + p_[1]; } while (0)
#define RW_OPQ(V) asm("" : "+v"(V))
#define RW_RS(V, C) do { V += dppf<C>(V); RW_OPQ(V); } while (0)
#define RW_RED4(A, B, C, D) do { RW_RS(A, 0xB1); RW_RS(B, 0xB1); RW_RS(C, 0xB1); RW_RS(D, 0xB1); RW_RS(A, 0x4E); RW_RS(B, 0x4E); RW_RS(C, 0x4E); RW_RS(D, 0x4E); \
            RW_RS(A, 0x141); RW_RS(B, 0x141); RW_RS(C, 0x141); RW_RS(D, 0x141); } while (0)
#define RW_RED2(A, B) do { RW_RS(A, 0xB1); RW_RS(B, 0xB1); RW_RS(A, 0x4E); RW_RS(B, 0x4E); RW_RS(A, 0x141); RW_RS(B, 0x141); } while (0)
#define RW_UPD(SS, VR, SA, Q, YP) do { const f32x2 vr2_ = {VR, VR}, sa2_ = {SA, SA}; f32x2 y_ = {0.f, 0.f}; \
            _Pragma("unroll") for (int i_ = 0; i_ < 2; ++i_) { \
                { const f32x2 t0_ = vr2_ * (f32x2){Q.x[i_][0], Q.x[i_][1]} + SS[2 * i_], t1_ = vr2_ * (f32x2){Q.x[i_][2], Q.x[i_][3]} + SS[2 * i_ + 1];     \
                  SS[2 * i_] = t0_ - sa2_ * (f32x2){Q.b[i_][0], Q.b[i_][1]}; SS[2 * i_ + 1] = t1_ - sa2_ * (f32x2){Q.b[i_][2], Q.b[i_][3]}; } \
                y_ = SS[2 * i_] * (f32x2){Q.r[i_][0], Q.r[i_][1]} + y_; y_ = SS[2 * i_ + 1] * (f32x2){Q.r[i_][2], Q.r[i_][3]} + y_; } \
            YP = y_[0] + y_[1]; } while (0)
#define RW_STEP(Q, X) do { float sa_, sb_; RW_DOT(Sa, Q, sa_); RW_DOT(Sb, Q, sb_); \
            if ((X) > 0) { RW_RED4(sa_, sb_, ypa, ypb); if (ks == 0) *(LAS f32x2*)(Yb + ((X) - 1) * 64 + srow) = (f32x2){ypa, ypb}; } else { RW_RED2(sa_, sb_); } \
            RW_UPD(Sa, Q.v[0], sa_, Q, ypa); RW_UPD(Sb, Q.v[1], sb_, Q, ypb); } while (0)
#define RW_FLUSH() do { RW_RED2(ypa, ypb); if (ks == 0) *(LAS f32x2*)(Yb + (CT - 1) * 64 + srow) = (f32x2){ypa, ypb}; \
            { const f32x4 e0_ = *(const LAS f32x4*)(Dd + (CT - 1) * 64 + ks * 8), e1_ = *(const LAS f32x4*)(Dd + (CT - 1) * 64 + ks * 8 + 4);     \
              Sa[0] *= (f32x2){e0_[0], e0_[1]}; Sa[1] *= (f32x2){e0_[2], e0_[3]}; Sa[2] *= (f32x2){e1_[0], e1_[1]}; Sa[3] *= (f32x2){e1_[2], e1_[3]}; \
              Sb[0] *= (f32x2){e0_[0], e0_[1]}; Sb[1] *= (f32x2){e0_[2], e0_[3]}; Sb[2] *= (f32x2){e1_[0], e1_[1]}; Sb[3] *= (f32x2){e1_[2], e1_[3]}; } } while (0)
#define RW_PAIR(X) do { RW_LOAD(B, (X) + 1); RW_STEP(A, X); if ((X) + 2 < CT) RW_LOAD(A, (X) + 2); RW_STEP(B, (X) + 1); } while (0)
        struct OpsK { f32x4 k0, k1, x[2], b[2], r[2]; f32x2 v; }; OpsK A, B; float ypa = 0.f, ypb = 0.f;
#pragma unroll 1
        for (int ci = 0; ci < NCH; ++ci) {
            LAS float* Rr = RW_BUF(ci); LAS float* Dd = Rr + CT * 64; LAS float* Kx = Dd + CT * 64; LAS float* Kk = Kx + CT * 64; LAS float* Kb = Kk + CT * 64; LAS float* Vv = Kb + CT * 64;
            LAS float* Yb = Vv + 2 * CT * 64;
            RW_LOAD(A, 0);
            RW_PAIR(0); RW_PAIR(2); RW_PAIR(4); RW_PAIR(6);
            RW_PAIR(8); RW_PAIR(10); RW_PAIR(12); RW_PAIR(14); RW_FLUSH();
            __syncthreads();
        }
        __builtin_amdgcn_s_setprio(0);
        __syncthreads();
#undef RW_LOAD
#undef RW_DOT
#undef RW_RED4
#undef RW_RED2
#undef RW_RS
#undef RW_OPQ
#undef RW_UPD
#undef RW_FLUSH
#undef RW_STEP
#undef RW_PAIR
    } else {
        const int pt = c.tid - 256, tt = pt >> 4, part = pt & 15;
        u32x4 g0[7], g1[7]; float gbo0 = 0.f, gbo1 = 0.f;
#define RW_PVLOAD() do { pv = (c.lane < 15) ? __hip_atomic_load((GAS unsigned*)fl + c.lane, RLX_AGENT) : epoch; } while (0)
#define RW_WAIT(CI) do { if ((CI) >= ready) { for (;;) { const unsigned long long m_ = __ballot(pv == epoch); int np_ = (~m_ != 0ull) ? __builtin_ctzll(~m_) : 15; np_ = np_ > 15 ? 15 : np_; \
              ready = __builtin_amdgcn_readfirstlane(np_ <= 8 ? 2 * np_ : 16 * (np_ - 7)); if ((CI) < ready) break; __builtin_amdgcn_s_sleep(1); RW_PVLOAD(); } \
              __builtin_amdgcn_fence(__ATOMIC_ACQUIRE, "agent"); } } while (0)
#define RW_FETCH(G, GBO, CI) do { RW_WAIT(CI); const GAS float* blk_ = rw_block((GAS float*)ops, b, h, (CI)); _Pragma("unroll") for (int i_ = 0; i_ < 7; ++i_) G[i_] = *(const GAS u32x4*)(blk_ + i_ * 1024 + pt * 4); if (pt < 16) GBO = blk_[7168 + pt]; } while (0)
#define RW_STASH(G, GBO, BUF) do { _Pragma("unroll") for (int i_ = 0; i_ < 7; ++i_) *(LAS u32x4*)((BUF) + i_ * 1024 + pt * 4) = G[i_]; if (pt < 16) (BUF)[8 * CT * 64 + pt] = GBO; } while (0)
#define RW_POST(BUF, CI) do { LAS float* Vv = (BUF) + 5 * CT * 64; LAS float* Gg = Vv + CT * 64; LAS float* Yb = Gg + CT * 64; LAS float* Bo = (BUF) + 8 * CT * 64; \
          float yv[4], sm = 0.f; \
          _Pragma("unroll") for (int jj = 0; jj < 4; ++jj) { yv[jj] = Yb[tt * 64 + part * 4 + jj]; sm += yv[jj]; } \
          const float mean = red16(sm) * (1.0f / 64.0f); float q = 0.f; \
          _Pragma("unroll") for (int jj = 0; jj < 4; ++jj) { yv[jj] -= mean; q += yv[jj] * yv[jj]; } \
          const float rs = rsqrtf(red16(q) * (1.0f / 64.0f) + 64e-5f); const float bo = Bo[tt]; float o[4]; \
          _Pragma("unroll") for (int jj = 0; jj < 4; ++jj) { const int j = part * 4 + jj; \
              const float yn = yv[jj] * rs * CH[j] + CH[64 + j]; o[jj] = (yn + bo * Vv[tt * 64 + j]) * Gg[tt * 64 + j]; } \
          u32x2 w; w.x = pack_bf16(o[0], o[1]); w.y = pack_bf16(o[2], o[3]); \
          *(GAS u32x2*)(P.mix + (size_t)(b * SEQ + (CI) * CT + tt) * D + 512 + h * 64 + part * 4) = w; } while (0)
        unsigned pv; int ready = 0;
        RW_PVLOAD(); RW_FETCH(g0, gbo0, 0); RW_STASH(g0, gbo0, RW_BUF(0)); RW_FETCH(g1, gbo1, 1);
        __syncthreads();
        RW_PVLOAD(); RW_FETCH(g0, gbo0, 2);
#pragma unroll 1
        for (int ci = 0; ci < NCH; ci += 2) {
            if (ci + 3 < NCH && ci + 3 >= ready) RW_PVLOAD();
            if (ci > 0) RW_POST(RW_BUF(ci - 1), ci - 1);
            RW_STASH(g1, gbo1, RW_BUF(ci + 1)); if (ci + 3 < NCH) RW_FETCH(g1, gbo1, ci + 3);
            __syncthreads();
            if (ci + 4 < NCH && ci + 4 >= ready) RW_PVLOAD();
            RW_POST(RW_BUF(ci), ci);
            if (ci + 2 < NCH) { RW_STASH(g0, gbo0, RW_BUF(ci + 2)); if (ci + 4 < NCH) RW_FETCH(g0, gbo0, ci + 4); }
            __syncthreads();
        }
        RW_POST(RW_BUF(NCH - 1), NCH - 1);
        __syncthreads();
#undef RW_FETCH
#undef RW_WAIT
#undef RW_PVLOAD
#undef RW_STASH
#undef RW_POST
    }
#undef RW_BUF
}
DI void mix_ssd_v3(const Ctx& c, const MixP& P, int b, int g) {
    constexpr int LD = 72, RL = 264;
    LAS bf16_t* Cm = (LAS bf16_t*)c.lds; LAS bf16_t* Bm = Cm + 64 * LD; LAS bf16_t* BmT = Bm + 64 * LD;
    LAS bf16_t* XT = BmT + 64 * LD;
    LAS bf16_t* Stb = XT + 128 * LD;
    LAS float* Yz = (LAS float*)(c.lds + 64512);
    LAS bf16_t* Wm = (LAS bf16_t*)(c.lds + 97280); LAS bf16_t* XdT = Wm + 64 * LD;
    LAS bf16_t* Wm1 = XdT + 64 * LD; LAS bf16_t* XdT1 = Wm1 + 64 * LD;
    LAS bf16_t* RAW = (LAS bf16_t*)(c.lds + 64512);
    LAS float* Dt = (LAS float*)(c.lds + 134144); LAS float* Ac = Dt + 128;
    LAS float* CW = Ac + 128;
    const int L = P.layer; const int l = c.tid >> 3, part = c.tid & 7;
    f32x4 St0[2] = {{0.f, 0.f, 0.f, 0.f}, {0.f, 0.f, 0.f, 0.f}}, St1[2] = {{0.f, 0.f, 0.f, 0.f}, {0.f, 0.f, 0.f, 0.f}};
    for (int i = c.tid; i < 128 * LD; i += 512) Stb[i] = 0;
    for (int i = c.tid; i < 1280; i += 512) { const int k = i >> 8, ch = i & 255;
        const int xi = (ch < 128) ? (g * 128 + ch) : ((ch < 192) ? (256 + g * 64 + (ch - 128)) : (384 + g * 64 + (ch - 192)));
        CW[i] = (k < 4) ? P.s_conv_w[(L * 4 + k) * 512 + xi] : P.s_conv_b[L * 512 + xi]; }
    const float dsk0 = P.s_d[L * 4 + 2 * g], dsk1 = P.s_d[L * 4 + 2 * g + 1];
    const float dtb = (part < 2) ? P.s_dt_bias[L * 4 + 2 * g + part] : 0.f, aneg = (part < 2) ? -__expf(P.s_a_log[L * 4 + 2 * g + part]) : 0.f;
    u32x4 rx[3], rbm[2], rcm[2]; float dtr = 0.f;
#define SSD_FETCH(S0) do { \
        _Pragma("unroll") for (int i_ = 0; i_ < 3; ++i_) { const int p_ = c.tid + 512 * i_; if (p_ < 1072) { const int r_ = p_ >> 4, c8_ = p_ & 15, s_ = (S0) - 3 + r_; \
            rx[i_] = (s_ >= 0) ? *(const GAS u32x4*)(P.proj + (size_t)(b * SEQ + s_) * NINP + OFF_S + 256 + g * 128 + c8_ * 8) : (u32x4){0u, 0u, 0u, 0u}; } } \
        _Pragma("unroll") for (int i_ = 0; i_ < 2; ++i_) { const int p_ = c.tid + 512 * i_; if (p_ < 536) { const int r_ = p_ >> 3, c8_ = p_ & 7, s_ = (S0) - 3 + r_; \
            const GAS bf16_t* q_ = P.proj + (size_t)(b * SEQ + (s_ >= 0 ? s_ : 0)) * NINP + OFF_S + 512 + g * 64 + c8_ * 8; \
            rbm[i_] = (s_ >= 0) ? *(const GAS u32x4*)q_ : (u32x4){0u, 0u, 0u, 0u}; rcm[i_] = (s_ >= 0) ? *(const GAS u32x4*)(q_ + 128) : (u32x4){0u, 0u, 0u, 0u}; } } \
        if (part < 2) dtr = ldp(P.proj, b * SEQ + (S0) + l, OFF_S + 768 + 2 * g + part); } while (0)
#define SSD_STASH() do { \
        _Pragma("unroll") for (int i_ = 0; i_ < 3; ++i_) { const int p_ = c.tid + 512 * i_; if (p_ < 1072) *(LAS u32x4*)(RAW + (p_ >> 4) * RL + (p_ & 15) * 8) = rx[i_]; } \
        _Pragma("unroll") for (int i_ = 0; i_ < 2; ++i_) { const int p_ = c.tid + 512 * i_; if (p_ < 536) { *(LAS u32x4*)(RAW + (p_ >> 3) * RL + 128 + (p_ & 7) * 8) = rbm[i_]; *(LAS u32x4*)(RAW + (p_ >> 3) * RL + 192 + (p_ & 7) * 8) = rcm[i_]; } } } while (0)
    SSD_FETCH(0);
    __syncthreads();
    for (int s0 = 0; s0 < SEQ; s0 += 64) {
        const int t = b * SEQ + s0 + l;
        SSD_STASH();
        if (part < 2) { const float dt = softplusf_(dtr + dtb); Dt[l * 2 + part] = dt; Ac[l * 2 + part] = aneg * dt; }
        __syncthreads();
        if (s0 + 64 < SEQ) SSD_FETCH(s0 + 64);
#pragma unroll
        for (int gq = 0; gq < 4; ++gq) { const int ch0 = part * 32 + gq * 8; float acc[8];
#pragma unroll
            for (int j = 0; j < 8; ++j) acc[j] = CW[1024 + ch0 + j];
#pragma unroll
            for (int k = 0; k < 4; ++k) { const u32x4 rw = *(const LAS u32x4*)(RAW + (l + k) * RL + ch0); const f32x4 w0 = *(const LAS f32x4*)(CW + k * 256 + ch0), w1 = *(const LAS f32x4*)(CW + k * 256 + ch0 + 4);
                acc[0] += w0[0] * pg8::bflo(rw.x); acc[1] += w0[1] * pg8::bfhi(rw.x); acc[2] += w0[2] * pg8::bflo(rw.y); acc[3] += w0[3] * pg8::bfhi(rw.y);
                acc[4] += w1[0] * pg8::bflo(rw.z); acc[5] += w1[1] * pg8::bfhi(rw.z); acc[6] += w1[2] * pg8::bflo(rw.w); acc[7] += w1[3] * pg8::bfhi(rw.w); }
            bf16_t v[8];
#pragma unroll
            for (int j = 0; j < 8; ++j) v[j] = f2bf(siluf_(acc[j]));
            if (ch0 < 128) {
#pragma unroll
                for (int j = 0; j < 8; ++j) XT[(ch0 + j) * LD + l] = v[j];
            } else { u32x4 w; w.x = (unsigned)v[0] | ((unsigned)v[1] << 16); w.y = (unsigned)v[2] | ((unsigned)v[3] << 16); w.z = (unsigned)v[4] | ((unsigned)v[5] << 16); w.w = (unsigned)v[6] | ((unsigned)v[7] << 16);
                if (ch0 < 192) { *(LAS u32x4*)(Bm + l * LD + ch0 - 128) = w;
#pragma unroll
                    for (int j = 0; j < 8; ++j) BmT[(ch0 - 128 + j) * LD + l] = v[j]; }
                else *(LAS u32x4*)(Cm + l * LD + ch0 - 192) = w; } }
        if (c.wave < 2) { const float v = wave_scan_add(Ac[c.lane * 2 + c.wave], c.lane); Ac[c.lane * 2 + c.wave] = v; }
        __syncthreads();
        { const float alast0 = Ac[63 * 2], alast1 = Ac[63 * 2 + 1];
          mm_lds(Cm, LD, Bm, LD, 64, 64, 64, c.wave, c.lane, [&](int row, int col0, const f32x4& a) {
              const float al0 = Ac[row * 2], al1 = Ac[row * 2 + 1]; f32x4 o0, o1;
#pragma unroll
              for (int j = 0; j < 4; ++j) { const int sidx = col0 + j; const bool in = sidx <= row;
                  o0[j] = in ? a[j] * __expf(al0 - Ac[sidx * 2]) * Dt[sidx * 2] : 0.f; o1[j] = in ? a[j] * __expf(al1 - Ac[sidx * 2 + 1]) * Dt[sidx * 2 + 1] : 0.f; }
              st_bf16x4(Wm + row * LD + col0, o0); st_bf16x4(Wm1 + row * LD + col0, o1); });
#pragma unroll
          for (int w = 0; w < 2; ++w) { const float alast = w ? alast1 : alast0;
              const u32x4 xt = *(const LAS u32x4*)(XT + (w * 64 + l) * LD + part * 8); float f[8];
#pragma unroll
              for (int j = 0; j < 8; ++j) { const int sidx = part * 8 + j; f[j] = Dt[sidx * 2 + w] * __expf(alast - Ac[sidx * 2 + w]); }
              u32x4 o; o.x = pack_bf16(pg8::bflo(xt.x) * f[0], pg8::bfhi(xt.x) * f[1]); o.y = pack_bf16(pg8::bflo(xt.y) * f[2], pg8::bfhi(xt.y) * f[3]);
              o.z = pack_bf16(pg8::bflo(xt.z) * f[4], pg8::bfhi(xt.z) * f[5]); o.w = pack_bf16(pg8::bflo(xt.w) * f[6], pg8::bfhi(xt.w) * f[7]);
              *(LAS u32x4*)((w ? XdT1 : XdT) + l * LD + part * 8) = o; }
          __syncthreads();
#pragma unroll
          for (int w = 0; w < 2; ++w) { const float dsk = w ? dsk1 : dsk0;
              mm_lds2(w ? Wm1 : Wm, LD, XT + w * 64 * LD, LD, 64, Cm, LD, Stb + w * 64 * LD, LD, 64, 64, 64, c.wave, c.lane, [&](int row, int col0, const f32x4& a1, const f32x4& a2) {
                const float e = __expf(Ac[row * 2 + w]); f32x4 o;
#pragma unroll
                for (int j = 0; j < 4; ++j) o[j] = a1[j] + e * a2[j] + dsk * bf2f(XT[(w * 64 + col0 + j) * LD + row]);
                *(LAS f32x4*)(Yz + row * 128 + w * 64 + col0) = o; }); }
          __syncthreads();
          mm_lds_state<2>(XdT, LD, BmT, LD, 4, 64, c.wave, c.lane, St0, __expf(alast0), [&](int row, int col0, const f32x4& a) { st_bf16x4(Stb + row * LD + col0, a); });
          mm_lds_state<2>(XdT1, LD, BmT, LD, 4, 64, c.wave, c.lane, St1, __expf(alast1), [&](int row, int col0, const f32x4& a) { st_bf16x4(Stb + (64 + row) * LD + col0, a); });
        }
        { const GAS bf16_t* zp = P.proj + (size_t)t * NINP + OFF_S + g * 128 + part * 16; const u32x4 z0 = *(const GAS u32x4*)zp, z1 = *(const GAS u32x4*)(zp + 8);
          const unsigned zz[8] = {z0.x, z0.y, z0.z, z0.w, z1.x, z1.y, z1.z, z1.w};
          float yz[16], ss = 0.f;
#pragma unroll
          for (int j = 0; j < 8; ++j) { const float a = Yz[l * 128 + part * 16 + 2 * j] * siluf_(pg8::bflo(zz[j])), bq = Yz[l * 128 + part * 16 + 2 * j + 1] * siluf_(pg8::bfhi(zz[j]));
              yz[2 * j] = a; yz[2 * j + 1] = bq; ss += a * a + bq * bq; }
          ss = red8(ss); const float rs = rsqrtf(ss * (1.0f / 128.0f) + 1e-6f);
          const GAS float* nw = P.s_norm_w + L * 256 + g * 128 + part * 16;
          unsigned ow[8];
#pragma unroll
          for (int j = 0; j < 8; ++j) ow[j] = pack_bf16(yz[2 * j] * rs * nw[2 * j], yz[2 * j + 1] * rs * nw[2 * j + 1]);
          u32x4 o0, o1; o0.x = ow[0]; o0.y = ow[1]; o0.z = ow[2]; o0.w = ow[3]; o1.x = ow[4]; o1.y = ow[5]; o1.z = ow[6]; o1.w = ow[7];
          GAS bf16_t* mp = P.mix + (size_t)t * D + 768 + g * 128 + part * 16; *(GAS u32x4*)mp = o0; *(GAS u32x4*)(mp + 8) = o1; }
        __syncthreads();
    }
}

DI void mix_rglru_v2(const Ctx& c, const MixP& P, int b, int h) {
    constexpr int LD = 72, RL = 136;
    LAS bf16_t* WaT = (LAS bf16_t*)c.lds; LAS bf16_t* WxT = WaT + 64 * LD; LAS bf16_t* XCb = WxT + 64 * LD;
    LAS bf16_t* RAW = XCb + 64 * LD;
    LAS float* XCf = (LAS float*)(c.lds + 45888); LAS float* Av = XCf + 4096; LAS float* Uv = Av + 4096; LAS float* Gt = Uv + 4096;
    LAS float* CH = Gt + 4096;
    const int L = P.layer; const int l = c.tid >> 3, part = c.tid & 7;
    for (int i = c.tid; i < 4096; i += 512) { const int r = i >> 6, j = i & 63;
        WaT[j * LD + r] = f2bf(P.g_w_a[(size_t)(L * 4 + h) * 4096 + i]); WxT[j * LD + r] = f2bf(P.g_w_x[(size_t)(L * 4 + h) * 4096 + i]); }
    if (c.tid < 64) { const int hj = L * 256 + h * 64 + c.tid;
#pragma unroll
        for (int k = 0; k < 4; ++k) CH[k * 64 + c.tid] = P.g_conv_w[(L * 4 + k) * 256 + h * 64 + c.tid];
        CH[256 + c.tid] = P.g_conv_b[hj]; CH[320 + c.tid] = P.g_b_a[hj]; CH[384 + c.tid] = P.g_b_x[hj]; CH[448 + c.tid] = softplusf_(-P.g_lambda[hj]); }
    float hst = 0.f;
    u32x4 rxb[2], rgt[2];
#define RG_FETCH(S0) do { _Pragma("unroll") for (int i_ = 0; i_ < 2; ++i_) { const int p_ = c.tid + 512 * i_; if (p_ < 536) { const int r_ = p_ >> 3, c8_ = p_ & 7, s_ = (S0) - 3 + r_; \
            const GAS bf16_t* q_ = P.proj + (size_t)(b * SEQ + (s_ >= 0 ? s_ : 0)) * NINP + OFF_G + h * 64 + c8_ * 8; \
            rxb[i_] = (s_ >= 0) ? *(const GAS u32x4*)q_ : (u32x4){0u, 0u, 0u, 0u}; rgt[i_] = (s_ >= 0) ? *(const GAS u32x4*)(q_ + 256) : (u32x4){0u, 0u, 0u, 0u}; } } } while (0)
#define RG_STASH() do { _Pragma("unroll") for (int i_ = 0; i_ < 2; ++i_) { const int p_ = c.tid + 512 * i_; if (p_ < 536) { \
            *(LAS u32x4*)(RAW + (p_ >> 3) * RL + (p_ & 7) * 8) = rxb[i_]; *(LAS u32x4*)(RAW + (p_ >> 3) * RL + 64 + (p_ & 7) * 8) = rgt[i_]; } } } while (0)
    RG_FETCH(0);
    __syncthreads();
    for (int s0 = 0; s0 < SEQ; s0 += 64) {
        const int t = b * SEQ + s0 + l;
        RG_STASH();
        __syncthreads();
        if (s0 + 64 < SEQ) RG_FETCH(s0 + 64);
        { const int ch0 = part * 8; float acc[8];
#pragma unroll
          for (int j = 0; j < 8; ++j) acc[j] = CH[256 + ch0 + j];
#pragma unroll
          for (int k = 0; k < 4; ++k) { const u32x4 rw = *(const LAS u32x4*)(RAW + (l + k) * RL + ch0); const f32x4 w0 = *(const LAS f32x4*)(CH + k * 64 + ch0), w1 = *(const LAS f32x4*)(CH + k * 64 + ch0 + 4);
              acc[0] += w0[0] * pg8::bflo(rw.x); acc[1] += w0[1] * pg8::bfhi(rw.x); acc[2] += w0[2] * pg8::bflo(rw.y); acc[3] += w0[3] * pg8::bfhi(rw.y);
              acc[4] += w1[0] * pg8::bflo(rw.z); acc[5] += w1[1] * pg8::bfhi(rw.z); acc[6] += w1[2] * pg8::bflo(rw.w); acc[7] += w1[3] * pg8::bfhi(rw.w); }
          u32x4 w; w.x = pack_bf16(acc[0], acc[1]); w.y = pack_bf16(acc[2], acc[3]); w.z = pack_bf16(acc[4], acc[5]); w.w = pack_bf16(acc[6], acc[7]);
          *(LAS u32x4*)(XCb + l * LD + ch0) = w;
          *(LAS f32x4*)(XCf + l * 64 + ch0) = (f32x4){acc[0], acc[1], acc[2], acc[3]}; *(LAS f32x4*)(XCf + l * 64 + ch0 + 4) = (f32x4){acc[4], acc[5], acc[6], acc[7]};
          const u32x4 gw = *(const LAS u32x4*)(RAW + (l + 3) * RL + 64 + ch0);
          *(LAS f32x4*)(Gt + l * 64 + ch0) = (f32x4){gelu_tanhf_(pg8::bflo(gw.x)), gelu_tanhf_(pg8::bfhi(gw.x)), gelu_tanhf_(pg8::bflo(gw.y)), gelu_tanhf_(pg8::bfhi(gw.y))};
          *(LAS f32x4*)(Gt + l * 64 + ch0 + 4) = (f32x4){gelu_tanhf_(pg8::bflo(gw.z)), gelu_tanhf_(pg8::bfhi(gw.z)), gelu_tanhf_(pg8::bflo(gw.w)), gelu_tanhf_(pg8::bfhi(gw.w))}; }
        __syncthreads();
        mm_lds2(XCb, LD, WaT, LD, 64, XCb, LD, WxT, LD, 64, 64, 64, c.wave, c.lane, [&](int row, int col0, const f32x4& a1, const f32x4& a2) {
            const f32x4 xc = *(const LAS f32x4*)(XCf + row * 64 + col0); f32x4 av, uv;
#pragma unroll
            for (int j = 0; j < 4; ++j) { const int ch = col0 + j; const float r = sigmoidf_(a1[j] + CH[320 + ch]), ig = sigmoidf_(a2[j] + CH[384 + ch]);
                const float la = -8.0f * CH[448 + ch] * r; av[j] = __expf(la); uv[j] = sqrtf(fmaxf(1.0f - __expf(2.0f * la), 0.f)) * (ig * xc[j]); }
            *(LAS f32x4*)(Av + row * 64 + col0) = av; *(LAS f32x4*)(Uv + row * 64 + col0) = uv; });
        __syncthreads();
        if (c.wave == 0) {
#pragma unroll 1
            for (int x0 = 0; x0 < 64; x0 += 8) { float a[8], u[8];
#pragma unroll
                for (int j = 0; j < 8; ++j) { a[j] = Av[(x0 + j) * 64 + c.lane]; u[j] = Uv[(x0 + j) * 64 + c.lane]; }
#pragma unroll
                for (int j = 0; j < 8; ++j) { hst = a[j] * hst + u[j]; Uv[(x0 + j) * 64 + c.lane] = hst; } }
        }
        __syncthreads();
        { const f32x4 h0 = *(const LAS f32x4*)(Uv + l * 64 + part * 8) * *(const LAS f32x4*)(Gt + l * 64 + part * 8), h1 = *(const LAS f32x4*)(Uv + l * 64 + part * 8 + 4) * *(const LAS f32x4*)(Gt + l * 64 + part * 8 + 4);
          u32x4 o; o.x = pack_bf16(h0[0], h0[1]); o.y = pack_bf16(h0[2], h0[3]); o.z = pack_bf16(h1[0], h1[1]); o.w = pack_bf16(h1[2], h1[3]);
          *(GAS u32x4*)(P.mix + (size_t)t * D + 256 + h * 64 + part * 8) = o; }
        __syncthreads();
    }
}
constexpr size_t al256(size_t x) { return (x + 255) & ~(size_t)255; }
constexpr size_t WS_CTL = 0;
constexpr size_t CTL_BYTES = 65536;
constexpr int CW_BAR = 0;
constexpr int CW_CNT = 4096;
constexpr int CW_CUR = 4096 + 128;
constexpr int CW_Q = 4096 + 256;
constexpr int CW_RDY = 8192;
constexpr size_t SZ_WIN = (size_t)NINP * D * 2, SZ_WOUT = (size_t)D * D * 2, SZ_WPE = (size_t)D * PE_DIM * 2, SZ_WG = (size_t)D * D * 2;
constexpr size_t SZ_W13 = (size_t)NH2 * D * 2, SZ_W2 = (size_t)D * DFF * 2;
constexpr size_t WS_WIN = WS_CTL + CTL_BYTES, WS_WOUT = WS_WIN + SZ_WIN, WS_WPE = WS_WOUT + SZ_WOUT, WS_WG = WS_WPE + SZ_WPE, WS_W13 = WS_WG + SZ_WG, WS_W2 = WS_W13 + NE * SZ_W13;
constexpr size_t WS_XB = WS_W2 + NE * SZ_W2;
constexpr size_t WS_PB = WS_XB + (size_t)T * D * 2;
constexpr size_t WS_PE = WS_PB + (size_t)T * PE_DIM * 2;
constexpr size_t WS_H = WS_PE + (size_t)T * D * 2;
constexpr size_t SZ_PROJ = (size_t)T * NINP * 2, SZ_HMOE = (size_t)MOE_ROWS * DFF * 2;
constexpr size_t WS_MIX = WS_H + SZ_PROJ;
constexpr size_t WS_XG = WS_H + SZ_HMOE;
constexpr size_t WS_ROUTE = WS_XG + (size_t)MOE_ROWS * D * 2;
constexpr size_t WS_RWOPS = WS_XG;
constexpr size_t WS_PRE1 = WS_H;
constexpr size_t WS_PRE2 = WS_XG;
constexpr size_t WS_XB8 = WS_XG + (size_t)T * D * 2;
constexpr size_t WS_NEED = WS_RWOPS + (size_t)T * 4 * 8 * 64 * 4;
constexpr size_t WS_END = WS_ROUTE + (size_t)T * 32;
static_assert(SZ_PROJ + (size_t)T * D * 2 <= SZ_HMOE, "proj + mix inside the hidden region");
constexpr int LDS_BYTES = 147456;
constexpr int LDS_MISC = 146432;

#ifndef PHMASK
#define PHMASK 0x1FF
#endif
#define PHEN(k) ((PHMASK >> (k)) & 1)

#ifndef PHMASK
#define PHMASK 0x1FF
#endif
#define PHEN(k) ((PHMASK >> (k)) & 1)
struct Args { const float* in[45]; float* out; unsigned char* ws; int ph_lo, ph_hi; };
constexpr int NPH = 9;
constexpr int LDS_ARGS = LDS_MISC + 64;
#ifndef MOE_FP8
#define MOE_FP8 1
#endif
#ifndef DENSE_FP8
#define DENSE_FP8 0
#endif
#ifndef DENSE_FP8_DOWN
#define DENSE_FP8_DOWN 1
#endif
constexpr int MOE_EARLY = 4;
constexpr size_t MOE13_OFF = 4 * SZ_W13, MOE2_OFF = 4 * SZ_W2;
static_assert(MOE_FP8 == 1, "the early expert conversion needs the one-byte expert weights (two sets do not fit otherwise)");
constexpr float W13_SCALE = 64.0f, W2_SCALE = 256.0f;
#define PHASE_FN static __device__ __forceinline__ void
typedef const volatile LAS Args* LArgs;
DI Ctx make_ctx() { Ctx c; c.lds = (LAS unsigned char*)0; int t = threadIdx.x; asm volatile("" : "+v"(t)); int g = gridDim.x, b = blockIdx.x; asm volatile("" : "+s"(g), "+s"(b));
    c.tid = t; c.lane = t & 63; c.wave = __builtin_amdgcn_readfirstlane(t >> 6); c.G = g; c.bid = b; return c; }
DI const float* inp(LArgs a, int i) { return (const float*)rfl64((unsigned long long)a->in[i]); }
DI unsigned char* wsp(LArgs a) { return (unsigned char*)rfl64((unsigned long long)a->ws); }
DI float* outp(LArgs a) { return (float*)rfl64((unsigned long long)a->out); }

PHASE_FN ph_cvt_in(int L) {
    const Ctx c = make_ctx(); LArgs a = (LArgs)(LDS_ARGS); unsigned char* ws = wsp(a);
    int rot = 0;
    cvt_weight(c, inp(a, 2) + (size_t)L * D * NIN, (bf16_t*)(ws + WS_WIN), D, NIN, 0, 1, 0, 0, rot);
    cvt_weight(c, inp(a, 42) + (size_t)L * PE_DIM * D, (bf16_t*)(ws + WS_WPE), PE_DIM, D, 0, 1, 0, 0, rot);
    cvt_act(c, inp(a, 1) + (size_t)L * T * PE_DIM, (bf16_t*)(ws + WS_PB), (size_t)T * PE_DIM);
    if (L == 0) cvt_act(c, inp(a, 0), (bf16_t*)(ws + WS_XB), (size_t)T * D);
}
PHASE_FN ph_cvt_queue(int L) {
    const Ctx c = make_ctx(); LArgs a = (LArgs)(LDS_ARGS); unsigned char* ws = wsp(a);
    const bool moe = (L & 1) != 0; const int fi = L >> 1;
    unsigned* q = (unsigned*)(ws + WS_CTL) + CW_Q + 64 * L;
    volatile LAS int* slot = (volatile LAS int*)(c.lds + 67584);
    const int own = moe ? 3 * 704 * (NE - MOE_EARLY) : 3 * 704, total = 576 + own + (moe ? 0 : 3 * 704 * MOE_EARLY);
    struct TileD { const float* s; bf16_t* d; int K, N, mode, k0, n0; float wsc; };
    auto desc = [&](int idx, TileD& t) -> bool {
        if (idx >= total || (idx >= 256 && idx < 320)) return false;
        if (idx < 256) { t.s = inp(a, 30) + (size_t)L * D * D; t.d = (bf16_t*)(ws + WS_WOUT); t.K = D; t.N = D; t.mode = 0; t.wsc = 0.f; t.k0 = (idx >> 4) << 6; t.n0 = (idx & 15) << 6; }
        else if (idx < 576) { const int r = idx - 320; t.s = inp(a, 43) + (size_t)L * D * D; t.d = (bf16_t*)(ws + WS_WG); t.K = D; t.N = D; t.mode = 0; t.wsc = 0.f; t.k0 = (r >> 4) << 6; t.n0 = (r & 15) << 6; }
        else { int r = idx - 576; bool mt = moe; int eo = moe ? MOE_EARLY : 0, nbx = moe ? NE - MOE_EARLY : 1;
            if (!moe && r >= own) { r -= own; mt = true; eo = 0; nbx = MOE_EARLY; }
            const int ffn = 704 * nbx; const int which = r / ffn; r -= which * ffn; const int el = r / 704; r -= el * 704; const int e = eo + el;
            const float* src = inp(a, (mt ? 39 : 35) + which) + (size_t)((mt ? fi * NE : fi) + e) * D * DFF;
            if (which < 2) { t.s = src; t.K = D; t.N = DFF; t.mode = 1 + which; t.k0 = (r / 44) << 6; t.n0 = (r % 44) << 6;
                if (mt) { t.d = (bf16_t*)(ws + WS_W13 + MOE13_OFF + (size_t)e * NH2 * D); t.wsc = W13_SCALE; }
                else if (DENSE_FP8) { t.d = (bf16_t*)(ws + WS_W13); t.wsc = W13_SCALE; } else { t.d = (bf16_t*)(ws + WS_W13); t.wsc = 0.f; } }
            else { t.s = src; t.K = DFF; t.N = D; t.mode = 0; t.k0 = (r >> 4) << 6; t.n0 = (r & 15) << 6;
                if (mt) { t.d = (bf16_t*)(ws + WS_W2 + MOE2_OFF + (size_t)e * D * DFF); t.wsc = W2_SCALE; }
                else if (DENSE_FP8 || DENSE_FP8_DOWN) { t.d = (bf16_t*)(ws + WS_W2); t.wsc = W2_SCALE; } else { t.d = (bf16_t*)(ws + WS_W2); t.wsc = 0.f; } } }
        return true; };
    constexpr int NQ = 4;
    auto loadq = [&](const TileD& t, float (&r)[NQ][8]) {
#pragma unroll
        for (int qd = 0; qd < NQ; ++qd) {
#pragma unroll
            for (int i = 0; i < 8; ++i) r[qd][i] = t.s[(size_t)(t.k0 + i * 8 + (c.tid >> 6)) * t.N + t.n0 + 64 * qd + (c.tid & 63)]; } };
    LAS float* tiles = (LAS float*)c.lds;
    auto stageq = [&](const float (&r)[NQ][8]) {
#pragma unroll
        for (int qd = 0; qd < NQ; ++qd) {
#pragma unroll
            for (int j = 0; j < 8; ++j) tiles[qd * (64 * 65) + (j * 8 + (c.tid >> 6)) * 65 + (c.tid & 63)] = r[qd][j]; } };
    auto emitq = [&](const TileD& cur) {
#pragma unroll
        for (int qd = 0; qd < NQ; ++qd) { const LAS float* tile = tiles + qd * (64 * 65);
            const int n = c.tid >> 3, kk = (c.tid & 7) * 8, ng = cur.n0 + 64 * qd + n;
            int drow = ng; if (cur.mode == 1) drow = (ng >> 7) * 256 + (ng & 127); else if (cur.mode == 2) drow = (ng >> 7) * 256 + 128 + (ng & 127);
            if (cur.wsc == 0.f) { u32x4 w; w.x = pack_bf16(tile[(kk + 0) * 65 + n], tile[(kk + 1) * 65 + n]); w.y = pack_bf16(tile[(kk + 2) * 65 + n], tile[(kk + 3) * 65 + n]);
                w.z = pack_bf16(tile[(kk + 4) * 65 + n], tile[(kk + 5) * 65 + n]); w.w = pack_bf16(tile[(kk + 6) * 65 + n], tile[(kk + 7) * 65 + n]);
                *(u32x4*)(cur.d + (size_t)drow * cur.K + cur.k0 + kk) = w; }
            else { const float s_ = cur.wsc; u32x2 w8;
                w8.x = pg8::pk4_fp8(tile[(kk + 0) * 65 + n] * s_, tile[(kk + 1) * 65 + n] * s_, tile[(kk + 2) * 65 + n] * s_, tile[(kk + 3) * 65 + n] * s_);
                w8.y = pg8::pk4_fp8(tile[(kk + 4) * 65 + n] * s_, tile[(kk + 5) * 65 + n] * s_, tile[(kk + 6) * 65 + n] * s_, tile[(kk + 7) * 65 + n] * s_);
                *(u32x2*)((unsigned char*)cur.d + (size_t)drow * cur.K + cur.k0 + kk) = w8; } } };
    if (c.tid == 0) slot[0] = (int)atomicAdd(q, 8u);
    __syncthreads();
    int base = slot[0], pi = 0;
    __syncthreads();
    TileD cq, nq; float r[NQ][8];
    bool hq = desc(base, cq);
    if (hq) loadq(cq, r);
    int nb = 0;
#pragma unroll 1
    while (base < total) {
        if (hq) stageq(r);
        const bool last = (pi == 1);
        if (pi == 0 && c.tid == 0) nb = (int)atomicAdd(q, 8u);
        if (last && c.tid == 0) slot[0] = nb;
        __syncthreads();
        const int nbase = last ? slot[0] : base, npi = last ? 0 : pi + 1;
        const bool gq = desc(nbase + NQ * npi, nq);
        if (gq) loadq(nq, r);
        if (hq) emitq(cq);
        __syncthreads();
        cq = nq; hq = gq; base = nbase; pi = npi;
    }
}
PHASE_FN ph_proj(int L) {
    const Ctx c = make_ctx(); LArgs a = (LArgs)(LDS_ARGS); unsigned char* ws = wsp(a);
    pg8::Gemm g{(bf16_t*)(ws + WS_XB), (bf16_t*)(ws + WS_WIN), T, NINP, D}; pg8::StaticOrder S; S.init(T, NINP, c.G, c.bid);
    pg8::EpiBf16 E{(bf16_t*)(ws + WS_H), NINP};
    pg8::gemm_phase<pg8::EpiBf16, pg8::StaticOrder, false>(c.lds, g, S, E, nullptr);
}
DI MixP make_mixp(LArgs a, int L) {
    unsigned char* ws = wsp(a);
    MixP P; P.proj = (const GAS bf16_t*)(ws + WS_H); P.mix = (GAS bf16_t*)(ws + WS_MIX); P.layer = L;
    P.m_i_bias = (const GAS float*)inp(a, 3); P.m_f_bias = (const GAS float*)inp(a, 4); P.m_norm_w = (const GAS float*)inp(a, 5);
    P.g_conv_w = (const GAS float*)inp(a, 6); P.g_conv_b = (const GAS float*)inp(a, 7); P.g_w_a = (const GAS float*)inp(a, 8); P.g_b_a = (const GAS float*)inp(a, 9); P.g_w_x = (const GAS float*)inp(a, 10); P.g_b_x = (const GAS float*)inp(a, 11); P.g_lambda = (const GAS float*)inp(a, 12);
    P.r_mu = (const GAS float*)inp(a, 13); P.r_w0 = (const GAS float*)inp(a, 14); P.r_w2 = (const GAS float*)inp(a, 15); P.r_a0 = (const GAS float*)inp(a, 16); P.r_a2 = (const GAS float*)inp(a, 17); P.r_g2 = (const GAS float*)inp(a, 18); P.r_k_k = (const GAS float*)inp(a, 19); P.r_k_a = (const GAS float*)inp(a, 20);
    P.r_r_k = (const GAS float*)inp(a, 21); P.r_ln_w = (const GAS float*)inp(a, 22); P.r_ln_b = (const GAS float*)inp(a, 23);
    P.s_conv_w = (const GAS float*)inp(a, 24); P.s_conv_b = (const GAS float*)inp(a, 25); P.s_dt_bias = (const GAS float*)inp(a, 26); P.s_a_log = (const GAS float*)inp(a, 27); P.s_d = (const GAS float*)inp(a, 28); P.s_norm_w = (const GAS float*)inp(a, 29);
    return P;
}
PHASE_FN ph_mix_rwkv(int L, int b, int h) { const Ctx c = make_ctx(); LArgs a = (LArgs)(LDS_ARGS); const MixP P = make_mixp(a, L); unsigned char* ws = wsp(a);
    mix_rwkv_v5(c, P, (const GAS float*)(ws + WS_RWOPS), b, h, (const GAS unsigned*)(ws + WS_CTL) + CW_RDY + (b * 4 + h) * 16, (unsigned)(L + 1)); }
PHASE_FN ph_rwkv_prep(int L, int b, int h, int sp) { const Ctx c = make_ctx(); LArgs a = (LArgs)(LDS_ARGS); const MixP P = make_mixp(a, L); unsigned char* ws = wsp(a);
    rwkv_prep(c, P, (GAS float*)(ws + WS_RWOPS), b, h, sp, (GAS unsigned*)(ws + WS_CTL) + CW_RDY + (b * 4 + h) * 16, (unsigned)(L + 1)); }
PHASE_FN ph_mix_mlstm(int L, int b, int h) { const Ctx c = make_ctx(); const MixP P = make_mixp((LArgs)(LDS_ARGS), L); mix_mlstm_v2(c, P, b, h); }
PHASE_FN ph_mix_rglru(int L, int b, int h) { const Ctx c = make_ctx(); const MixP P = make_mixp((LArgs)(LDS_ARGS), L); mix_rglru_v2(c, P, b, h); }
PHASE_FN ph_mix_ssd(int L, int b, int g) { const Ctx c = make_ctx(); const MixP P = make_mixp((LArgs)(LDS_ARGS), L); mix_ssd_v3(c, P, b, g); }
PHASE_FN ph_outproj(int L) {
    const Ctx c = make_ctx(); LArgs a = (LArgs)(LDS_ARGS); unsigned char* ws = wsp(a); float* X = outp(a);
    pg8::Gemm g{(bf16_t*)(ws + WS_MIX), (bf16_t*)(ws + WS_WOUT), T, D, D}; pg8::StaticOrder S; S.init(T, D, c.G, c.bid);
    if (L == 0) { pg8::EpiPreLn<0, false> E{(bf16_t*)(ws + WS_PRE1), inp(a, 0), nullptr, D, ALPHA}; pg8::gemm_phase<pg8::EpiPreLn<0, false>, pg8::StaticOrder, false>(c.lds, g, S, E, nullptr); }
    else { pg8::EpiPreLn<1, false> E{(bf16_t*)(ws + WS_PRE1), (bf16_t*)(ws + WS_XB), nullptr, D, ALPHA}; pg8::gemm_phase<pg8::EpiPreLn<1, false>, pg8::StaticOrder, false>(c.lds, g, S, E, nullptr); }
}
PHASE_FN ph_ln1(int L) {
    const Ctx c = make_ctx(); LArgs a = (LArgs)(LDS_ARGS); unsigned char* ws = wsp(a); float* X = outp(a);
    const bool moe = (L & 1) != 0; const int fi = L >> 1; unsigned* ctl = (unsigned*)(ws + WS_CTL);
    if (moe) ln_phase<false, true, false>(c, X, (bf16_t*)(ws + WS_PRE1), (bf16_t*)(ws + WS_XB), nullptr, inp(a, 31) + L * D, inp(a, 32) + L * D, nullptr, nullptr, (Route*)(ws + WS_ROUTE), inp(a, 38) + (size_t)fi * D * NE, ctl + CW_CNT + 64 * fi);
    else ln_phase<false, false, false>(c, X, (bf16_t*)(ws + WS_PRE1), (bf16_t*)(ws + WS_XB), DENSE_FP8 ? ws + WS_XB8 : nullptr, inp(a, 31) + L * D, inp(a, 32) + L * D, nullptr, nullptr, nullptr, nullptr, nullptr);
}
PHASE_FN ph_gate(int L) {
    const Ctx c = make_ctx(); LArgs a = (LArgs)(LDS_ARGS); unsigned char* ws = wsp(a);
    pg8::Gemm g{(bf16_t*)(ws + WS_XB), (bf16_t*)(ws + WS_WG), T, D, D}; pg8::StaticOrder S; S.init(T, D, c.G, c.bid);
    pg8::EpiGate E{(bf16_t*)(ws + WS_PE), D, inp(a, 44) + L * D};
    pg8::gemm_phase<pg8::EpiGate, pg8::StaticOrder, false>(c.lds, g, S, E, nullptr);
}
PHASE_FN ph_pe(int L) {
    const Ctx c = make_ctx(); LArgs a = (LArgs)(LDS_ARGS); unsigned char* ws = wsp(a);
    pg8::Gemm g{(bf16_t*)(ws + WS_PB), (bf16_t*)(ws + WS_WPE), T, D, PE_DIM}; pg8::StaticOrder S; S.init(T, D, c.G, c.bid);
    pg8::EpiPeMul E{(bf16_t*)(ws + WS_PE), D};
    pg8::gemm_phase<pg8::EpiPeMul, pg8::StaticOrder, false>(c.lds, g, S, E, nullptr);
}
PHASE_FN ph_pe_raw(int L, int first, int stride) {
    const Ctx c = make_ctx(); LArgs a = (LArgs)(LDS_ARGS); unsigned char* ws = wsp(a);
    pg8::Gemm g{(bf16_t*)(ws + WS_PB), (bf16_t*)(ws + WS_WPE), T, D, PE_DIM}; pg8::ListOrder S; S.init(first, stride, (T / 256) * (D / 256), D / 256);
    pg8::EpiBf16 E{(bf16_t*)(ws + WS_PE), D};
    pg8::gemm_phase<pg8::EpiBf16, pg8::ListOrder, false>(c.lds, g, S, E, nullptr);
}
PHASE_FN ph_gate_mul(int L, int first, int stride) {
    const Ctx c = make_ctx(); LArgs a = (LArgs)(LDS_ARGS); unsigned char* ws = wsp(a);
    pg8::Gemm g{(bf16_t*)(ws + WS_XB), (bf16_t*)(ws + WS_WG), T, D, D}; pg8::ListOrder S; S.init(first, stride, (T / 256) * (D / 256), D / 256);
    pg8::EpiGateMul E{(bf16_t*)(ws + WS_PE), D, inp(a, 44) + L * D};
    pg8::gemm_phase<pg8::EpiGateMul, pg8::ListOrder, false>(c.lds, g, S, E, nullptr);
}
PHASE_FN ph_gate_mul_moe(int L) {
    const Ctx c = make_ctx(); LArgs a = (LArgs)(LDS_ARGS); unsigned char* ws = wsp(a); const int fi = L >> 1; const unsigned* counts = (const unsigned*)(ws + WS_CTL) + CW_CNT + 64 * fi;
    int nt = 0;
#pragma unroll
    for (int e = 0; e < NE; ++e) nt += __builtin_amdgcn_readfirstlane(((int)counts[e] + 255) >> 8);
    const int nwg = nt * (D / 256), rem = nwg % c.G, fast = c.G - rem;
    const int first = (c.bid >= rem) ? c.bid - rem : -1;
    pg8::Gemm g{(bf16_t*)(ws + WS_XB), (bf16_t*)(ws + WS_WG), T, D, D}; pg8::ListOrder S; S.init(first, fast, (T / 256) * (D / 256), D / 256);
    pg8::EpiGateMul E{(bf16_t*)(ws + WS_PE), D, inp(a, 44) + L * D};
    pg8::gemm_phase<pg8::EpiGateMul, pg8::ListOrder, false>(c.lds, g, S, E, nullptr);
}
PHASE_FN ph_cvt_pe(int L) {
    const Ctx c = make_ctx(); LArgs a = (LArgs)(LDS_ARGS); unsigned char* ws = wsp(a);
    int rot = 0;
    cvt_weight(c, inp(a, 42) + (size_t)L * PE_DIM * D, (bf16_t*)(ws + WS_WPE), PE_DIM, D, 0, 1, 0, 0, rot);
}
PHASE_FN ph_gather(int L) {
    const Ctx c = make_ctx(); LArgs a = (LArgs)(LDS_ARGS); unsigned char* ws = wsp(a); const int fi = L >> 1; unsigned* ctl = (unsigned*)(ws + WS_CTL);
    moe_assign_gather(c, (Route*)(ws + WS_ROUTE), ctl + CW_CNT + 64 * fi, ctl + CW_CUR + 64 * fi, (bf16_t*)(ws + WS_XB), (bf16_t*)(ws + WS_XG));
}
PHASE_FN ph_up_dense(int L) {
    const Ctx c = make_ctx(); LArgs a = (LArgs)(LDS_ARGS); unsigned char* ws = wsp(a);
#if DENSE_FP8
    pg8::Gemm g{(bf16_t*)(ws + WS_XB8), (bf16_t*)(ws + WS_W13), T, NH2, D / 2}; pg8::StaticOrder S; S.init(T, NH2, c.G, c.bid);
    pg8::EpiSwiglu8 E{ws + WS_H, DFF, 1.0f / W13_SCALE};
    pg8::gemm_phase<pg8::EpiSwiglu8, pg8::StaticOrder, false>(c.lds, g, S, E, nullptr);
#elif DENSE_FP8_DOWN
    pg8::Gemm g{(bf16_t*)(ws + WS_XB), (bf16_t*)(ws + WS_W13), T, NH2, D}; pg8::StaticOrder S; S.init(T, NH2, c.G, c.bid);
    pg8::EpiSwiglu8T<false> E{ws + WS_H, DFF, 1.0f};
    pg8::gemm_phase<pg8::EpiSwiglu8T<false>, pg8::StaticOrder, false>(c.lds, g, S, E, nullptr);
#else
    pg8::Gemm g{(bf16_t*)(ws + WS_XB), (bf16_t*)(ws + WS_W13), T, NH2, D}; pg8::StaticOrder S; S.init(T, NH2, c.G, c.bid);
    pg8::EpiSwiglu E{(bf16_t*)(ws + WS_H), DFF};
    pg8::gemm_phase<pg8::EpiSwiglu, pg8::StaticOrder, false>(c.lds, g, S, E, nullptr);
#endif
}
PHASE_FN ph_up_moe(int L) {
    const Ctx c = make_ctx(); LArgs a = (LArgs)(LDS_ARGS); unsigned char* ws = wsp(a); const int fi = L >> 1; unsigned* ctl = (unsigned*)(ws + WS_CTL);
#if MOE_FP8
    pg8::Gemm g{(bf16_t*)(ws + WS_XG), (bf16_t*)(ws + WS_W13 + MOE13_OFF), MOE_ROWS, NH2, D / 2}; pg8::MoeOrder S; S.init_moe(ctl + CW_CNT + 64 * fi, NH2 / 256, c.G, c.bid, (size_t)NH2 * D);
    pg8::EpiSwiglu8 E{ws + WS_H, DFF, 1.0f / W13_SCALE};
    pg8::gemm_phase<pg8::EpiSwiglu8, pg8::MoeOrder, false>(c.lds, g, S, E, nullptr);
#else
    pg8::Gemm g{(bf16_t*)(ws + WS_XG), (bf16_t*)(ws + WS_W13), MOE_ROWS, NH2, D}; pg8::MoeOrder S; S.init_moe(ctl + CW_CNT + 64 * fi, NH2 / 256, c.G, c.bid, SZ_W13);
    pg8::EpiSwiglu E{(bf16_t*)(ws + WS_H), DFF};
    pg8::gemm_phase<pg8::EpiSwiglu, pg8::MoeOrder, false>(c.lds, g, S, E, nullptr);
#endif
}
PHASE_FN ph_down_dense(int L) {
    const Ctx c = make_ctx(); LArgs a = (LArgs)(LDS_ARGS); unsigned char* ws = wsp(a); float* X = outp(a);
#if DENSE_FP8 || DENSE_FP8_DOWN
    pg8::Gemm g{(bf16_t*)(ws + WS_H), (bf16_t*)(ws + WS_W2), T, D, DFF / 2}; pg8::StaticOrder S; S.init(T, D, c.G, c.bid);
    pg8::EpiPreLn<1, true, true> E{(bf16_t*)(ws + WS_PRE2), (bf16_t*)(ws + WS_XB), (bf16_t*)(ws + WS_PE), D, ALPHA, 1.0f / W2_SCALE};
    pg8::gemm_phase<pg8::EpiPreLn<1, true, true>, pg8::StaticOrder, false>(c.lds, g, S, E, nullptr);
#else
    pg8::Gemm g{(bf16_t*)(ws + WS_H), (bf16_t*)(ws + WS_W2), T, D, DFF}; pg8::StaticOrder S; S.init(T, D, c.G, c.bid);
    pg8::EpiPreLn<1, true> E{(bf16_t*)(ws + WS_PRE2), (bf16_t*)(ws + WS_XB), (bf16_t*)(ws + WS_PE), D, ALPHA};
    pg8::gemm_phase<pg8::EpiPreLn<1, true>, pg8::StaticOrder, false>(c.lds, g, S, E, nullptr);
#endif
}
PHASE_FN ph_down_moe(int L) {
    const Ctx c = make_ctx(); LArgs a = (LArgs)(LDS_ARGS); unsigned char* ws = wsp(a); const int fi = L >> 1; unsigned* ctl = (unsigned*)(ws + WS_CTL);
#if MOE_FP8
    pg8::Gemm g{(bf16_t*)(ws + WS_H), (bf16_t*)(ws + WS_W2 + MOE2_OFF), MOE_ROWS, D, DFF / 2}; pg8::MoeOrder S; S.init_moe(ctl + CW_CNT + 64 * fi, D / 256, c.G, c.bid, (size_t)D * DFF);
    pg8::EpiBf16S8 E{(bf16_t*)(ws + WS_XG), D, 1.0f / W2_SCALE};
    pg8::gemm_phase<pg8::EpiBf16S8, pg8::MoeOrder, false>(c.lds, g, S, E, nullptr);
#else
    pg8::Gemm g{(bf16_t*)(ws + WS_H), (bf16_t*)(ws + WS_W2), MOE_ROWS, D, DFF}; pg8::MoeOrder S; S.init_moe(ctl + CW_CNT + 64 * fi, D / 256, c.G, c.bid, SZ_W2);
    pg8::EpiBf16 E{(bf16_t*)(ws + WS_XG), D};
    pg8::gemm_phase<pg8::EpiBf16, pg8::MoeOrder, false>(c.lds, g, S, E, nullptr);
#endif
}
PHASE_FN ph_ln2(int L) {
    const Ctx c = make_ctx(); LArgs a = (LArgs)(LDS_ARGS); unsigned char* ws = wsp(a); float* X = outp(a);
    const bool moe = (L & 1) != 0;
    if (moe) { if (L == DEPTH - 1) ln_phase<true, false, true>(c, X, nullptr, (bf16_t*)(ws + WS_XB), nullptr, inp(a, 33) + L * D, inp(a, 34) + L * D, (bf16_t*)(ws + WS_XG), (bf16_t*)(ws + WS_PE), (Route*)(ws + WS_ROUTE), nullptr, nullptr);
               else ln_phase<true, false, false>(c, X, nullptr, (bf16_t*)(ws + WS_XB), nullptr, inp(a, 33) + L * D, inp(a, 34) + L * D, (bf16_t*)(ws + WS_XG), (bf16_t*)(ws + WS_PE), (Route*)(ws + WS_ROUTE), nullptr, nullptr); }
    else ln_phase<false, false, false>(c, X, (bf16_t*)(ws + WS_PRE2), (bf16_t*)(ws + WS_XB), nullptr, inp(a, 33) + L * D, inp(a, 34) + L * D, nullptr, nullptr, nullptr, nullptr, nullptr);
}

DI void grid_bar(unsigned* barw, unsigned x, volatile LAS unsigned* st) { asm volatile("" : "+s"(barw), "+s"(x)); XcdBarrier b; b.bar = barw; b.x = x; b.st = st; xcd_barrier(b); }

#define IN(k) (ph_lo <= (k) && (k) < ph_hi)
#define SEAM(k) do { if (IN((k) + 1)) grid_bar(bar.bar, bar.x, bar.st); } while (0)
template <int L> DI void layer_body(const int ph_lo, const int ph_hi, const XcdBarrier& bar) {
        const int p0 = L * NPH; const bool moe = (L & 1) != 0;
        if (PHEN(0) && IN(p0 + 0)) { if (L == 0) { ph_cvt_in(0); SEAM(p0 + 0); } }
        if (PHEN(1) && IN(p0 + 1)) { ph_proj(L); SEAM(p0 + 1); }
        if (PHEN(2) && IN(p0 + 2)) {
            { const bool handoff = gridDim.x == 256; const int grp = blockIdx.x & 3, idx = blockIdx.x >> 2;
              const int rank = (grp == 2) ? idx : (grp == 1) ? 64 + idx : (grp == 3 && idx >= 32) ? 96 + idx : 512;
              for (int t = handoff ? rank : (int)blockIdx.x; t < 512; t += handoff ? 160 : (int)gridDim.x) { ph_rwkv_prep(L, (t & 63) >> 2, t & 3, t >> 6); __syncthreads(); }
              if (!handoff) grid_bar(bar.bar, bar.x, bar.st); }
            for (int task = blockIdx.x; task < 256; task += gridDim.x) {
                const int grp = task & 3, idx = task >> 2;
                if (grp == 0) ph_mix_rwkv(L, idx >> 2, idx & 3);
                else if (grp == 1) ph_mix_mlstm(L, idx >> 2, idx & 3);
                else if (grp == 2) ph_mix_rglru(L, idx >> 2, idx & 3);
                else if (idx < 32) ph_mix_ssd(L, idx >> 1, idx & 1);
                else ph_pe_raw(L, idx - 32, 32);
                __syncthreads();
            }
            ph_cvt_queue(L);
            SEAM(p0 + 2);
        }
        if (PHEN(3) && IN(p0 + 3)) { ph_outproj(L); SEAM(p0 + 3); }
        if (PHEN(4) && IN(p0 + 4)) { ph_ln1(L); SEAM(p0 + 4); }
        if (PHEN(5) && IN(p0 + 5)) { if (moe) { ph_gather(L); SEAM(p0 + 5); } }
        if (PHEN(6) && IN(p0 + 6)) { if (moe) ph_up_moe(L); else { ph_up_dense(L); ph_gate_mul(L, blockIdx.x, gridDim.x); } SEAM(p0 + 6); }
        if (PHEN(7) && IN(p0 + 7)) { if (moe) { ph_down_moe(L); ph_gate_mul_moe(L); } else ph_down_dense(L); SEAM(p0 + 7); }
        if (PHEN(8) && IN(p0 + 8)) { ph_ln2(L); if (L + 1 < DEPTH) { __syncthreads(); ph_cvt_in(L + 1); SEAM(p0 + 8); } }
}

__global__ void __launch_bounds__(512, 2) fwd_kernel(Args args) {
    extern __shared__ __attribute__((aligned(16))) unsigned char lds_raw[];
    LAS unsigned char* lds = (LAS unsigned char*)lds_raw;
    const int tid = threadIdx.x;
    volatile LAS unsigned* misc = (volatile LAS unsigned*)(lds + LDS_MISC);
    if (tid < 4) misc[tid] = 0u;
    { LAS unsigned long long* la = (LAS unsigned long long*)(lds + LDS_ARGS); const unsigned long long* ga = (const unsigned long long*)&args;
      if (tid < (int)(sizeof(Args) / 8)) la[tid] = ga[tid]; }
    __syncthreads();
    const int ph_lo = args.ph_lo, ph_hi = args.ph_hi;
    const bool multi = !(ph_lo == 0 && ph_hi == DEPTH * NPH);
    unsigned* ctl = (unsigned*)(args.ws + WS_CTL);
    XcdBarrier bar; bar.bar = ctl + CW_BAR; bar.x = 0; bar.st = misc;
    if (!multi) bar = xcd_barrier_post(ctl + CW_BAR, misc);
    layer_body<0>(ph_lo, ph_hi, bar); layer_body<1>(ph_lo, ph_hi, bar); layer_body<2>(ph_lo, ph_hi, bar); layer_body<3>(ph_lo, ph_hi, bar);
#undef IN
#undef SEAM
}

#ifndef MK_PER_PHASE
#define MK_PER_PHASE 0
#endif
extern "C" void kernel_launch(void* const* d_in, const int* in_sizes, int n_in, void* d_out, int out_size, void* d_ws, size_t ws_size, hipStream_t stream) {
    static int grid = 0;
    if (grid == 0) {
        if (n_in != 45 || in_sizes[0] != T * D || out_size != T * D || ws_size < (WS_END > WS_NEED ? WS_END : WS_NEED)) {
            fprintf(stderr, "kernel_launch: unexpected shapes (n_in %d, in0 %d, out %d, ws %zu < %zu); nothing launched\n", n_in, n_in > 0 ? in_sizes[0] : -1, out_size, ws_size, (size_t)WS_END); grid = -1; return; }
        int dev = 0, cus = 0, per_cu = 0;
        if (hipGetDevice(&dev) != hipSuccess || hipDeviceGetAttribute(&cus, hipDeviceAttributeMultiprocessorCount, dev) != hipSuccess) { grid = -1; return; }
        if (hipFuncSetAttribute((const void*)fwd_kernel, hipFuncAttributeMaxDynamicSharedMemorySize, LDS_BYTES) != hipSuccess) { fprintf(stderr, "kernel_launch: hipFuncSetAttribute failed\n"); grid = -1; return; }
        if (hipOccupancyMaxActiveBlocksPerMultiprocessor(&per_cu, (const void*)fwd_kernel, 512, LDS_BYTES) != hipSuccess || per_cu < 1) { fprintf(stderr, "kernel_launch: occupancy query reports %d\n", per_cu); (void)hipGetLastError(); grid = -1; return; }
        grid = cus;
    }
    if (grid < 0) return;
    (void)hipMemsetAsync((char*)d_ws + WS_CTL, 0, CTL_BYTES, stream);
    Args a{};
    for (int i = 0; i < 45; ++i) a.in[i] = (const float*)d_in[i];
    a.out = (float*)d_out; a.ws = (unsigned char*)d_ws;
#if MK_PER_PHASE
    for (int ph = 0; ph < DEPTH * NPH; ++ph) { a.ph_lo = ph; a.ph_hi = ph + 1; hipLaunchKernelGGL(fwd_kernel, dim3(grid), dim3(512), LDS_BYTES, stream, a); }
#else
    a.ph_lo = 0; a.ph_hi = DEPTH * NPH;
    hipLaunchKernelGGL(fwd_kernel, dim3(grid), dim3(512), LDS_BYTES, stream, a);
#endif
}
```

```cpp
#include <hip/hip_runtime.h>
#include <cstdio>
#include <cstdint>

#define LAS __attribute__((address_space(3)))
typedef unsigned short bf16_t;
typedef short bf16x8 __attribute__((ext_vector_type(8)));
typedef float f32x4 __attribute__((ext_vector_type(4)));
typedef float f32x2 __attribute__((ext_vector_type(2)));
typedef unsigned u32x4 __attribute__((ext_vector_type(4)));
typedef unsigned u32x2 __attribute__((ext_vector_type(2)));
#define DI __device__ __forceinline__
#define GAS __attribute__((address_space(1)))

constexpr int NB = 16, SEQ = 2048, T = NB * SEQ, D = 1024, DEPTH = 4, PE_DIM = 256;
constexpr int NIN = 3212, NINP = 3328, DFF = 2816, NH2 = 2 * DFF, NE = 8;
constexpr int OFF_M = 0, OFF_G = 1032, OFF_R = 1544, OFF_S = 2440;
constexpr float ALPHA = 1.6817928305074290f;
constexpr int MOE_ROWS = 2 * T + NE * 256;

DI float bf2f(bf16_t b) { return __uint_as_float(((unsigned)b) << 16); }
typedef __bf16 bf16x2_t __attribute__((ext_vector_type(2)));
DI bf16_t f2bf(float f) { return __builtin_bit_cast(bf16_t, (__bf16)f); }
DI unsigned pack_bf16(float lo, float hi) { bf16x2_t v; v[0] = (__bf16)lo; v[1] = (__bf16)hi; return __builtin_bit_cast(unsigned, v); }
DI float rcpf_(float x) { return __builtin_amdgcn_rcpf(x); }
DI float sigmoidf_(float x) { return rcpf_(1.0f + __expf(-x)); }
DI float softplusf_(float x) { return fmaxf(x, 0.f) + __logf(1.0f + __expf(-fabsf(x))); }
DI float siluf_(float x) { return x * sigmoidf_(x); }
DI float tanhf_(float x) { const float e = __expf(-2.0f * fabsf(x)); const float r = (1.0f - e) * rcpf_(1.0f + e); return x < 0.f ? -r : r; }
DI float gelu_tanhf_(float x) { const float u = 0.7978845608028654f * (x + 0.044715f * x * x * x); return x * sigmoidf_(2.0f * u); }
DI float grp16_sum(float v) {
#pragma unroll
    for (int o = 8; o >= 1; o >>= 1) v += __shfl_xor(v, o);
    return v;
}
DI unsigned long long rfl64(unsigned long long v) { const unsigned lo = __builtin_amdgcn_readfirstlane((unsigned)v), hi = __builtin_amdgcn_readfirstlane((unsigned)(v >> 32)); return ((unsigned long long)hi << 32) | lo; }
#define XB_TMO      128
#define XB_XCNT(j)  (256  + 64 * (j))
#define XB_XSUB(j)  (1280 + 64 * (j))
#define XB_XGEN(j)  (2304 + 64 * (j))
#define XB_TOP      3328
#define XB_TOPGEN   3392
#define XCD_BAR_WORDS 3456
#define XB_SPIN_CAP (1u << 18)

__device__ __forceinline__ unsigned xb_ld(unsigned* p)              { return __hip_atomic_load(p, __ATOMIC_RELAXED, __HIP_MEMORY_SCOPE_AGENT); }
__device__ __forceinline__ unsigned xb_add(unsigned* p, unsigned v) { return __hip_atomic_fetch_add(p, v, __ATOMIC_RELAXED, __HIP_MEMORY_SCOPE_AGENT); }
__device__ __forceinline__ unsigned xb_xcc_id() { return (unsigned)__builtin_amdgcn_s_getreg((3 << 11) | 20) & 0xFu; }
#define XB_SPIN(cond, bar) do { unsigned _sp = 0; while (cond) { __builtin_amdgcn_s_sleep(1); \
    if ((++_sp & 255u) == 0u) { if (xb_ld(&(bar)[XB_TMO])) break; if (_sp > XB_SPIN_CAP) { atomicAdd(&(bar)[XB_TMO], 1u); break; } } } } while (0)

struct XcdBarrier {
    unsigned* bar; unsigned x;
    volatile LAS unsigned* st;
};

__device__ __forceinline__ XcdBarrier xcd_barrier_post(unsigned* bar, volatile LAS unsigned* st) {
    XcdBarrier b; b.bar = bar; b.x = xb_xcc_id(); b.st = st;
    if (threadIdx.x == 0) (void)xb_add(&bar[XB_XCNT(b.x)], 1u);
    return b;
}
__device__ __forceinline__ void xcd_barrier_complete(unsigned* bar, unsigned x, unsigned& nloc, unsigned& nx) {
    const unsigned G = gridDim.x * gridDim.y * gridDim.z;
    unsigned sum, cnt, mine, sp = 0u;
    for (;;) {
        sum = 0u; cnt = 0u; mine = 0u;
#pragma unroll
        for (unsigned j = 0; j < 16; ++j) { const unsigned c = xb_ld(&bar[XB_XCNT(j)]); sum += c; cnt += (c > 0u) ? 1u : 0u; mine = (j == x) ? c : mine; }
        if (sum == G) break;
        __builtin_amdgcn_s_sleep(1);
        if ((++sp & 255u) == 0u) { if (xb_ld(&bar[XB_TMO])) break; if (sp > XB_SPIN_CAP) { atomicAdd(&bar[XB_TMO], 1u); break; } }
    }
    nloc = mine > 0u ? mine : 1u; nx = cnt > 0u ? cnt : 1u;
}

__device__ __forceinline__ void xcd_barrier(const XcdBarrier& b) {
    asm volatile("s_waitcnt vmcnt(0)" ::: "memory");
    __syncthreads();
    if (threadIdx.x == 0) {
        unsigned* bar = b.bar;
        __builtin_amdgcn_s_waitcnt(0);
        unsigned nloc = b.st[0], nx = b.st[1];
        if (nloc == 0u) { xcd_barrier_complete(bar, b.x, nloc, nx); b.st[0] = nloc; b.st[1] = nx; }
        const unsigned old = xb_add(&bar[XB_XSUB(b.x)], 1u);
        const unsigned gen = old / nloc;
        if (old + 1u == (gen + 1u) * nloc) {
            __builtin_amdgcn_fence(__ATOMIC_RELEASE, "agent");
            asm volatile("s_waitcnt vmcnt(0)" ::: "memory");
            const unsigned og = xb_add(&bar[XB_TOP], 1u);
            const unsigned tg = og / nx;
            if (og + 1u == (tg + 1u) * nx) xb_add(&bar[XB_TOPGEN], 1u);
            else XB_SPIN(xb_ld(&bar[XB_TOPGEN]) == tg, bar);
            __builtin_amdgcn_fence(__ATOMIC_ACQUIRE, "agent");
            xb_add(&bar[XB_XGEN(b.x)], 1u);
            asm volatile("s_waitcnt vmcnt(0)" ::: "memory");
        } else {
            XB_SPIN(xb_ld(&bar[XB_XGEN(b.x)]) == gen, bar);
            __builtin_amdgcn_fence(__ATOMIC_ACQUIRE, "agent");
            asm volatile("s_waitcnt vmcnt(0)" ::: "memory");
        }
    }
    __syncthreads();
}
namespace pg8 {
typedef short bf16x8 __attribute__((ext_vector_type(8)));
typedef float f32x4 __attribute__((ext_vector_type(4)));
typedef unsigned u32x4 __attribute__((ext_vector_type(4)));
constexpr int BM = 256, BK = 64, HALF = 128, HTB = HALF * BK * 2  , STAGE_BYTES = 8 * HTB, NXCD = 8, WGM = 4;

__host__ __device__ __forceinline__ int lds_byte(int r, int c) { const int st = (r >> 4) * 2 + (c >> 5), rr = r & 15, cc = c & 31, ob = rr * 64 + cc * 2; return st * 1024 + (ob ^ (((ob >> 9) & 1) << 5)); }
__host__ __device__ __forceinline__ void stage_rc(int b, int& R, int& C) { const int st = b / 1024, sb = b % 1024, swz = sb ^ (((sb >> 9) & 1) << 5); R = (st >> 1) * 16 + swz / 64; C = (st & 1) * 32 + (swz % 64) / 2; }
__host__ __device__ __forceinline__ int perm32(int rho) { const int n = rho >> 4, i = rho & 15; return 8 * (i >> 2) + 4 * n + (i & 3); }

#define PG8_LAS __attribute__((address_space(3)))
struct Unit { int pm, pn; size_t boff; };
struct Gemm { const bf16_t* A; const bf16_t* Bt; int M, N, K; };

struct StaticOrder {
    int nM, nN, nwg, G, c;
    __device__ void init(int M, int N, int G_, int c_) { nM = M / BM; nN = N / BM; nwg = nM * nN; G = G_; c = c_; }
    __device__ bool next(int i, Unit& u) const {
        const long L = (long)i * G + c; if (L >= nwg) return false;
        int wgid = (int)L; { const int q = nwg / NXCD, r = nwg % NXCD, xcd = wgid % NXCD, off = wgid / NXCD; wgid = (xcd < r ? xcd * (q + 1) : r * (q + 1) + (xcd - r) * q) + off; }
        const int nig = WGM * nN, gid = wgid / nig, fm = gid * WGM, gsz = (nM - fm) < WGM ? (nM - fm) : WGM;
        u.pm = fm + ((wgid % nig) % gsz); u.pn = (wgid % nig) / gsz; u.boff = 0; return true;
    }
    __device__ __forceinline__ void a_ready(const Unit&) const {}
    __device__ __forceinline__ void done(const Unit&) const {}
};
struct MoeOrder : StaticOrder {
    int tstart[NE + 1]; size_t estride;
    __device__ void init_moe(const unsigned* counts, int nN_, int G_, int c_, size_t estride_) {
        int acc = 0;
#pragma unroll
        for (int e = 0; e < NE; ++e) { tstart[e] = acc; acc += __builtin_amdgcn_readfirstlane(((int)counts[e] + 255) >> 8); }
        tstart[NE] = acc; nM = acc; nN = nN_; nwg = nM * nN; G = G_; c = c_; estride = estride_;
    }
    __device__ bool next(int i, Unit& u) const {
        if (!StaticOrder::next(i, u)) return false;
        int e = 0;
#pragma unroll
        for (int j = 1; j < NE; ++j) e += (u.pm >= tstart[j]) ? 1 : 0;
        u.boff = (size_t)e * estride; return true;
    }
};


struct ListOrder {
    int first, stride, total, nN;
    __device__ void init(int first_, int stride_, int total_, int nN_) { first = first_; stride = stride_; total = total_; nN = nN_; }
    __device__ bool next(int i, Unit& u) const { const int idx = first + i * stride; if (first < 0 || idx >= total) return false; u.pm = idx / nN; u.pn = idx - u.pm * nN; u.boff = 0; return true; }
    __device__ __forceinline__ void a_ready(const Unit&) const {}
    __device__ __forceinline__ void done(const Unit&) const {}
};

__device__ __forceinline__ unsigned cvt_pk_bf16(float lo, float hi) { return pack_bf16(lo, hi); }
__device__ __forceinline__ float bflo(unsigned w) { return __uint_as_float(w << 16); }
__device__ __forceinline__ float bfhi(unsigned w) { return __uint_as_float(w & 0xFFFF0000u); }
__device__ __forceinline__ float sigm(float x) { return __builtin_amdgcn_rcpf(1.0f + __expf(-x)); }

struct EpiBf16 {
    static constexpr bool PERM = true, AFTER_DRAIN = false, FP8 = false;
    bf16_t* O; int ldc;
    __device__ __forceinline__ void operator()(const f32x4 (&acc)[2][2][4][2], const Unit& u, int wr, int wc, int fr, int fq) const {
        const int row0 = u.pm * BM + wr * 64 + fr, col0 = u.pn * BM + wc * 32 + 8 * fq;
#pragma unroll
        for (int ai = 0; ai < 2; ++ai)
#pragma unroll
            for (int m = 0; m < 4; ++m) { bf16_t* rowp = O + (size_t)(row0 + ai * HALF + m * 16) * ldc + col0;
#pragma unroll
                for (int bj = 0; bj < 2; ++bj) { const f32x4 v0 = acc[ai][bj][m][0], v1 = acc[ai][bj][m][1];
                    u32x4 w; w.x = cvt_pk_bf16(v0[0], v0[1]); w.y = cvt_pk_bf16(v0[2], v0[3]); w.z = cvt_pk_bf16(v1[0], v1[1]); w.w = cvt_pk_bf16(v1[2], v1[3]);
                    *(GAS u32x4*)(rowp + bj * HALF) = w; } }
    }
};
struct EpiSwiglu {
    static constexpr bool PERM = true, AFTER_DRAIN = false, FP8 = false;
    bf16_t* H; int ldh;
    __device__ __forceinline__ void operator()(const f32x4 (&acc)[2][2][4][2], const Unit& u, int wr, int wc, int fr, int fq) const {
        const int row0 = u.pm * BM + wr * 64 + fr, col0 = u.pn * HALF + wc * 32 + 8 * fq;
#pragma unroll
        for (int ai = 0; ai < 2; ++ai)
#pragma unroll
            for (int m = 0; m < 4; ++m) { bf16_t* rowp = H + (size_t)(row0 + ai * HALF + m * 16) * ldh + col0;
                float h[8];
#pragma unroll
                for (int n = 0; n < 2; ++n)
#pragma unroll
                    for (int j = 0; j < 4; ++j) { const float a = acc[ai][0][m][n][j], b = acc[ai][1][m][n][j]; h[n * 4 + j] = a * sigm(a) * b; }
                u32x4 w; w.x = cvt_pk_bf16(h[0], h[1]); w.y = cvt_pk_bf16(h[2], h[3]); w.z = cvt_pk_bf16(h[4], h[5]); w.w = cvt_pk_bf16(h[6], h[7]);
                *(GAS u32x4*)rowp = w; }
    }
};
typedef int v8i __attribute__((ext_vector_type(8)));
typedef int v4i __attribute__((ext_vector_type(4)));
__device__ __forceinline__ v8i cat8(const bf16x8 lo, const bf16x8 hi) { const v4i a = __builtin_bit_cast(v4i, lo), b = __builtin_bit_cast(v4i, hi); return (v8i){a.x, a.y, a.z, a.w, b.x, b.y, b.z, b.w}; }
__device__ __forceinline__ unsigned pk4_fp8(float a, float b, float c, float d) { unsigned w = 0; w = __builtin_amdgcn_cvt_pk_fp8_f32(a, b, w, false); w = __builtin_amdgcn_cvt_pk_fp8_f32(c, d, w, true); return w; }
template <bool F8IN = true>
struct EpiSwiglu8T {
    static constexpr bool PERM = true, AFTER_DRAIN = false, FP8 = F8IN;
    unsigned char* H; int ldh; float sc;
    __device__ __forceinline__ void operator()(const f32x4 (&acc)[2][2][4][2], const Unit& u, int wr, int wc, int fr, int fq) const {
        const int row0 = u.pm * BM + wr * 64 + fr, col0 = u.pn * HALF + wc * 32 + 8 * fq;
#pragma unroll
        for (int ai = 0; ai < 2; ++ai)
#pragma unroll
            for (int m = 0; m < 4; ++m) { unsigned char* rowp = H + (size_t)(row0 + ai * HALF + m * 16) * ldh + col0;
                float h[8];
#pragma unroll
                for (int n = 0; n < 2; ++n)
#pragma unroll
                    for (int j = 0; j < 4; ++j) { const float a = acc[ai][0][m][n][j] * sc, b = acc[ai][1][m][n][j] * sc; h[n * 4 + j] = a * sigm(a) * b; }
                u32x2 w; w.x = pk4_fp8(h[0], h[1], h[2], h[3]); w.y = pk4_fp8(h[4], h[5], h[6], h[7]);
                *(GAS u32x2*)rowp = w; }
    }
};
typedef EpiSwiglu8T<true> EpiSwiglu8;
struct EpiBf16S8 {
    static constexpr bool PERM = true, AFTER_DRAIN = false, FP8 = true;
    bf16_t* O; int ldc; float sc;
    __device__ __forceinline__ void operator()(const f32x4 (&acc)[2][2][4][2], const Unit& u, int wr, int wc, int fr, int fq) const {
        const int row0 = u.pm * BM + wr * 64 + fr, col0 = u.pn * BM + wc * 32 + 8 * fq;
#pragma unroll
        for (int ai = 0; ai < 2; ++ai)
#pragma unroll
            for (int m = 0; m < 4; ++m) { bf16_t* rowp = O + (size_t)(row0 + ai * HALF + m * 16) * ldc + col0;
#pragma unroll
                for (int bj = 0; bj < 2; ++bj) { const f32x4 v0 = acc[ai][bj][m][0] * sc, v1 = acc[ai][bj][m][1] * sc;
                    u32x4 w; w.x = cvt_pk_bf16(v0[0], v0[1]); w.y = cvt_pk_bf16(v0[2], v0[3]); w.z = cvt_pk_bf16(v1[0], v1[1]); w.w = cvt_pk_bf16(v1[2], v1[3]);
                    *(GAS u32x4*)(rowp + bj * HALF) = w; } }
    }
};
struct EpiResF32 {
    static constexpr bool PERM = false, AFTER_DRAIN = false, FP8 = false;
    float* X; const float* R; int ldc; float alpha;
    __device__ __forceinline__ void operator()(const f32x4 (&acc)[2][2][4][2], const Unit& u, int wr, int wc, int fr, int fq) const {
        const int row0 = u.pm * BM + wr * 64 + fr, col0 = u.pn * BM + wc * 32 + 4 * fq;
#pragma unroll
        for (int ai = 0; ai < 2; ++ai)
#pragma unroll
            for (int m = 0; m < 4; ++m) { const size_t ro = (size_t)(row0 + ai * HALF + m * 16) * ldc + col0;
#pragma unroll
                for (int bj = 0; bj < 2; ++bj)
#pragma unroll
                    for (int n = 0; n < 2; ++n) { asm volatile("" ::: "memory"); const f32x4 r = *(const GAS f32x4*)(R + ro + bj * HALF + n * 16); *(GAS f32x4*)(X + ro + bj * HALF + n * 16) = r * alpha + acc[ai][bj][m][n]; } }
    }
};
struct EpiResBf {
    static constexpr bool PERM = false, AFTER_DRAIN = false, FP8 = false;
    float* X; const bf16_t* RB; int ldc; float alpha;
    __device__ __forceinline__ void operator()(const f32x4 (&acc)[2][2][4][2], const Unit& u, int wr, int wc, int fr, int fq) const {
        const int row0 = u.pm * BM + wr * 64 + fr, col0 = u.pn * BM + wc * 32 + 4 * fq;
#pragma unroll
        for (int ai = 0; ai < 2; ++ai)
#pragma unroll
            for (int m = 0; m < 4; ++m) { const size_t ro = (size_t)(row0 + ai * HALF + m * 16) * ldc + col0;
#pragma unroll
                for (int bj = 0; bj < 2; ++bj)
#pragma unroll
                    for (int n = 0; n < 2; ++n) { asm volatile("" ::: "memory"); const size_t o = ro + bj * HALF + n * 16; const u32x2 rw = *(const GAS u32x2*)(RB + o);
                        f32x4 r; r[0] = bflo(rw.x); r[1] = bfhi(rw.x); r[2] = bflo(rw.y); r[3] = bfhi(rw.y);
                        *(GAS f32x4*)(X + o) = r * alpha + acc[ai][bj][m][n]; } }
    }
};
struct EpiDownRes {
    static constexpr bool PERM = false, AFTER_DRAIN = false, FP8 = false;
    float* X; const bf16_t* RB; const bf16_t* PEb; int ldc; float alpha;
    __device__ __forceinline__ void operator()(const f32x4 (&acc)[2][2][4][2], const Unit& u, int wr, int wc, int fr, int fq) const {
        const int row0 = u.pm * BM + wr * 64 + fr, col0 = u.pn * BM + wc * 32 + 4 * fq;
#pragma unroll
        for (int ai = 0; ai < 2; ++ai)
#pragma unroll
            for (int m = 0; m < 4; ++m) { const size_t ro = (size_t)(row0 + ai * HALF + m * 16) * ldc + col0;
#pragma unroll
                for (int bj = 0; bj < 2; ++bj)
#pragma unroll
                    for (int n = 0; n < 2; ++n) { asm volatile("" ::: "memory"); const size_t o = ro + bj * HALF + n * 16; const u32x2 rw = *(const GAS u32x2*)(RB + o); const u32x2 pw = *(const GAS u32x2*)(PEb + o);
                        f32x4 r; r[0] = bflo(rw.x); r[1] = bfhi(rw.x); r[2] = bflo(rw.y); r[3] = bfhi(rw.y);
                        f32x4 pe; pe[0] = bflo(pw.x); pe[1] = bfhi(pw.x); pe[2] = bflo(pw.y); pe[3] = bfhi(pw.y);
                        *(GAS f32x4*)(X + o) = r * alpha + acc[ai][bj][m][n] + pe; } }
    }
};
__device__ __forceinline__ void unpack8(const u32x4 w, float (&f)[8]) { f[0] = bflo(w.x); f[1] = bfhi(w.x); f[2] = bflo(w.y); f[3] = bfhi(w.y); f[4] = bflo(w.z); f[5] = bfhi(w.z); f[6] = bflo(w.w); f[7] = bfhi(w.w); }
template <int RMODE  , bool HASPE, bool F8 = false>
struct EpiPreLn {
    static constexpr bool PERM = true, AFTER_DRAIN = false, FP8 = F8;
    bf16_t* P; const void* R; const bf16_t* PEb; int ldc; float alpha; float sc = 1.0f;
    __device__ __forceinline__ void operator()(const f32x4 (&acc)[2][2][4][2], const Unit& u, int wr, int wc, int fr, int fq) const {
        const int row0 = u.pm * BM + wr * 64 + fr, col0 = u.pn * BM + wc * 32 + 8 * fq;
#pragma unroll
        for (int ai = 0; ai < 2; ++ai)
#pragma unroll
            for (int m = 0; m < 4; ++m) { const size_t ro = (size_t)(row0 + ai * HALF + m * 16) * ldc + col0;
#pragma unroll
                for (int bj = 0; bj < 2; ++bj) { asm volatile("" ::: "memory"); const size_t o = ro + bj * HALF; float r[8];
                    if (RMODE == 0) { const f32x4 a = *(const GAS f32x4*)((const float*)R + o), b = *(const GAS f32x4*)((const float*)R + o + 4); r[0] = a[0]; r[1] = a[1]; r[2] = a[2]; r[3] = a[3]; r[4] = b[0]; r[5] = b[1]; r[6] = b[2]; r[7] = b[3]; }
                    else unpack8(*(const GAS u32x4*)((const bf16_t*)R + o), r);
                    float v[8];
#pragma unroll
                    for (int j = 0; j < 4; ++j) { v[j] = r[j] * alpha + acc[ai][bj][m][0][j] * (F8 ? sc : 1.0f); v[4 + j] = r[4 + j] * alpha + acc[ai][bj][m][1][j] * (F8 ? sc : 1.0f); }
                    if (HASPE) { float pe[8]; unpack8(*(const GAS u32x4*)(PEb + o), pe);
#pragma unroll
                        for (int j = 0; j < 8; ++j) v[j] += pe[j]; }
                    u32x4 w; w.x = cvt_pk_bf16(v[0], v[1]); w.y = cvt_pk_bf16(v[2], v[3]); w.z = cvt_pk_bf16(v[4], v[5]); w.w = cvt_pk_bf16(v[6], v[7]);
                    *(GAS u32x4*)(P + o) = w; } }
    }
};
struct EpiGate {
    static constexpr bool PERM = true, AFTER_DRAIN = false, FP8 = false;
    bf16_t* O; int ldc; const float* bias;
    __device__ __forceinline__ void operator()(const f32x4 (&acc)[2][2][4][2], const Unit& u, int wr, int wc, int fr, int fq) const {
        const int row0 = u.pm * BM + wr * 64 + fr, col0 = u.pn * BM + wc * 32 + 8 * fq;
        f32x4 bv[2][2];
#pragma unroll
        for (int bj = 0; bj < 2; ++bj)
#pragma unroll
            for (int n = 0; n < 2; ++n) bv[bj][n] = *(const GAS f32x4*)(bias + col0 + bj * HALF + 4 * n);
#pragma unroll
        for (int ai = 0; ai < 2; ++ai)
#pragma unroll
            for (int m = 0; m < 4; ++m) { bf16_t* rowp = O + (size_t)(row0 + ai * HALF + m * 16) * ldc + col0;
#pragma unroll
                for (int bj = 0; bj < 2; ++bj) { f32x4 v0 = acc[ai][bj][m][0] + bv[bj][0], v1 = acc[ai][bj][m][1] + bv[bj][1];
#pragma unroll
                    for (int j = 0; j < 4; ++j) { v0[j] = sigm(v0[j]); v1[j] = sigm(v1[j]); }
                    u32x4 w; w.x = cvt_pk_bf16(v0[0], v0[1]); w.y = cvt_pk_bf16(v0[2], v0[3]); w.z = cvt_pk_bf16(v1[0], v1[1]); w.w = cvt_pk_bf16(v1[2], v1[3]);
                    *(GAS u32x4*)(rowp + bj * HALF) = w; } }
    }
};
struct EpiGateMul {
    static constexpr bool PERM = true, AFTER_DRAIN = false, FP8 = false;
    bf16_t* O; int ldc; const float* bias;
    __device__ __forceinline__ void operator()(const f32x4 (&acc)[2][2][4][2], const Unit& u, int wr, int wc, int fr, int fq) const {
        const int row0 = u.pm * BM + wr * 64 + fr, col0 = u.pn * BM + wc * 32 + 8 * fq;
        f32x4 bv[2][2];
#pragma unroll
        for (int bj = 0; bj < 2; ++bj)
#pragma unroll
            for (int n = 0; n < 2; ++n) bv[bj][n] = *(const GAS f32x4*)(bias + col0 + bj * HALF + 4 * n);
#pragma unroll
        for (int ai = 0; ai < 2; ++ai)
#pragma unroll
            for (int m = 0; m < 4; ++m) { bf16_t* rowp = O + (size_t)(row0 + ai * HALF + m * 16) * ldc + col0;
#pragma unroll
                for (int bj = 0; bj < 2; ++bj) { asm volatile("" ::: "memory"); const f32x4 v0 = acc[ai][bj][m][0] + bv[bj][0], v1 = acc[ai][bj][m][1] + bv[bj][1]; const u32x4 g = *(const GAS u32x4*)(rowp + bj * HALF);
                    u32x4 w; w.x = cvt_pk_bf16(sigm(v0[0]) * bflo(g.x), sigm(v0[1]) * bfhi(g.x)); w.y = cvt_pk_bf16(sigm(v0[2]) * bflo(g.y), sigm(v0[3]) * bfhi(g.y));
                    w.z = cvt_pk_bf16(sigm(v1[0]) * bflo(g.z), sigm(v1[1]) * bfhi(g.z)); w.w = cvt_pk_bf16(sigm(v1[2]) * bflo(g.w), sigm(v1[3]) * bfhi(g.w));
                    *(GAS u32x4*)(rowp + bj * HALF) = w; } }
    }
};
struct EpiPeMul {
    static constexpr bool PERM = true, AFTER_DRAIN = false, FP8 = false;
    bf16_t* O; int ldc;
    __device__ __forceinline__ void operator()(const f32x4 (&acc)[2][2][4][2], const Unit& u, int wr, int wc, int fr, int fq) const {
        const int row0 = u.pm * BM + wr * 64 + fr, col0 = u.pn * BM + wc * 32 + 8 * fq;
#pragma unroll
        for (int ai = 0; ai < 2; ++ai)
#pragma unroll
            for (int m = 0; m < 4; ++m) { bf16_t* rowp = O + (size_t)(row0 + ai * HALF + m * 16) * ldc + col0;
#pragma unroll
                for (int bj = 0; bj < 2; ++bj) { asm volatile("" ::: "memory"); const f32x4 v0 = acc[ai][bj][m][0], v1 = acc[ai][bj][m][1]; const u32x4 g = *(const GAS u32x4*)(rowp + bj * HALF);
                    u32x4 w; w.x = cvt_pk_bf16(v0[0] * bflo(g.x), v0[1] * bfhi(g.x)); w.y = cvt_pk_bf16(v0[2] * bflo(g.y), v0[3] * bfhi(g.y));
                    w.z = cvt_pk_bf16(v1[0] * bflo(g.z), v1[1] * bfhi(g.z)); w.w = cvt_pk_bf16(v1[2] * bflo(g.w), v1[3] * bfhi(g.w));
                    *(GAS u32x4*)(rowp + bj * HALF) = w; } }
    }
};

template <class Epi, class Sched, bool STAMP = false>
__device__ __forceinline__ void gemm_phase(PG8_LAS unsigned char* lds, const Gemm g, const Sched& S, const Epi& E, unsigned long long* stamps) {
    int tid_ = threadIdx.x; asm volatile("" : "+v"(tid_));
    const int tid = tid_, wid = __builtin_amdgcn_readfirstlane(tid >> 6), lane = tid & 63, wr = wid >> 2, wc = wid & 3, fr = lane & 15, fq = lane >> 4;
    const int K = g.K, nt = K / BK;
    int ts_lo = 0, ts_hi = 0, nts = 0; const unsigned long long rt_entry = STAMP ? (unsigned long long)wall_clock64() : 0ull;
#define PG8_STAMP() do { if (STAMP && wid == 0 && nts < 64) { const unsigned long long _c = (unsigned long long)clock64(); \
        ts_lo = (lane == nts) ? (int)(unsigned)_c : ts_lo; ts_hi = (lane == nts) ? (int)(unsigned)(_c >> 32) : ts_hi; ++nts; } } while (0)
    PG8_STAMP();
    unsigned voffA[2], voffB[2];
#pragma unroll
    for (int i = 0; i < 2; ++i) { int R, C; stage_rc(tid * 16 + i * 8192, R, C); const int Rb = Epi::PERM ? ((R & ~31) + perm32(R & 31)) : R;
        voffA[i] = (unsigned)(R * K + C) * 2u; voffB[i] = (unsigned)(Rb * K + C) * 2u; }
    const size_t kstep = (size_t)(BK * 2);
    const size_t hstep = (size_t)HALF * K * 2;
    const size_t tstep = 2 * hstep;
    const unsigned ldsw = (unsigned)wid * 1024u;
    const int aoff = lds_byte(wr * 64 + fr, fq * 8), boff = lds_byte(wc * 32 + fr, fq * 8);
#define PG8_SA(b, h) (((b) * 2 + (h)) * HTB)
#define PG8_SB(b, h) ((4 + (b) * 2 + (h)) * HTB)
#define PG8_STAGE(bufoff, gbase, voff) do { _Pragma("unroll") for (int _i = 0; _i < 2; ++_i) \
        __builtin_amdgcn_global_load_lds((const unsigned*)((const char*)(gbase) + (voff)[_i]), (PG8_LAS unsigned*)(lds + (bufoff) + ldsw + _i * 8192), 16, 0, 0); } while (0)
#define PG8_LDA(dst, b, h) do { _Pragma("unroll") for (int m = 0; m < 4; ++m) { dst[m].lo = *(const PG8_LAS v4i*)(lds + PG8_SA(b, h) + aoff + m * 2048); dst[m].hi = *(const PG8_LAS v4i*)(lds + PG8_SA(b, h) + aoff + m * 2048 + 1024); } } while (0)
#define PG8_LDB(dst, b, h) do { _Pragma("unroll") for (int n = 0; n < 2; ++n) { dst[n].lo = *(const PG8_LAS v4i*)(lds + PG8_SB(b, h) + boff + n * 2048); dst[n].hi = *(const PG8_LAS v4i*)(lds + PG8_SB(b, h) + boff + n * 2048 + 1024); } } while (0)
#define PG8_MMA(ai, bj, At, Bt) do { __builtin_amdgcn_s_setprio(1); \
        if constexpr (Epi::FP8) { _Pragma("unroll") for (int m = 0; m < 4; ++m) _Pragma("unroll") for (int n = 0; n < 2; ++n) \
            asm volatile("v_mfma_f32_16x16x128_f8f6f4 %0, %1, %2, %0" : "+v"(acc[ai][bj][m][n]) : "v"(Bt[n]), "v"(At[m])); } \
        else { _Pragma("unroll") for (int m = 0; m < 4; ++m) _Pragma("unroll") for (int n = 0; n < 2; ++n) { \
            const v4i bl_ = Bt[n].lo, bh_ = Bt[n].hi, al_ = At[m].lo, ah_ = At[m].hi;     \
            acc[ai][bj][m][n] = __builtin_amdgcn_mfma_f32_16x16x32_bf16(__builtin_bit_cast(bf16x8, bl_), __builtin_bit_cast(bf16x8, al_), acc[ai][bj][m][n], 0, 0, 0); \
            acc[ai][bj][m][n] = __builtin_amdgcn_mfma_f32_16x16x32_bf16(__builtin_bit_cast(bf16x8, bh_), __builtin_bit_cast(bf16x8, ah_), acc[ai][bj][m][n], 0, 0, 0); } } \
        __builtin_amdgcn_s_setprio(0); } while (0)
#define PG8_WAIT_V(n) asm volatile("s_waitcnt vmcnt(" #n ")" ::: "memory")
#define PG8_WAIT_L(n) asm volatile("s_waitcnt lgkmcnt(" #n ")" ::: "memory")
#define PG8_BAR __builtin_amdgcn_s_barrier()
#define PG8_SCHED __builtin_amdgcn_sched_barrier(0)
    Unit cur, nxt; int ui = 0;
    if (!S.next(0, cur)) return;
    f32x4 acc[2][2][4][2];
#pragma unroll
    for (int a = 0; a < 2; ++a)
#pragma unroll
        for (int b = 0; b < 2; ++b)
#pragma unroll
            for (int m = 0; m < 4; ++m)
#pragma unroll
                for (int n = 0; n < 2; ++n) acc[a][b][m][n] = (f32x4){0.f, 0.f, 0.f, 0.f};
    v8i At[4], B0[2], B1[2];
    const char* cA = (const char*)g.A + (size_t)cur.pm * tstep; const char* cB = (const char*)g.Bt + cur.boff + (size_t)cur.pn * tstep;
    S.a_ready(cur);
    PG8_STAGE(PG8_SB(0, 0), cB, voffB); PG8_STAGE(PG8_SA(0, 0), cA, voffA); PG8_STAGE(PG8_SB(0, 1), cB + hstep, voffB); PG8_STAGE(PG8_SA(0, 1), cA + hstep, voffA);
    if (wr == 1) PG8_BAR;
    PG8_WAIT_V(4); PG8_BAR;
    PG8_STAGE(PG8_SB(1, 0), cB + kstep, voffB); PG8_STAGE(PG8_SA(1, 0), cA + kstep, voffA); PG8_STAGE(PG8_SB(1, 1), cB + hstep + kstep, voffB);
    PG8_WAIT_V(6); PG8_BAR;
    PG8_STAMP();
    for (;;) {
        const bool has_next = S.next(ui + 1, nxt);
        const char* nA = has_next ? (const char*)g.A + (size_t)nxt.pm * tstep : cA; const char* nB = has_next ? (const char*)g.Bt + nxt.boff + (size_t)nxt.pn * tstep : cB;
#pragma nounroll
        for (int t = 0; t < nt; t += 2) {
            const bool last = (t == nt - 2);
            const char* a1 = cA + (size_t)(t + 1) * kstep;
            const char* a2 = last ? nA : cA + (size_t)(t + 2) * kstep; const char* b2 = last ? nB : cB + (size_t)(t + 2) * kstep;
            const char* a3 = a2 + kstep; const char* b3 = b2 + kstep;
            if (last && has_next) S.a_ready(nxt);
            PG8_LDB(B0, 0, 0); PG8_SCHED; PG8_LDA(At, 0, 0); PG8_STAGE(PG8_SA(1, 1), a1 + hstep, voffA);
            PG8_WAIT_L(8); PG8_BAR; PG8_WAIT_L(0); PG8_MMA(0, 0, At, B0); PG8_BAR; PG8_SCHED;
            PG8_LDB(B1, 0, 1); PG8_STAGE(PG8_SB(0, 0), b2, voffB);
            PG8_BAR; PG8_WAIT_L(0); PG8_MMA(0, 1, At, B1); PG8_BAR;
            PG8_LDA(At, 0, 1); PG8_STAGE(PG8_SA(0, 0), a2, voffA);
            PG8_BAR; PG8_WAIT_L(0); PG8_MMA(1, 0, At, B0); PG8_BAR; PG8_SCHED;
            PG8_STAGE(PG8_SB(0, 1), b2 + hstep, voffB);
            PG8_WAIT_V(6); PG8_BAR; PG8_MMA(1, 1, At, B1); PG8_BAR;
            PG8_LDB(B0, 1, 0); PG8_SCHED; PG8_LDA(At, 1, 0); PG8_STAGE(PG8_SA(0, 1), a2 + hstep, voffA);
            PG8_WAIT_L(8); PG8_BAR; PG8_WAIT_L(0); PG8_MMA(0, 0, At, B0); PG8_BAR; PG8_SCHED;
            PG8_LDB(B1, 1, 1); PG8_STAGE(PG8_SB(1, 0), b3, voffB);
            PG8_BAR; PG8_WAIT_L(0); PG8_MMA(0, 1, At, B1); PG8_BAR;
            PG8_LDA(At, 1, 1); PG8_STAGE(PG8_SA(1, 0), a3, voffA);
            PG8_BAR; PG8_WAIT_L(0); PG8_MMA(1, 0, At, B0); PG8_BAR; PG8_SCHED;
            PG8_STAGE(PG8_SB(1, 1), b3 + hstep, voffB);
            PG8_WAIT_V(6); PG8_BAR; PG8_MMA(1, 1, At, B1); PG8_BAR;
        }
        PG8_STAMP();
        if constexpr (Epi::FP8) { asm volatile("s_nop 15\n\ts_nop 15" : "+v"(acc[0][0][0][0]), "+v"(acc[0][0][0][1]), "+v"(acc[0][0][1][0]), "+v"(acc[0][0][1][1]), "+v"(acc[0][0][2][0]), "+v"(acc[0][0][2][1]), "+v"(acc[0][0][3][0]), "+v"(acc[0][0][3][1]), "+v"(acc[0][1][0][0]), "+v"(acc[0][1][0][1]), "+v"(acc[0][1][1][0]), "+v"(acc[0][1][1][1]), "+v"(acc[0][1][2][0]), "+v"(acc[0][1][2][1]), "+v"(acc[0][1][3][0]), "+v"(acc[0][1][3][1]));
                                  asm volatile("" : "+v"(acc[1][0][0][0]), "+v"(acc[1][0][0][1]), "+v"(acc[1][0][1][0]), "+v"(acc[1][0][1][1]), "+v"(acc[1][0][2][0]), "+v"(acc[1][0][2][1]), "+v"(acc[1][0][3][0]), "+v"(acc[1][0][3][1]), "+v"(acc[1][1][0][0]), "+v"(acc[1][1][0][1]), "+v"(acc[1][1][1][0]), "+v"(acc[1][1][1][1]), "+v"(acc[1][1][2][0]), "+v"(acc[1][1][2][1]), "+v"(acc[1][1][3][0]), "+v"(acc[1][1][3][1])); }
        if constexpr (!Epi::AFTER_DRAIN) { E(acc, cur, wr, wc, fr, fq); S.done(cur); }
        PG8_STAMP();
        if (!has_next) break;
#pragma unroll
        for (int a = 0; a < 2; ++a)
#pragma unroll
            for (int b = 0; b < 2; ++b)
#pragma unroll
                for (int m = 0; m < 4; ++m)
#pragma unroll
                    for (int n = 0; n < 2; ++n) acc[a][b][m][n] = (f32x4){0.f, 0.f, 0.f, 0.f};
        cur = nxt; cA = nA; cB = nB; ++ui;
    }
    PG8_WAIT_V(0);
    if (wr == 0) PG8_BAR;
    PG8_BAR;
    if constexpr (Epi::AFTER_DRAIN) { E.fused(acc, cur, wr, wc, fr, fq, lds, wid, lane); S.done(cur); }
    PG8_STAMP();
    if (STAMP && wid == 0) { stamps[lane] = lane < nts ? (((unsigned long long)(unsigned)ts_hi << 32) | (unsigned)ts_lo) : 0ull;
        if (lane == 62) stamps[62] = rt_entry; if (lane == 63) stamps[63] = (unsigned long long)wall_clock64(); }
#undef PG8_STAMP
#undef PG8_SA
#undef PG8_SB
#undef PG8_STAGE
#undef PG8_LDA
#undef PG8_LDB
#undef PG8_MMA
#undef PG8_WAIT_V
#undef PG8_WAIT_L
#undef PG8_BAR
#undef PG8_SCHED
}
}
template <class F>
DI void mm_lds(const LAS bf16_t* A, int lda, const LAS bf16_t* Bt, int ldb, int M, int N, int K, int wave, int lane, F epi) {
    const int ntn = N >> 4, nt = (M >> 4) * ntn, r = lane & 15, q = lane >> 4;
    for (int t = wave; t < nt; t += 8) {
        const int m0 = (t / ntn) << 4, n0 = (t % ntn) << 4;
        f32x4 acc = {0.f, 0.f, 0.f, 0.f};
        for (int k0 = 0; k0 < K; k0 += 32) {
            const bf16x8 a = *(const LAS bf16x8*)(A + (m0 + r) * lda + k0 + q * 8);
            const bf16x8 b = *(const LAS bf16x8*)(Bt + (n0 + r) * ldb + k0 + q * 8);
            acc = __builtin_amdgcn_mfma_f32_16x16x32_bf16(b, a, acc, 0, 0, 0);
        }
        epi(m0 + r, n0 + 4 * q, acc);
    }
}
template <class F>
DI void mm_lds2(const LAS bf16_t* A1, int lda1, const LAS bf16_t* Bt1, int ldb1, int K1, const LAS bf16_t* A2, int lda2, const LAS bf16_t* Bt2, int ldb2, int K2,
                int M, int N, int wave, int lane, F epi) {
    const int ntn = N >> 4, nt = (M >> 4) * ntn, r = lane & 15, q = lane >> 4;
    for (int t = wave; t < nt; t += 8) {
        const int m0 = (t / ntn) << 4, n0 = (t % ntn) << 4;
        f32x4 acc1 = {0.f, 0.f, 0.f, 0.f}, acc2 = {0.f, 0.f, 0.f, 0.f};
        for (int k0 = 0; k0 < K1; k0 += 32) {
            const bf16x8 a = *(const LAS bf16x8*)(A1 + (m0 + r) * lda1 + k0 + q * 8);
            const bf16x8 b = *(const LAS bf16x8*)(Bt1 + (n0 + r) * ldb1 + k0 + q * 8);
            acc1 = __builtin_amdgcn_mfma_f32_16x16x32_bf16(b, a, acc1, 0, 0, 0);
        }
        for (int k0 = 0; k0 < K2; k0 += 32) {
            const bf16x8 a = *(const LAS bf16x8*)(A2 + (m0 + r) * lda2 + k0 + q * 8);
            const bf16x8 b = *(const LAS bf16x8*)(Bt2 + (n0 + r) * ldb2 + k0 + q * 8);
            acc2 = __builtin_amdgcn_mfma_f32_16x16x32_bf16(b, a, acc2, 0, 0, 0);
        }
        epi(m0 + r, n0 + 4 * q, acc1, acc2);
    }
}
template <int CTRL> DI float dppf(float v) { return __builtin_bit_cast(float, __builtin_amdgcn_update_dpp(0, __builtin_bit_cast(int, v), CTRL, 0xF, 0xF, true)); }
DI float red4(float v) { v += dppf<0xB1>(v); v += dppf<0x4E>(v); return v; }
DI float red8(float v) { v += dppf<0xB1>(v); v += dppf<0x4E>(v); v += dppf<0x141>(v); return v; }
DI void st_bf16x4(LAS bf16_t* p, const f32x4 v) { u32x2 w; w.x = pack_bf16(v[0], v[1]); w.y = pack_bf16(v[2], v[3]); *(LAS u32x2*)p = w; }
template <int NT, class FO>
DI void mm_lds_state(const LAS bf16_t* A, int lda, const LAS bf16_t* Bt, int ldb, int ntn, int K, int wave, int lane, f32x4 (&st)[NT], float decay, FO out) {
    const int r = lane & 15, q = lane >> 4;
#pragma unroll
    for (int i = 0; i < NT; ++i) {
        const int t = wave + 8 * i, m0 = (t / ntn) << 4, n0 = (t % ntn) << 4;
        f32x4 acc = st[i] * decay;
        for (int k0 = 0; k0 < K; k0 += 32) {
            const bf16x8 a = *(const LAS bf16x8*)(A + (m0 + r) * lda + k0 + q * 8);
            const bf16x8 b = *(const LAS bf16x8*)(Bt + (n0 + r) * ldb + k0 + q * 8);
            acc = __builtin_amdgcn_mfma_f32_16x16x32_bf16(b, a, acc, 0, 0, 0);
        }
        st[i] = acc; out(m0 + r, n0 + 4 * q, acc);
    }
}
template <int CTRL, int RM> DI float dppo(float old, float v) { return __builtin_bit_cast(float, __builtin_amdgcn_update_dpp(__builtin_bit_cast(int, old), __builtin_bit_cast(int, v), CTRL, RM, 0xF, false)); }
DI float wave_scan_add(float v, int) {
    v += dppo<0x111, 0xF>(0.f, v); v += dppo<0x112, 0xF>(0.f, v); v += dppo<0x114, 0xF>(0.f, v); v += dppo<0x118, 0xF>(0.f, v);
    v += dppo<0x142, 0xA>(0.f, v); v += dppo<0x143, 0xC>(0.f, v); return v;
}
DI float wave_scan_max(float v, int) {
    const float ni = -3.0e38f;
    v = fmaxf(v, dppo<0x111, 0xF>(ni, v)); v = fmaxf(v, dppo<0x112, 0xF>(ni, v)); v = fmaxf(v, dppo<0x114, 0xF>(ni, v)); v = fmaxf(v, dppo<0x118, 0xF>(ni, v));
    v = fmaxf(v, dppo<0x142, 0xA>(ni, v)); v = fmaxf(v, dppo<0x143, 0xC>(ni, v)); return v;
}
DI float lane63(float v) { return __builtin_bit_cast(float, __builtin_amdgcn_readlane(__builtin_bit_cast(int, v), 63)); }
DI float wave_max(float v) {
#pragma unroll
    for (int o = 32; o >= 1; o >>= 1) v = fmaxf(v, __shfl_xor(v, o));
    return v;
}
DI float red16(float v) { v += dppf<0xB1>(v); v += dppf<0x4E>(v); v += dppf<0x141>(v); v += dppf<0x140>(v); return v; }
template <class F>
DI void mm_lds_w(const LAS bf16_t* A, int lda, const LAS bf16_t* Bt, int ldb, int M, int N, int K, int pw, int nw, int lane, F epi) {
    const int ntn = N >> 4, nt = (M >> 4) * ntn, r = lane & 15, q = lane >> 4;
    for (int t = pw; t < nt; t += nw) {
        const int m0 = (t / ntn) << 4, n0 = (t % ntn) << 4;
        f32x4 acc = {0.f, 0.f, 0.f, 0.f};
        for (int k0 = 0; k0 < K; k0 += 32) {
            const bf16x8 a = *(const LAS bf16x8*)(A + (m0 + r) * lda + k0 + q * 8);
            const bf16x8 b = *(const LAS bf16x8*)(Bt + (n0 + r) * ldb + k0 + q * 8);
            acc = __builtin_amdgcn_mfma_f32_16x16x32_bf16(b, a, acc, 0, 0, 0);
        }
        epi(m0 + r, n0 + 4 * q, acc);
    }
}

DI float wave_sum(float v) { return lane63(wave_scan_add(v, 0)); }
#ifndef MOE_FP8
#define MOE_FP8 1
#endif
struct Ctx {
    LAS unsigned char* lds;
    int tid, lane, wave, G, bid;
};

DI void cvt_tile(const Ctx& c, const float* __restrict__ s, bf16_t* __restrict__ d, int K, int N, int mode, int k0, int n0) {
    LAS float* tile = (LAS float*)c.lds;
#pragma unroll
    for (int i = 0; i < 8; ++i) { const int row = i * 8 + (c.tid >> 6), col = c.tid & 63, n = n0 + col;
        tile[row * 65 + col] = (n < N) ? s[(size_t)(k0 + row) * N + n] : 0.f; }
    __syncthreads();
    { const int n = c.tid >> 3, kk = (c.tid & 7) * 8, ng = n0 + n;
      int drow = ng; if (mode == 1) drow = (ng >> 7) * 256 + (ng & 127); else if (mode == 2) drow = (ng >> 7) * 256 + 128 + (ng & 127);
      u32x4 w; w.x = pack_bf16(tile[(kk + 0) * 65 + n], tile[(kk + 1) * 65 + n]); w.y = pack_bf16(tile[(kk + 2) * 65 + n], tile[(kk + 3) * 65 + n]);
      w.z = pack_bf16(tile[(kk + 4) * 65 + n], tile[(kk + 5) * 65 + n]); w.w = pack_bf16(tile[(kk + 6) * 65 + n], tile[(kk + 7) * 65 + n]);
      *(GAS u32x4*)(d + (size_t)drow * K + k0 + kk) = w; }
    __syncthreads();
}
DI void cvt_weight(const Ctx& c, const float* __restrict__ src, bf16_t* __restrict__ dst, int K, int N, int mode, int nb, size_t sstride, size_t dstride, int& rot) {
    const int ntk = K >> 6, ntn = (N + 63) >> 6, per = ntk * ntn, total = per * nb;
    int first = c.bid - rot; if (first < 0) first += c.G;
    for (int t = first; t < total; t += c.G) {
        const int b = t / per, r = t - b * per, tk = r / ntn, tn = r - tk * ntn;
        cvt_tile(c, src + (size_t)b * sstride, dst + (size_t)b * dstride, K, N, mode, tk << 6, tn << 6);
    }
    rot = (rot + total) % c.G;
}
DI void cvt_act(const Ctx& c, const float* __restrict__ src, bf16_t* __restrict__ dst, size_t n) {
    const size_t nv = n >> 3;
    for (size_t i = (size_t)c.bid * 512 + c.tid; i < nv; i += (size_t)c.G * 512) {
        const f32x4 a = *(const GAS f32x4*)(src + i * 8), b = *(const GAS f32x4*)(src + i * 8 + 4);
        u32x4 w; w.x = pack_bf16(a[0], a[1]); w.y = pack_bf16(a[2], a[3]); w.z = pack_bf16(b[0], b[1]); w.w = pack_bf16(b[2], b[3]);
        *(GAS u32x4*)(dst + i * 8) = w;
    }
}

struct Route { int e0, e1; float g0, g1; int s0, s1; int pad0, pad1; };
template <bool COMBINE, bool ROUTE, bool WRITEX>
DI void ln_phase(const Ctx& c, float* __restrict__ X, const bf16_t* __restrict__ PRE, bf16_t* __restrict__ XB, unsigned char* __restrict__ XB8, const float* __restrict__ gam, const float* __restrict__ bet,
                 const bf16_t* __restrict__ YB, const bf16_t* __restrict__ PEb, Route* __restrict__ route, const float* __restrict__ wr, unsigned* __restrict__ counts) {
    LAS float* wrs = (LAS float*)c.lds;
    LAS unsigned* lcnt = (LAS unsigned*)(c.lds + 32768);
    if (ROUTE) {
        for (int i = c.tid; i < 1024 * 8; i += 512) wrs[i] = wr[i];
        if (c.tid < NE) lcnt[c.tid] = 0u;
        __syncthreads();
    }
    f32x4 gv[4], bv[4];
#pragma unroll
    for (int i = 0; i < 4; ++i) { gv[i] = *(const GAS f32x4*)(gam + i * 256 + c.lane * 4); bv[i] = *(const GAS f32x4*)(bet + i * 256 + c.lane * 4); }
    for (int row = c.bid * 8 + c.wave; row < T; row += c.G * 8) {
        float* xr = X + (size_t)row * D;
        f32x4 v[4];
        if (!COMBINE) {
#pragma unroll
            for (int i = 0; i < 4; ++i) { const u32x2 w = *(const GAS u32x2*)(PRE + (size_t)row * D + i * 256 + c.lane * 4); v[i][0] = pg8::bflo(w.x); v[i][1] = pg8::bfhi(w.x); v[i][2] = pg8::bflo(w.y); v[i][3] = pg8::bfhi(w.y); }
        } else {
#pragma unroll
            for (int i = 0; i < 4; ++i) { const u32x2 w = *(const GAS u32x2*)(XB + (size_t)row * D + i * 256 + c.lane * 4); v[i][0] = pg8::bflo(w.x); v[i][1] = pg8::bfhi(w.x); v[i][2] = pg8::bflo(w.y); v[i][3] = pg8::bfhi(w.y); }
        }
        if (COMBINE) {
            const Route rt = route[row];
            const bf16_t* y0 = YB + (size_t)rt.s0 * D; const bf16_t* y1 = YB + (size_t)rt.s1 * D; const bf16_t* pe = PEb + (size_t)row * D;
#pragma unroll
            for (int i = 0; i < 4; ++i) { const int o = i * 256 + c.lane * 4;
                const u32x2 a = *(const GAS u32x2*)(y0 + o), b = *(const GAS u32x2*)(y1 + o), p = *(const GAS u32x2*)(pe + o);
                v[i][0] = ALPHA * v[i][0] + rt.g0 * pg8::bflo(a.x) + rt.g1 * pg8::bflo(b.x) + pg8::bflo(p.x);
                v[i][1] = ALPHA * v[i][1] + rt.g0 * pg8::bfhi(a.x) + rt.g1 * pg8::bfhi(b.x) + pg8::bfhi(p.x);
                v[i][2] = ALPHA * v[i][2] + rt.g0 * pg8::bflo(a.y) + rt.g1 * pg8::bflo(b.y) + pg8::bflo(p.y);
                v[i][3] = ALPHA * v[i][3] + rt.g0 * pg8::bfhi(a.y) + rt.g1 * pg8::bfhi(b.y) + pg8::bfhi(p.y); }
        }
        float s = 0.f;
#pragma unroll
        for (int i = 0; i < 4; ++i) s += (v[i][0] + v[i][1]) + (v[i][2] + v[i][3]);
        const float mean = wave_sum(s) * (1.0f / D);
        float q = 0.f;
#pragma unroll
        for (int i = 0; i < 4; ++i) { v[i] = v[i] - mean; q += (v[i][0] * v[i][0] + v[i][1] * v[i][1]) + (v[i][2] * v[i][2] + v[i][3] * v[i][3]); }
        const float rstd = rsqrtf(wave_sum(q) * (1.0f / D) + 1e-5f);
#pragma unroll
        for (int i = 0; i < 4; ++i) { v[i] = v[i] * rstd * gv[i] + bv[i];
            if (WRITEX) *(GAS f32x4*)(xr + i * 256 + c.lane * 4) = v[i];
            u32x2 w; w.x = pack_bf16(v[i][0], v[i][1]); w.y = pack_bf16(v[i][2], v[i][3]);
            *(GAS u32x2*)(XB + (size_t)row * D + i * 256 + c.lane * 4) = w;
            if (XB8) *(GAS unsigned*)(XB8 + (size_t)row * D + i * 256 + c.lane * 4) = pg8::pk4_fp8(v[i][0], v[i][1], v[i][2], v[i][3]); }
        if (ROUTE) {
            float lg[NE];
#pragma unroll
            for (int e = 0; e < NE; ++e) lg[e] = 0.f;
#pragma unroll
            for (int i = 0; i < 4; ++i)
#pragma unroll
                for (int j = 0; j < 4; ++j) { const int d = i * 256 + c.lane * 4 + j; const f32x4 w0 = *(const LAS f32x4*)(wrs + d * 8), w1 = *(const LAS f32x4*)(wrs + d * 8 + 4);
                    lg[0] += v[i][j] * w0[0]; lg[1] += v[i][j] * w0[1]; lg[2] += v[i][j] * w0[2]; lg[3] += v[i][j] * w0[3];
                    lg[4] += v[i][j] * w1[0]; lg[5] += v[i][j] * w1[1]; lg[6] += v[i][j] * w1[2]; lg[7] += v[i][j] * w1[3]; }
#pragma unroll
            for (int e = 0; e < NE; ++e) lg[e] = wave_sum(lg[e]);
            int e0 = 0; float l0 = lg[0];
#pragma unroll
            for (int e = 1; e < NE; ++e) if (lg[e] > l0) { l0 = lg[e]; e0 = e; }
            int e1 = -1; float l1 = -3.0e38f;
#pragma unroll
            for (int e = 0; e < NE; ++e) if (e != e0 && lg[e] > l1) { l1 = lg[e]; e1 = e; }
            if (c.lane == 0) {
                const float g0 = 1.0f / (1.0f + __expf(l1 - l0));
                u32x4 rw; rw.x = (unsigned)e0; rw.y = (unsigned)e1; rw.z = __float_as_uint(g0); rw.w = __float_as_uint(1.0f - g0);
                *(GAS u32x4*)&route[row] = rw;
                atomicAdd((unsigned*)&lcnt[e0], 1u); atomicAdd((unsigned*)&lcnt[e1], 1u);
            }
        }
    }
    if (ROUTE) {
        __syncthreads();
        if (c.tid < NE) atomicAdd(&counts[c.tid], lcnt[c.tid]);
    }
}

DI void moe_assign_gather(const Ctx& c, Route* __restrict__ route, const unsigned* __restrict__ counts, unsigned* __restrict__ cursor, const bf16_t* __restrict__ XB, bf16_t* __restrict__ XG) {
    LAS unsigned* lcnt = (LAS unsigned*)c.lds;
    LAS unsigned* lbase = lcnt + 8;
    LAS int* lslot = (LAS int*)(lcnt + 16);
    unsigned pstart[NE]; { unsigned acc = 0;
#pragma unroll
        for (int e = 0; e < NE; ++e) { pstart[e] = acc; acc += ((counts[e] + 255u) >> 8) << 8; } }
    for (int chunk = c.bid; chunk < T / 128; chunk += c.G) {
        if (c.tid < NE) lcnt[c.tid] = 0u;
        __syncthreads();
        const int tok = chunk * 128 + c.tid; int e0 = 0, e1 = 0; unsigned r0 = 0, r1 = 0;
        if (c.tid < 128) { e0 = route[tok].e0; e1 = route[tok].e1; r0 = atomicAdd((unsigned*)&lcnt[e0], 1u); r1 = atomicAdd((unsigned*)&lcnt[e1], 1u); }
        __syncthreads();
        if (c.tid < NE) lbase[c.tid] = atomicAdd(&cursor[c.tid], lcnt[c.tid]);
        __syncthreads();
        if (c.tid < 128) {
            unsigned p0 = 0, p1 = 0;
#pragma unroll
            for (int e = 0; e < NE; ++e) { if (e == e0) p0 = pstart[e]; if (e == e1) p1 = pstart[e]; }
            const int s0 = (int)(p0 + lbase[e0] + r0), s1 = (int)(p1 + lbase[e1] + r1);
            route[tok].s0 = s0; route[tok].s1 = s1; lslot[c.tid * 2] = s0; lslot[c.tid * 2 + 1] = s1;
        }
        __syncthreads();
        for (int pr = c.tid >> 7; pr < 256; pr += 4) {
            const int tk = chunk * 128 + (pr >> 1); const int slot = lslot[pr]; const int o = (c.tid & 127) * 8;
#if !MOE_FP8
            *(GAS u32x4*)(XG + (size_t)slot * D + o) = *(const GAS u32x4*)(XB + (size_t)tk * D + o);
#else
            const u32x4 xw = *(const GAS u32x4*)(XB + (size_t)tk * D + o);
            u32x2 w8; w8.x = pg8::pk4_fp8(pg8::bflo(xw.x), pg8::bfhi(xw.x), pg8::bflo(xw.y), pg8::bfhi(xw.y)); w8.y = pg8::pk4_fp8(pg8::bflo(xw.z), pg8::bfhi(xw.z), pg8::bflo(xw.w), pg8::bfhi(xw.w));
            *(GAS u32x2*)((unsigned char*)XG + (size_t)slot * D + o) = w8;
#endif
        }
        __syncthreads();
    }
}
struct MixP {
    const GAS bf16_t* proj; GAS bf16_t* mix; int layer;
    const GAS float *m_i_bias, *m_f_bias, *m_norm_w;
    const GAS float *g_conv_w, *g_conv_b, *g_w_a, *g_b_a, *g_w_x, *g_b_x, *g_lambda;
    const GAS float *r_mu, *r_w0, *r_w2, *r_a0, *r_a2, *r_g2, *r_k_k, *r_k_a, *r_r_k, *r_ln_w, *r_ln_b;
    const GAS float *s_conv_w, *s_conv_b, *s_dt_bias, *s_a_log, *s_d, *s_norm_w;
};
constexpr int TC = 32;
DI float ldp(const GAS bf16_t* proj, int t, int col) { return bf2f(proj[(size_t)t * NINP + col]); }
DI void stage_rows(const Ctx& c, LAS bf16_t* dst, int ldd, const GAS bf16_t* proj, int b, int srow0, int nrows, int col0, int ncols) {
    const int pc = ncols >> 3, np = nrows * pc;
    for (int p = c.tid; p < np; p += 512) { const int r = p / pc, c8 = p - r * pc, s = srow0 + r;
        u32x4 v = {0u, 0u, 0u, 0u}; if (s >= 0) v = *(const GAS u32x4*)(proj + (size_t)(b * SEQ + s) * NINP + col0 + c8 * 8);
        *(LAS u32x4*)(dst + r * ldd + c8 * 8) = v; }
}
DI void mix_mlstm_v2(const Ctx& c, const MixP& P, int b, int h) {
    constexpr int LD = 72;
    LAS bf16_t* Qs = (LAS bf16_t*)c.lds; LAS bf16_t* Ks = Qs + 64 * LD; LAS bf16_t* KT = Ks + 64 * LD; LAS bf16_t* VT = KT + 64 * LD; LAS bf16_t* VwT = VT + 64 * LD;
    LAS bf16_t* Sb = VwT + 64 * LD; LAS bf16_t* Cb = Sb + 64 * LD;
    LAS float* Hn = (LAS float*)(c.lds + 64512); LAS float* Og = Hn + 64 * 64;
    LAS float* Li = Og + 64 * 64; LAS float* Bc = Li + 64; LAS float* Mt = Bc + 64; LAS float* Iw = Mt + 64; LAS float* Wg = Iw + 64; LAS float* Qn = Wg + 64;
    LAS float* Inv = Qn + 64; LAS float* Nv = Inv + 64; LAS float* Sc = Nv + 64; LAS float* Np = Sc + 64;
    const int L = P.layer; const float ib = P.m_i_bias[L * 4 + h], fb = P.m_f_bias[L * 4 + h];
    const int l = c.tid >> 3, part = c.tid & 7;
    f32x4 Cst[2] = {{0.f, 0.f, 0.f, 0.f}, {0.f, 0.f, 0.f, 0.f}};
    for (int i = c.tid; i < 64 * LD; i += 512) Cb[i] = 0;
    if (c.tid < 64) Nv[c.tid] = 0.f;
    if (c.tid == 0) { Sc[0] = 1.f; Sc[1] = 0.f; }
    __syncthreads();
    u32x4 qw, kw, vw, ow; float gi = 0.f, gf = 0.f;
#define ML_FETCH(S0) do { const int t_ = b * SEQ + (S0) + l; const GAS bf16_t* pr = P.proj + (size_t)t_ * NINP + OFF_M + h * 64 + part * 8; \
        qw = *(const GAS u32x4*)pr; kw = *(const GAS u32x4*)(pr + 256); vw = *(const GAS u32x4*)(pr + 512); ow = *(const GAS u32x4*)(pr + 768); \
        if (part == 0) { gi = ldp(P.proj, t_, OFF_M + 1024 + h); gf = ldp(P.proj, t_, OFF_M + 1028 + h); } } while (0)
    ML_FETCH(0);
    for (int s0 = 0; s0 < SEQ; s0 += 64) {
        const int t = b * SEQ + s0 + l;
        {
          *(LAS u32x4*)(Qs + l * LD + part * 8) = qw;
          const unsigned kk[4] = {kw.x, kw.y, kw.z, kw.w}, vv[4] = {vw.x, vw.y, vw.z, vw.w}, oo[4] = {ow.x, ow.y, ow.z, ow.w};
          u32x4 ks;
#pragma unroll
          for (int j = 0; j < 4; ++j) { const float k0 = pg8::bflo(kk[j]) * 0.125f, k1 = pg8::bfhi(kk[j]) * 0.125f; const unsigned pk = pack_bf16(k0, k1);
              if (j == 0) ks.x = pk; else if (j == 1) ks.y = pk; else if (j == 2) ks.z = pk; else ks.w = pk;
              KT[(part * 8 + 2 * j) * LD + l] = (bf16_t)(pk & 0xFFFFu); KT[(part * 8 + 2 * j + 1) * LD + l] = (bf16_t)(pk >> 16);
              VT[(part * 8 + 2 * j) * LD + l] = (bf16_t)(vv[j] & 0xFFFFu); VT[(part * 8 + 2 * j + 1) * LD + l] = (bf16_t)(vv[j] >> 16);
              Og[l * 64 + part * 8 + 2 * j] = sigmoidf_(pg8::bflo(oo[j])); Og[l * 64 + part * 8 + 2 * j + 1] = sigmoidf_(pg8::bfhi(oo[j])); }
          *(LAS u32x4*)(Ks + l * LD + part * 8) = ks;
          if (part == 0) { Li[l] = gi + ib; Bc[l] = -softplusf_(-(gf + fb)); } }
        if (s0 + 64 < SEQ) ML_FETCH(s0 + 64);
        __syncthreads();
        if (c.wave == 1 && s0 > 0) { float acc = 0.f;
#pragma unroll
            for (int j = 0; j < 8; ++j) acc += Np[j * 64 + c.lane];
            Nv[c.lane] = acc; }
        if (c.wave == 0) {
            const float mprev = Sc[1]; const float li = Li[c.lane];
            const float bb = wave_scan_add(Bc[c.lane], c.lane);
            const float g = lane63(bb);
            const float pm = wave_scan_max(li - bb, c.lane);
            const float a = g - bb + li; const float amax = lane63(wave_scan_max(a, c.lane));
            const float mt = fmaxf(bb + mprev, bb + pm);
            const float mnew = fmaxf(g + mprev, amax);
            Bc[c.lane] = bb; Mt[c.lane] = mt; Iw[c.lane] = __expf(bb + mprev - mt); Wg[c.lane] = __expf(a - mnew);
            if (c.lane == 0) { Sc[0] = __expf(g + mprev - mnew); Sc[1] = mnew; }
        }
        __syncthreads();
        mm_lds(Qs, LD, Ks, LD, 64, 64, 64, c.wave, c.lane, [&](int row, int col0, const f32x4& a) {
            const float bl = Bc[row] - Mt[row]; f32x4 o;
#pragma unroll
            for (int j = 0; j < 4; ++j) { const int sidx = col0 + j; o[j] = (sidx <= row) ? a[j] * __expf(bl - Bc[sidx] + Li[sidx]) : 0.f; }
            st_bf16x4(Sb + row * LD + col0, o); });
        {
          const u32x4 vt = *(const LAS u32x4*)(VT + l * LD + part * 8); const f32x4 w0 = *(const LAS f32x4*)(Wg + part * 8), w1 = *(const LAS f32x4*)(Wg + part * 8 + 4);
          u32x4 o; o.x = pack_bf16(pg8::bflo(vt.x) * w0[0], pg8::bfhi(vt.x) * w0[1]); o.y = pack_bf16(pg8::bflo(vt.y) * w0[2], pg8::bfhi(vt.y) * w0[3]);
          o.z = pack_bf16(pg8::bflo(vt.z) * w1[0], pg8::bfhi(vt.z) * w1[1]); o.w = pack_bf16(pg8::bflo(vt.w) * w1[2], pg8::bfhi(vt.w) * w1[3]);
          *(LAS u32x4*)(VwT + l * LD + part * 8) = o;
          const u32x4 qw = *(const LAS u32x4*)(Qs + l * LD + part * 8); const f32x4 n0 = *(const LAS f32x4*)(Nv + part * 8), n1 = *(const LAS f32x4*)(Nv + part * 8 + 4);
          float d = pg8::bflo(qw.x) * n0[0] + pg8::bfhi(qw.x) * n0[1] + pg8::bflo(qw.y) * n0[2] + pg8::bfhi(qw.y) * n0[3]
                  + pg8::bflo(qw.z) * n1[0] + pg8::bfhi(qw.z) * n1[1] + pg8::bflo(qw.w) * n1[2] + pg8::bfhi(qw.w) * n1[3];
          d = red8(d); if (part == 0) Qn[l] = d; }
        __syncthreads();
        mm_lds2(Sb, LD, VT, LD, 64, Qs, LD, Cb, LD, 64, 64, 64, c.wave, c.lane, [&](int row, int col0, const f32x4& a1, const f32x4& a2) {
            const float iw = Iw[row]; *(LAS f32x4*)(Hn + row * 64 + col0) = a1 + a2 * iw; });
        { const u32x4 sw = *(const LAS u32x4*)(Sb + l * LD + part * 8);
          float rs = (pg8::bflo(sw.x) + pg8::bfhi(sw.x)) + (pg8::bflo(sw.y) + pg8::bfhi(sw.y)) + (pg8::bflo(sw.z) + pg8::bfhi(sw.z)) + (pg8::bflo(sw.w) + pg8::bfhi(sw.w));
          rs = red8(rs);
          if (part == 0) { const float den = rs + Iw[l] * Qn[l]; Inv[l] = rcpf_(fmaxf(fabsf(den), __expf(-Mt[l]))); } }
        __syncthreads();
        { const float dec = Sc[0];
          mm_lds_state<2>(VwT, LD, KT, LD, 4, 64, c.wave, c.lane, Cst, dec, [&](int row, int col0, const f32x4& a) { st_bf16x4(Cb + row * LD + col0, a); });
          { float acc = (c.wave == 0) ? dec * Nv[c.lane] : 0.f;
#pragma unroll
            for (int j = 0; j < 8; ++j) acc += Wg[c.wave * 8 + j] * bf2f(Ks[(c.wave * 8 + j) * LD + c.lane]);
            Np[c.wave * 64 + c.lane] = acc; }
          const float inv = Inv[l]; f32x4 h0 = *(const LAS f32x4*)(Hn + l * 64 + part * 8) * inv, h1 = *(const LAS f32x4*)(Hn + l * 64 + part * 8 + 4) * inv;
          float ss = (h0[0] * h0[0] + h0[1] * h0[1]) + (h0[2] * h0[2] + h0[3] * h0[3]) + (h1[0] * h1[0] + h1[1] * h1[1]) + (h1[2] * h1[2] + h1[3] * h1[3]);
          ss = red8(ss); const float rsn = rsqrtf(ss * (1.0f / 64.0f) + 1e-6f);
          const f32x4 g0 = *(const LAS f32x4*)(Og + l * 64 + part * 8), g1 = *(const LAS f32x4*)(Og + l * 64 + part * 8 + 4);
          const GAS float* nw = P.m_norm_w + L * 256 + h * 64 + part * 8; const f32x4 w0 = *(const GAS f32x4*)nw, w1 = *(const GAS f32x4*)(nw + 4);
          h0 = h0 * rsn * w0 * g0; h1 = h1 * rsn * w1 * g1;
          u32x4 o; o.x = pack_bf16(h0[0], h0[1]); o.y = pack_bf16(h0[2], h0[3]); o.z = pack_bf16(h1[0], h1[1]); o.w = pack_bf16(h1[2], h1[3]);
          *(GAS u32x4*)(P.mix + (size_t)t * D + h * 64 + part * 8) = o; }
        __syncthreads();
    }
}
constexpr size_t RWB_CHUNK = 8 * 16 * 64;
DI GAS float* rw_block(GAS float* ops, int b, int h, int chunk16) { return ops + ((size_t)((b * 4 + h) * (SEQ / 16) + chunk16)) * RWB_CHUNK; }

#define RLX_AGENT __ATOMIC_RELAXED, __HIP_MEMORY_SCOPE_AGENT
DI void rwkv_prep(const Ctx& c, const MixP& P, GAS float* ops, int b, int h, int sp, GAS unsigned* fl, unsigned epoch) {
    constexpr int TC2 = 32;
    LAS bf16_t* W2T = (LAS bf16_t*)c.lds;
    LAS bf16_t* A2T = W2T + 64 * 40;
    LAS bf16_t* G2T = A2T + 64 * 40;
    LAS bf16_t* LoB = G2T + 64 * 72;
    LAS float* WL = (LAS float*)(c.lds + 28160); LAS float* AL = WL + TC2 * 64; LAS float* Gl = AL + TC2 * 64;
    LAS float* MU = Gl + TC2 * 64;
    LAS float* CH = MU + 320;
    const int L = P.layer; const int tt = c.tid >> 4, part = c.tid & 15;
    for (int i = c.tid; i < 2048; i += 512) { const int r = i >> 6, j = i & 63;
        W2T[j * 40 + r] = f2bf(P.r_w2[(size_t)(L * 32 + r) * 256 + h * 64 + j]); A2T[j * 40 + r] = f2bf(P.r_a2[(size_t)(L * 32 + r) * 256 + h * 64 + j]); }
    for (int i = c.tid; i < 4096; i += 512) { const int r = i >> 6, j = i & 63; G2T[j * 72 + r] = f2bf(P.r_g2[(size_t)(L * 64 + r) * 256 + h * 64 + j]); }
    if (c.tid < 320) { const int i = c.tid; MU[i] = P.r_mu[L * 896 + ((i < 192) ? ((i >> 6) * 256 + h * 64 + (i & 63)) : (768 + i - 192))]; }
    if (c.tid < 64) { const int hj = L * 256 + h * 64 + c.tid;
        CH[c.tid] = P.r_w0[hj]; CH[64 + c.tid] = P.r_a0[hj]; CH[128 + c.tid] = P.r_k_k[hj]; CH[192 + c.tid] = P.r_k_a[hj]; CH[256 + c.tid] = P.r_r_k[hj]; }
    u32x4 lc, lp; u32x2 rc, rp, kc, kp, vc, vp;
#define RWKV_FETCH(S0) do { const int s_ = (S0) + tt; const GAS bf16_t* cur_ = P.proj + (size_t)(b * SEQ + s_) * NINP + OFF_R; const GAS bf16_t* prv_ = cur_ - NINP; const bool hp_ = s_ > 0; \
        lc = *(const GAS u32x4*)(cur_ + 768 + part * 8); lp = hp_ ? *(const GAS u32x4*)(prv_ + 768 + part * 8) : (u32x4){0u, 0u, 0u, 0u}; \
        rc = *(const GAS u32x2*)(cur_ + h * 64 + part * 4); rp = hp_ ? *(const GAS u32x2*)(prv_ + h * 64 + part * 4) : (u32x2){0u, 0u}; \
        kc = *(const GAS u32x2*)(cur_ + 256 + h * 64 + part * 4); kp = hp_ ? *(const GAS u32x2*)(prv_ + 256 + h * 64 + part * 4) : (u32x2){0u, 0u}; \
        vc = *(const GAS u32x2*)(cur_ + 512 + h * 64 + part * 4); vp = hp_ ? *(const GAS u32x2*)(prv_ + 512 + h * 64 + part * 4) : (u32x2){0u, 0u}; } while (0)
    const int sbeg = sp * (SEQ / 8), send = sbeg + SEQ / 8;
    const __amdgpu_buffer_rsrc_t rs = __builtin_amdgcn_make_buffer_rsrc((float*)ops, 0, 0x10000000, 0x00020000);
    RWKV_FETCH(sbeg);
    __syncthreads();
    for (int s0 = sbeg; s0 < send; s0 += TC2) {
        const u32x4 lc_ = lc, lp_ = lp; const u32x2 rc_ = rc, rp_ = rp, kc_ = kc, kp_ = kp, vc_ = vc, vp_ = vp;
        if (s0 + TC2 < send) RWKV_FETCH(s0 + TC2);
        { const unsigned cc[4] = {lc_.x, lc_.y, lc_.z, lc_.w}, pp[4] = {lp_.x, lp_.y, lp_.z, lp_.w}; float lo[8];
#pragma unroll
          for (int j = 0; j < 4; ++j) { const float c0 = pg8::bflo(cc[j]), c1 = pg8::bfhi(cc[j]);
              lo[2 * j] = c0 + (pg8::bflo(pp[j]) - c0) * MU[192 + part * 8 + 2 * j]; lo[2 * j + 1] = c1 + (pg8::bfhi(pp[j]) - c1) * MU[192 + part * 8 + 2 * j + 1]; }
#pragma unroll
          for (int j = 0; j < 8; ++j) { if (part < 4) lo[j] = tanhf_(lo[j]); else if (part >= 8) lo[j] = sigmoidf_(lo[j]); }
          u32x4 w; w.x = pack_bf16(lo[0], lo[1]); w.y = pack_bf16(lo[2], lo[3]); w.z = pack_bf16(lo[4], lo[5]); w.w = pack_bf16(lo[6], lo[7]);
          *(LAS u32x4*)(LoB + tt * 136 + part * 8) = w; }
        __syncthreads();
        mm_lds(LoB, 136, W2T, 40, TC2, 64, 32, c.wave, c.lane, [&](int row, int col0, const f32x4& a) { *(LAS f32x4*)(WL + row * 64 + col0) = a; });
        mm_lds(LoB + 32, 136, A2T, 40, TC2, 64, 32, c.wave, c.lane, [&](int row, int col0, const f32x4& a) { *(LAS f32x4*)(AL + row * 64 + col0) = a; });
        mm_lds(LoB + 64, 136, G2T, 72, TC2, 64, 64, c.wave, c.lane, [&](int row, int col0, const f32x4& a) { *(LAS f32x4*)(Gl + row * 64 + col0) = a; });
        __syncthreads();
        { float rv[4], kv[4], vv[4], kkr[4], av[4], wl[4], ss = 0.f;
          const float rcu[4] = {pg8::bflo(rc_.x), pg8::bfhi(rc_.x), pg8::bflo(rc_.y), pg8::bfhi(rc_.y)}, rpr[4] = {pg8::bflo(rp_.x), pg8::bfhi(rp_.x), pg8::bflo(rp_.y), pg8::bfhi(rp_.y)};
          const float kcu[4] = {pg8::bflo(kc_.x), pg8::bfhi(kc_.x), pg8::bflo(kc_.y), pg8::bfhi(kc_.y)}, kpr[4] = {pg8::bflo(kp_.x), pg8::bfhi(kp_.x), pg8::bflo(kp_.y), pg8::bfhi(kp_.y)};
          const float vcu[4] = {pg8::bflo(vc_.x), pg8::bfhi(vc_.x), pg8::bflo(vc_.y), pg8::bfhi(vc_.y)}, vpr[4] = {pg8::bflo(vp_.x), pg8::bfhi(vp_.x), pg8::bflo(vp_.y), pg8::bfhi(vp_.y)};
#pragma unroll
          for (int jj = 0; jj < 4; ++jj) { const int j = part * 4 + jj;
              rv[jj] = rcu[jj] + (rpr[jj] - rcu[jj]) * MU[j]; kv[jj] = kcu[jj] + (kpr[jj] - kcu[jj]) * MU[64 + j]; vv[jj] = vcu[jj] + (vpr[jj] - vcu[jj]) * MU[128 + j];
              kkr[jj] = kv[jj] * CH[128 + j]; ss += kkr[jj] * kkr[jj];
              av[jj] = sigmoidf_(CH[64 + j] + AL[tt * 64 + j]); wl[jj] = CH[j] + WL[tt * 64 + j]; }
          ss = red16(ss); const float inv = rsqrtf(fmaxf(ss, 1e-24f));
          f32x4 ld4;
#pragma unroll
          for (int jj = 0; jj < 4; ++jj) ld4[jj] = -0.60653065971f * sigmoidf_(wl[jj]);
          LAS float* DL = (LAS float*)LoB;
          *(LAS f32x4*)(DL + tt * 64 + part * 4) = ld4;
          __syncthreads();
          f32x4 cs = {0.f, 0.f, 0.f, 0.f};
          for (int t = (tt & ~15); t < tt; ++t) cs += *(const LAS f32x4*)(DL + t * 64 + part * 4);
          f32x4 o_d, o_kx, o_kk, o_kb; float bsum = 0.f;
#pragma unroll
          for (int jj = 0; jj < 4; ++jj) { const int j = part * 4 + jj;
              const float dprev = __expf(cs[jj]), dcur = dprev * __expf(ld4[jj]), dinv = rcpf_(dcur);
              const float kk = kkr[jj] * inv; const float kx = kv[jj] * (1.0f + (av[jj] - 1.0f) * CH[192 + j]);
              o_d[jj] = dcur; o_kx[jj] = kx * dinv; o_kk[jj] = kk * dprev; o_kb[jj] = kk * av[jj] * dinv;
              bsum += rv[jj] * kx * CH[256 + j]; rv[jj] *= dcur; }
          bsum = red16(bsum);
          const size_t blk0 = ((size_t)((b * 4 + h) * (SEQ / 16) + (s0 >> 4) + (tt >> 4))) * RWB_CHUNK;
          const unsigned off = (unsigned)((blk0 + (tt & 15) * 64 + part * 4) * 4);
#define RW_ST16(O, V) __builtin_amdgcn_raw_buffer_store_b128(__builtin_bit_cast(u32x4, V), rs, off + (O) * 4, 0, 16)
          const f32x4 o_r = {rv[0], rv[1], rv[2], rv[3]}, o_v = {vv[0], vv[1], vv[2], vv[3]}, o_g = *(const LAS f32x4*)(Gl + tt * 64 + part * 4);
          RW_ST16(0, o_r); RW_ST16(1024, o_d); RW_ST16(2048, o_kx); RW_ST16(3072, o_kk); RW_ST16(4096, o_kb); RW_ST16(5120, o_v); RW_ST16(6144, o_g);
#undef RW_ST16
          if (part == 0) __hip_atomic_store((GAS unsigned*)(ops + blk0 + 7168 + (tt & 15)), __builtin_bit_cast(unsigned, bsum), RLX_AGENT); }
        if (sp == 0) asm volatile("s_waitcnt vmcnt(0)" ::: "memory");
        __syncthreads();
        if (sp == 0 && c.tid == 0) __hip_atomic_store(fl + ((s0 - sbeg) >> 5), epoch, RLX_AGENT);
    }
    if (sp != 0) { asm volatile("s_waitcnt vmcnt(0)" ::: "memory"); __syncthreads(); if (c.tid == 0) __hip_atomic_store(fl + 7 + sp, epoch, RLX_AGENT); }
#undef RWKV_FETCH
}

DI float red8o(float v) { v += dppf<0xB1>(v); asm("" : "+v"(v)); v += dppf<0x4E>(v); asm("" : "+v"(v)); v += dppf<0x141>(v); asm("" : "+v"(v)); return v; }
DI void mix_rwkv_v5(const Ctx& c, const MixP& P, const GAS float* ops, int b, int h, const GAS unsigned* fl, unsigned epoch) {
    constexpr int CT = 16, NCH = SEQ / CT, BUFB = 8 * CT * 64 * 4 + 64;
    LAS float* CH = (LAS float*)c.lds;
    const int L = P.layer;
    if (c.tid < 64) { const int hj = L * 256 + h * 64 + c.tid; CH[c.tid] = P.r_ln_w[hj]; CH[64 + c.tid] = P.r_ln_b[hj]; }
#define RW_BUF(i) ((LAS float*)(c.lds + 512 + ((i) % 3) * BUFB))
    if (c.wave < 4) {
        const int ks = c.lane & 7, srow = c.wave * 16 + 2 * (c.lane >> 3);
        f32x2 Sa[4], Sb[4];
#pragma unroll
        for (int i = 0; i < 4; ++i) { Sa[i] = (f32x2){0.f, 0.f}; Sb[i] = (f32x2){0.f, 0.f}; }
        __syncthreads();
        __builtin_amdgcn_s_setprio(3);
#define RW_LOAD(Q, X) do { const int o_ = (X) * 64 + ks * 8; Q.k0 = *(const LAS f32x4*)(Kk + o_); Q.k1 = *(const LAS f32x4*)(Kk + o_ + 4); Q.v = *(const LAS f32x2*)(Vv + (X) * 64 + srow); \
            _Pragma("unroll") for (int i_ = 0; i_ < 2; ++i_) { Q.x[i_] = *(const LAS f32x4*)(Kx + o_ + 4 * i_); Q.b[i_] = *(const LAS f32x4*)(Kb + o_ + 4 * i_); Q.r[i_] = *(const LAS f32x4*)(Rr + o_ + 4 * i_); } } while (0)
#define RW_DOT(SS, Q, OUT) do { f32x2 p_ = SS[0] * (f32x2){Q.k0[0], Q.k0[1]}; p_ = SS[1] * (f32x2){Q.k0[2], Q.k0[3]} + p_; p_ = SS[2] * (f32x2){Q.k1[0], Q.k1[1]} + p_; p_ = SS[3] * (f32x2){Q.k1[2], Q.k1[3]} + p_; OUT = p_[0] + p_[1]; } while (0)
#define RW_OPQ(V) asm("" : "+v"(V))
#define RW_RS(V, C) do { V += dppf<C>(V); RW_OPQ(V); } while (0)
#define RW_RED4(A, B, C, D) do { RW_RS(A, 0xB1); RW_RS(B, 0xB1); RW_RS(C, 0xB1); RW_RS(D, 0xB1); RW_RS(A, 0x4E); RW_RS(B, 0x4E); RW_RS(C, 0x4E); RW_RS(D, 0x4E); \
            RW_RS(A, 0x141); RW_RS(B, 0x141); RW_RS(C, 0x141); RW_RS(D, 0x141); } while (0)
#define RW_RED2(A, B) do { RW_RS(A, 0xB1); RW_RS(B, 0xB1); RW_RS(A, 0x4E); RW_RS(B, 0x4E); RW_RS(A, 0x141); RW_RS(B, 0x141); } while (0)
#define RW_UPD(SS, VR, SA, Q, YP) do { const f32x2 vr2_ = {VR, VR}, sa2_ = {SA, SA}; f32x2 y_ = {0.f, 0.f}; \
            _Pragma("unroll") for (int i_ = 0; i_ < 2; ++i_) { \
                { const f32x2 t0_ = vr2_ * (f32x2){Q.x[i_][0], Q.x[i_][1]} + SS[2 * i_], t1_ = vr2_ * (f32x2){Q.x[i_][2], Q.x[i_][3]} + SS[2 * i_ + 1];     \
                  SS[2 * i_] = t0_ - sa2_ * (f32x2){Q.b[i_][0], Q.b[i_][1]}; SS[2 * i_ + 1] = t1_ - sa2_ * (f32x2){Q.b[i_][2], Q.b[i_][3]}; } \
                y_ = SS[2 * i_] * (f32x2){Q.r[i_][0], Q.r[i_][1]} + y_; y_ = SS[2 * i_ + 1] * (f32x2){Q.r[i_][2], Q.r[i_][3]} + y_; } \
            YP = y_[0] + y_[1]; } while (0)
#define RW_STEP(Q, X) do { float sa_, sb_; RW_DOT(Sa, Q, sa_); RW_DOT(Sb, Q, sb_); \
            if ((X) > 0) { RW_RED4(sa_, sb_, ypa, ypb); if (ks == 0) *(LAS f32x2*)(Yb + ((X) - 1) * 64 + srow) = (f32x2){ypa, ypb}; } else { RW_RED2(sa_, sb_); } \
            RW_UPD(Sa, Q.v[0], sa_, Q, ypa); RW_UPD(Sb, Q.v[1], sb_, Q, ypb); } while (0)
#define RW_FLUSH() do { RW_RED2(ypa, ypb); if (ks == 0) *(LAS f32x2*)(Yb + (CT - 1) * 64 + srow) = (f32x2){ypa, ypb}; \
            { const f32x4 e0_ = *(const LAS f32x4*)(Dd + (CT - 1) * 64 + ks * 8), e1_ = *(const LAS f32x4*)(Dd + (CT - 1) * 64 + ks * 8 + 4);     \
              Sa[0] *= (f32x2){e0_[0], e0_[1]}; Sa[1] *= (f32x2){e0_[2], e0_[3]}; Sa[2] *= (f32x2){e1_[0], e1_[1]}; Sa[3] *= (f32x2){e1_[2], e1_[3]}; \
              Sb[0] *= (f32x2){e0_[0], e0_[1]}; Sb[1] *= (f32x2){e0_[2], e0_[3]}; Sb[2] *= (f32x2){e1_[0], e1_[1]}; Sb[3] *= (f32x2){e1_[2], e1_[3]}; } } while (0)
#define RW_PAIR(X) do { RW_LOAD(B, (X) + 1); RW_STEP(A, X); if ((X) + 2 < CT) RW_LOAD(A, (X) + 2); RW_STEP(B, (X) + 1); } while (0)
        struct OpsK { f32x4 k0, k1, x[2], b[2], r[2]; f32x2 v; }; OpsK A, B; float ypa = 0.f, ypb = 0.f;
#pragma unroll 1
        for (int ci = 0; ci < NCH; ++ci) {
            LAS float* Rr = RW_BUF(ci); LAS float* Dd = Rr + CT * 64; LAS float* Kx = Dd + CT * 64; LAS float* Kk = Kx + CT * 64; LAS float* Kb = Kk + CT * 64; LAS float* Vv = Kb + CT * 64;
            LAS float* Yb = Vv + 2 * CT * 64;
            RW_LOAD(A, 0);
            RW_PAIR(0); RW_PAIR(2); RW_PAIR(4); RW_PAIR(6);
            RW_PAIR(8); RW_PAIR(10); RW_PAIR(12); RW_PAIR(14); RW_FLUSH();
            __syncthreads();
        }
        __builtin_amdgcn_s_setprio(0);
        __syncthreads();
#undef RW_LOAD
#undef RW_DOT
#undef RW_RED4
#undef RW_RED2
#undef RW_RS
#undef RW_OPQ
#undef RW_UPD
#undef RW_FLUSH
#undef RW_STEP
#undef RW_PAIR
    } else {
        const int pt = c.tid - 256, tt = pt >> 4, part = pt & 15;
        u32x4 g0[7], g1[7]; float gbo0 = 0.f, gbo1 = 0.f;
#define RW_PVLOAD() do { pv = (c.lane < 15) ? __hip_atomic_load((GAS unsigned*)fl + c.lane, RLX_AGENT) : epoch; } while (0)
#define RW_WAIT(CI) do { if ((CI) >= ready) { for (;;) { const unsigned long long m_ = __ballot(pv == epoch); int np_ = (~m_ != 0ull) ? __builtin_ctzll(~m_) : 15; np_ = np_ > 15 ? 15 : np_; \
              ready = __builtin_amdgcn_readfirstlane(np_ <= 8 ? 2 * np_ : 16 * (np_ - 7)); if ((CI) < ready) break; __builtin_amdgcn_s_sleep(1); RW_PVLOAD(); } \
              __builtin_amdgcn_fence(__ATOMIC_ACQUIRE, "agent"); } } while (0)
#define RW_FETCH(G, GBO, CI) do { RW_WAIT(CI); const GAS float* blk_ = rw_block((GAS float*)ops, b, h, (CI)); _Pragma("unroll") for (int i_ = 0; i_ < 7; ++i_) G[i_] = *(const GAS u32x4*)(blk_ + i_ * 1024 + pt * 4); if (pt < 16) GBO = blk_[7168 + pt]; } while (0)
#define RW_STASH(G, GBO, BUF) do { _Pragma("unroll") for (int i_ = 0; i_ < 7; ++i_) *(LAS u32x4*)((BUF) + i_ * 1024 + pt * 4) = G[i_]; if (pt < 16) (BUF)[8 * CT * 64 + pt] = GBO; } while (0)
#define RW_POST(BUF, CI) do { LAS float* Vv = (BUF) + 5 * CT * 64; LAS float* Gg = Vv + CT * 64; LAS float* Yb = Gg + CT * 64; LAS float* Bo = (BUF) + 8 * CT * 64; \
          float yv[4], sm = 0.f; \
          _Pragma("unroll") for (int jj = 0; jj < 4; ++jj) { yv[jj] = Yb[tt * 64 + part * 4 + jj]; sm += yv[jj]; } \
          const float mean = red16(sm) * (1.0f / 64.0f); float q = 0.f; \
          _Pragma("unroll") for (int jj = 0; jj < 4; ++jj) { yv[jj] -= mean; q += yv[jj] * yv[jj]; } \
          const float rs = rsqrtf(red16(q) * (1.0f / 64.0f) + 64e-5f); const float bo = Bo[tt]; float o[4]; \
          _Pragma("unroll") for (int jj = 0; jj < 4; ++jj) { const int j = part * 4 + jj; \
              const float yn = yv[jj] * rs * CH[j] + CH[64 + j]; o[jj] = (yn + bo * Vv[tt * 64 + j]) * Gg[tt * 64 + j]; } \
          u32x2 w; w.x = pack_bf16(o[0], o[1]); w.y = pack_bf16(o[2], o[3]); \
          *(GAS u32x2*)(P.mix + (size_t)(b * SEQ + (CI) * CT + tt) * D + 512 + h * 64 + part * 4) = w; } while (0)
        unsigned pv; int ready = 0;
        RW_PVLOAD(); RW_FETCH(g0, gbo0, 0); RW_STASH(g0, gbo0, RW_BUF(0)); RW_FETCH(g1, gbo1, 1);
        __syncthreads();
        RW_PVLOAD(); RW_FETCH(g0, gbo0, 2);
#pragma unroll 1
        for (int ci = 0; ci < NCH; ci += 2) {
            if (ci + 3 < NCH && ci + 3 >= ready) RW_PVLOAD();
            if (ci > 0) RW_POST(RW_BUF(ci - 1), ci - 1);
            RW_STASH(g1, gbo1, RW_BUF(ci + 1)); if (ci + 3 < NCH) RW_FETCH(g1, gbo1, ci + 3);
            __syncthreads();
            if (ci + 4 < NCH && ci + 4 >= ready) RW_PVLOAD();
            RW_POST(RW_BUF(ci), ci);
            if (ci + 2 < NCH) { RW_STASH(g0, gbo0, RW_BUF(ci + 2)); if (ci + 4 < NCH) RW_FETCH(g0, gbo0, ci + 4); }
            __syncthreads();
        }
        RW_POST(RW_BUF(NCH - 1), NCH - 1);
        __syncthreads();
#undef RW_FETCH
#undef RW_WAIT
#undef RW_PVLOAD
#undef RW_STASH
#undef RW_POST
    }
#undef RW_BUF
}
DI void mix_ssd_v3(const Ctx& c, const MixP& P, int b, int g) {
    constexpr int LD = 72, RL = 264;
    LAS bf16_t* Cm = (LAS bf16_t*)c.lds; LAS bf16_t* Bm = Cm + 64 * LD; LAS bf16_t* BmT = Bm + 64 * LD;
    LAS bf16_t* XT = BmT + 64 * LD;
    LAS bf16_t* Stb = XT + 128 * LD;
    LAS float* Yz = (LAS float*)(c.lds + 64512);
    LAS bf16_t* Wm = (LAS bf16_t*)(c.lds + 97280); LAS bf16_t* XdT = Wm + 64 * LD;
    LAS bf16_t* Wm1 = XdT + 64 * LD; LAS bf16_t* XdT1 = Wm1 + 64 * LD;
    LAS bf16_t* RAW = (LAS bf16_t*)(c.lds + 64512);
    LAS float* Dt = (LAS float*)(c.lds + 134144); LAS float* Ac = Dt + 128;
    LAS float* CW = Ac + 128;
    const int L = P.layer; const int l = c.tid >> 3, part = c.tid & 7;
    f32x4 St0[2] = {{0.f, 0.f, 0.f, 0.f}, {0.f, 0.f, 0.f, 0.f}}, St1[2] = {{0.f, 0.f, 0.f, 0.f}, {0.f, 0.f, 0.f, 0.f}};
    for (int i = c.tid; i < 128 * LD; i += 512) Stb[i] = 0;
    for (int i = c.tid; i < 1280; i += 512) { const int k = i >> 8, ch = i & 255;
        const int xi = (ch < 128) ? (g * 128 + ch) : ((ch < 192) ? (256 + g * 64 + (ch - 128)) : (384 + g * 64 + (ch - 192)));
        CW[i] = (k < 4) ? P.s_conv_w[(L * 4 + k) * 512 + xi] : P.s_conv_b[L * 512 + xi]; }
    const float dsk0 = P.s_d[L * 4 + 2 * g], dsk1 = P.s_d[L * 4 + 2 * g + 1];
    const float dtb = (part < 2) ? P.s_dt_bias[L * 4 + 2 * g + part] : 0.f, aneg = (part < 2) ? -__expf(P.s_a_log[L * 4 + 2 * g + part]) : 0.f;
    u32x4 rx[3], rbm[2], rcm[2]; float dtr = 0.f;
#define SSD_FETCH(S0) do { \
        _Pragma("unroll") for (int i_ = 0; i_ < 3; ++i_) { const int p_ = c.tid + 512 * i_; if (p_ < 1072) { const int r_ = p_ >> 4, c8_ = p_ & 15, s_ = (S0) - 3 + r_; \
            rx[i_] = (s_ >= 0) ? *(const GAS u32x4*)(P.proj + (size_t)(b * SEQ + s_) * NINP + OFF_S + 256 + g * 128 + c8_ * 8) : (u32x4){0u, 0u, 0u, 0u}; } } \
        _Pragma("unroll") for (int i_ = 0; i_ < 2; ++i_) { const int p_ = c.tid + 512 * i_; if (p_ < 536) { const int r_ = p_ >> 3, c8_ = p_ & 7, s_ = (S0) - 3 + r_; \
            const GAS bf16_t* q_ = P.proj + (size_t)(b * SEQ + (s_ >= 0 ? s_ : 0)) * NINP + OFF_S + 512 + g * 64 + c8_ * 8; \
            rbm[i_] = (s_ >= 0) ? *(const GAS u32x4*)q_ : (u32x4){0u, 0u, 0u, 0u}; rcm[i_] = (s_ >= 0) ? *(const GAS u32x4*)(q_ + 128) : (u32x4){0u, 0u, 0u, 0u}; } } \
        if (part < 2) dtr = ldp(P.proj, b * SEQ + (S0) + l, OFF_S + 768 + 2 * g + part); } while (0)
#define SSD_STASH() do { \
        _Pragma("unroll") for (int i_ = 0; i_ < 3; ++i_) { const int p_ = c.tid + 512 * i_; if (p_ < 1072) *(LAS u32x4*)(RAW + (p_ >> 4) * RL + (p_ & 15) * 8) = rx[i_]; } \
        _Pragma("unroll") for (int i_ = 0; i_ < 2; ++i_) { const int p_ = c.tid + 512 * i_; if (p_ < 536) { *(LAS u32x4*)(RAW + (p_ >> 3) * RL + 128 + (p_ & 7) * 8) = rbm[i_]; *(LAS u32x4*)(RAW + (p_ >> 3) * RL + 192 + (p_ & 7) * 8) = rcm[i_]; } } } while (0)
    SSD_FETCH(0);
    __syncthreads();
    for (int s0 = 0; s0 < SEQ; s0 += 64) {
        const int t = b * SEQ + s0 + l;
        SSD_STASH();
        if (part < 2) { const float dt = softplusf_(dtr + dtb); Dt[l * 2 + part] = dt; Ac[l * 2 + part] = aneg * dt; }
        __syncthreads();
        if (s0 + 64 < SEQ) SSD_FETCH(s0 + 64);
#pragma unroll
        for (int gq = 0; gq < 4; ++gq) { const int ch0 = part * 32 + gq * 8; float acc[8];
#pragma unroll
            for (int j = 0; j < 8; ++j) acc[j] = CW[1024 + ch0 + j];
#pragma unroll
            for (int k = 0; k < 4; ++k) { const u32x4 rw = *(const LAS u32x4*)(RAW + (l + k) * RL + ch0); const f32x4 w0 = *(const LAS f32x4*)(CW + k * 256 + ch0), w1 = *(const LAS f32x4*)(CW + k * 256 + ch0 + 4);
                acc[0] += w0[0] * pg8::bflo(rw.x); acc[1] += w0[1] * pg8::bfhi(rw.x); acc[2] += w0[2] * pg8::bflo(rw.y); acc[3] += w0[3] * pg8::bfhi(rw.y);
                acc[4] += w1[0] * pg8::bflo(rw.z); acc[5] += w1[1] * pg8::bfhi(rw.z); acc[6] += w1[2] * pg8::bflo(rw.w); acc[7] += w1[3] * pg8::bfhi(rw.w); }
            bf16_t v[8];
#pragma unroll
            for (int j = 0; j < 8; ++j) v[j] = f2bf(siluf_(acc[j]));
            if (ch0 < 128) {
#pragma unroll
                for (int j = 0; j < 8; ++j) XT[(ch0 + j) * LD + l] = v[j];
            } else { u32x4 w; w.x = (unsigned)v[0] | ((unsigned)v[1] << 16); w.y = (unsigned)v[2] | ((unsigned)v[3] << 16); w.z = (unsigned)v[4] | ((unsigned)v[5] << 16); w.w = (unsigned)v[6] | ((unsigned)v[7] << 16);
                if (ch0 < 192) { *(LAS u32x4*)(Bm + l * LD + ch0 - 128) = w;
#pragma unroll
                    for (int j = 0; j < 8; ++j) BmT[(ch0 - 128 + j) * LD + l] = v[j]; }
                else *(LAS u32x4*)(Cm + l * LD + ch0 - 192) = w; } }
        if (c.wave < 2) { const float v = wave_scan_add(Ac[c.lane * 2 + c.wave], c.lane); Ac[c.lane * 2 + c.wave] = v; }
        __syncthreads();
        { const float alast0 = Ac[63 * 2], alast1 = Ac[63 * 2 + 1];
          mm_lds(Cm, LD, Bm, LD, 64, 64, 64, c.wave, c.lane, [&](int row, int col0, const f32x4& a) {
              const float al0 = Ac[row * 2], al1 = Ac[row * 2 + 1]; f32x4 o0, o1;
#pragma unroll
              for (int j = 0; j < 4; ++j) { const int sidx = col0 + j; const bool in = sidx <= row;
                  o0[j] = in ? a[j] * __expf(al0 - Ac[sidx * 2]) * Dt[sidx * 2] : 0.f; o1[j] = in ? a[j] * __expf(al1 - Ac[sidx * 2 + 1]) * Dt[sidx * 2 + 1] : 0.f; }
              st_bf16x4(Wm + row * LD + col0, o0); st_bf16x4(Wm1 + row * LD + col0, o1); });
#pragma unroll
          for (int w = 0; w < 2; ++w) { const float alast = w ? alast1 : alast0;
              const u32x4 xt = *(const LAS u32x4*)(XT + (w * 64 + l) * LD + part * 8); float f[8];
#pragma unroll
              for (int j = 0; j < 8; ++j) { const int sidx = part * 8 + j; f[j] = Dt[sidx * 2 + w] * __expf(alast - Ac[sidx * 2 + w]); }
              u32x4 o; o.x = pack_bf16(pg8::bflo(xt.x) * f[0], pg8::bfhi(xt.x) * f[1]); o.y = pack_bf16(pg8::bflo(xt.y) * f[2], pg8::bfhi(xt.y) * f[3]);
              o.z = pack_bf16(pg8::bflo(xt.z) * f[4], pg8::bfhi(xt.z) * f[5]); o.w = pack_bf16(pg8::bflo(xt.w) * f[6], pg8::bfhi(xt.w) * f[7]);
              *(LAS u32x4*)((w ? XdT1 : XdT) + l * LD + part * 8) = o; }
          __syncthreads();
#pragma unroll
          for (int w = 0; w < 2; ++w) { const float dsk = w ? dsk1 : dsk0;
              mm_lds2(w ? Wm1 : Wm, LD, XT + w * 64 * LD, LD, 64, Cm, LD, Stb + w * 64 * LD, LD, 64, 64, 64, c.wave, c.lane, [&](int row, int col0, const f32x4& a1, const f32x4& a2) {
                const float e = __expf(Ac[row * 2 + w]); f32x4 o;
#pragma unroll
                for (int j = 0; j < 4; ++j) o[j] = a1[j] + e * a2[j] + dsk * bf2f(XT[(w * 64 + col0 + j) * LD + row]);
                *(LAS f32x4*)(Yz + row * 128 + w * 64 + col0) = o; }); }
          __syncthreads();
          mm_lds_state<2>(XdT, LD, BmT, LD, 4, 64, c.wave, c.lane, St0, __expf(alast0), [&](int row, int col0, const f32x4& a) { st_bf16x4(Stb + row * LD + col0, a); });
          mm_lds_state<2>(XdT1, LD, BmT, LD, 4, 64, c.wave, c.lane, St1, __expf(alast1), [&](int row, int col0, const f32x4& a) { st_bf16x4(Stb + (64 + row) * LD + col0, a); });
        }
        { const GAS bf16_t* zp = P.proj + (size_t)t * NINP + OFF_S + g * 128 + part * 16; const u32x4 z0 = *(const GAS u32x4*)zp, z1 = *(const GAS u32x4*)(zp + 8);
          const unsigned zz[8] = {z0.x, z0.y, z0.z, z0.w, z1.x, z1.y, z1.z, z1.w};
          float yz[16], ss = 0.f;
#pragma unroll
          for (int j = 0; j < 8; ++j) { const float a = Yz[l * 128 + part * 16 + 2 * j] * siluf_(pg8::bflo(zz[j])), bq = Yz[l * 128 + part * 16 + 2 * j + 1] * siluf_(pg8::bfhi(zz[j]));
              yz[2 * j] = a; yz[2 * j + 1] = bq; ss += a * a + bq * bq; }
          ss = red8(ss); const float rs = rsqrtf(ss * (1.0f / 128.0f) + 1e-6f);
          const GAS float* nw = P.s_norm_w + L * 256 + g * 128 + part * 16;
          unsigned ow[8];
#pragma unroll
          for (int j = 0; j < 8; ++j) ow[j] = pack_bf16(yz[2 * j] * rs * nw[2 * j], yz[2 * j + 1] * rs * nw[2 * j + 1]);
          u32x4 o0, o1; o0.x = ow[0]; o0.y = ow[1]; o0.z = ow[2]; o0.w = ow[3]; o1.x = ow[4]; o1.y = ow[5]; o1.z = ow[6]; o1.w = ow[7];
          GAS bf16_t* mp = P.mix + (size_t)t * D + 768 + g * 128 + part * 16; *(GAS u32x4*)mp = o0; *(GAS u32x4*)(mp + 8) = o1; }
        __syncthreads();
    }
}

DI void mix_rglru_v2(const Ctx& c, const MixP& P, int b, int h) {
    constexpr int LD = 72, RL = 136;
    LAS bf16_t* WaT = (LAS bf16_t*)c.lds; LAS bf16_t* WxT = WaT + 64 * LD; LAS bf16_t* XCb = WxT + 64 * LD;
    LAS bf16_t* RAW = XCb + 64 * LD;
    LAS float* XCf = (LAS float*)(c.lds + 45888); LAS float* Av = XCf + 4096; LAS float* Uv = Av + 4096; LAS float* Gt = Uv + 4096;
    LAS float* CH = Gt + 4096;
    const int L = P.layer; const int l = c.tid >> 3, part = c.tid & 7;
    for (int i = c.tid; i < 4096; i += 512) { const int r = i >> 6, j = i & 63;
        WaT[j * LD + r] = f2bf(P.g_w_a[(size_t)(L * 4 + h) * 4096 + i]); WxT[j * LD + r] = f2bf(P.g_w_x[(size_t)(L * 4 + h) * 4096 + i]); }
    if (c.tid < 64) { const int hj = L * 256 + h * 64 + c.tid;
#pragma unroll
        for (int k = 0; k < 4; ++k) CH[k * 64 + c.tid] = P.g_conv_w[(L * 4 + k) * 256 + h * 64 + c.tid];
        CH[256 + c.tid] = P.g_conv_b[hj]; CH[320 + c.tid] = P.g_b_a[hj]; CH[384 + c.tid] = P.g_b_x[hj]; CH[448 + c.tid] = softplusf_(-P.g_lambda[hj]); }
    float hst = 0.f;
    u32x4 rxb[2], rgt[2];
#define RG_FETCH(S0) do { _Pragma("unroll") for (int i_ = 0; i_ < 2; ++i_) { const int p_ = c.tid + 512 * i_; if (p_ < 536) { const int r_ = p_ >> 3, c8_ = p_ & 7, s_ = (S0) - 3 + r_; \
            const GAS bf16_t* q_ = P.proj + (size_t)(b * SEQ + (s_ >= 0 ? s_ : 0)) * NINP + OFF_G + h * 64 + c8_ * 8; \
            rxb[i_] = (s_ >= 0) ? *(const GAS u32x4*)q_ : (u32x4){0u, 0u, 0u, 0u}; rgt[i_] = (s_ >= 0) ? *(const GAS u32x4*)(q_ + 256) : (u32x4){0u, 0u, 0u, 0u}; } } } while (0)
#define RG_STASH() do { _Pragma("unroll") for (int i_ = 0; i_ < 2; ++i_) { const int p_ = c.tid + 512 * i_; if (p_ < 536) { \
            *(LAS u32x4*)(RAW + (p_ >> 3) * RL + (p_ & 7) * 8) = rxb[i_]; *(LAS u32x4*)(RAW + (p_ >> 3) * RL + 64 + (p_ & 7) * 8) = rgt[i_]; } } } while (0)
    RG_FETCH(0);
    __syncthreads();
    for (int s0 = 0; s0 < SEQ; s0 += 64) {
        const int t = b * SEQ + s0 + l;
        RG_STASH();
        __syncthreads();
        if (s0 + 64 < SEQ) RG_FETCH(s0 + 64);
        { const int ch0 = part * 8; float acc[8];
#pragma unroll
          for (int j = 0; j < 8; ++j) acc[j] = CH[256 + ch0 + j];
#pragma unroll
          for (int k = 0; k < 4; ++k) { const u32x4 rw = *(const LAS u32x4*)(RAW + (l + k) * RL + ch0); const f32x4 w0 = *(const LAS f32x4*)(CH + k * 64 + ch0), w1 = *(const LAS f32x4*)(CH + k * 64 + ch0 + 4);
              acc[0] += w0[0] * pg8::bflo(rw.x); acc[1] += w0[1] * pg8::bfhi(rw.x); acc[2] += w0[2] * pg8::bflo(rw.y); acc[3] += w0[3] * pg8::bfhi(rw.y);
              acc[4] += w1[0] * pg8::bflo(rw.z); acc[5] += w1[1] * pg8::bfhi(rw.z); acc[6] += w1[2] * pg8::bflo(rw.w); acc[7] += w1[3] * pg8::bfhi(rw.w); }
          u32x4 w; w.x = pack_bf16(acc[0], acc[1]); w.y = pack_bf16(acc[2], acc[3]); w.z = pack_bf16(acc[4], acc[5]); w.w = pack_bf16(acc[6], acc[7]);
          *(LAS u32x4*)(XCb + l * LD + ch0) = w;
          *(LAS f32x4*)(XCf + l * 64 + ch0) = (f32x4){acc[0], acc[1], acc[2], acc[3]}; *(LAS f32x4*)(XCf + l * 64 + ch0 + 4) = (f32x4){acc[4], acc[5], acc[6], acc[7]};
          const u32x4 gw = *(const LAS u32x4*)(RAW + (l + 3) * RL + 64 + ch0);
          *(LAS f32x4*)(Gt + l * 64 + ch0) = (f32x4){gelu_tanhf_(pg8::bflo(gw.x)), gelu_tanhf_(pg8::bfhi(gw.x)), gelu_tanhf_(pg8::bflo(gw.y)), gelu_tanhf_(pg8::bfhi(gw.y))};
          *(LAS f32x4*)(Gt + l * 64 + ch0 + 4) = (f32x4){gelu_tanhf_(pg8::bflo(gw.z)), gelu_tanhf_(pg8::bfhi(gw.z)), gelu_tanhf_(pg8::bflo(gw.w)), gelu_tanhf_(pg8::bfhi(gw.w))}; }
        __syncthreads();
        mm_lds2(XCb, LD, WaT, LD, 64, XCb, LD, WxT, LD, 64, 64, 64, c.wave, c.lane, [&](int row, int col0, const f32x4& a1, const f32x4& a2) {
            const f32x4 xc = *(const LAS f32x4*)(XCf + row * 64 + col0); f32x4 av, uv;
#pragma unroll
            for (int j = 0; j < 4; ++j) { const int ch = col0 + j; const float r = sigmoidf_(a1[j] + CH[320 + ch]), ig = sigmoidf_(a2[j] + CH[384 + ch]);
                const float la = -8.0f * CH[448 + ch] * r; av[j] = __expf(la); uv[j] = sqrtf(fmaxf(1.0f - __expf(2.0f * la), 0.f)) * (ig * xc[j]); }
            *(LAS f32x4*)(Av + row * 64 + col0) = av; *(LAS f32x4*)(Uv + row * 64 + col0) = uv; });
        __syncthreads();
        if (c.wave == 0) {
#pragma unroll 1
            for (int x0 = 0; x0 < 64; x0 += 8) { float a[8], u[8];
#pragma unroll
                for (int j = 0; j < 8; ++j) { a[j] = Av[(x0 + j) * 64 + c.lane]; u[j] = Uv[(x0 + j) * 64 + c.lane]; }
#pragma unroll
                for (int j = 0; j < 8; ++j) { hst = a[j] * hst + u[j]; Uv[(x0 + j) * 64 + c.lane] = hst; } }
        }
        __syncthreads();
        { const f32x4 h0 = *(const LAS f32x4*)(Uv + l * 64 + part * 8) * *(const LAS f32x4*)(Gt + l * 64 + part * 8), h1 = *(const LAS f32x4*)(Uv + l * 64 + part * 8 + 4) * *(const LAS f32x4*)(Gt + l * 64 + part * 8 + 4);
          u32x4 o; o.x = pack_bf16(h0[0], h0[1]); o.y = pack_bf16(h0[2], h0[3]); o.z = pack_bf16(h1[0], h1[1]); o.w = pack_bf16(h1[2], h1[3]);
          *(GAS u32x4*)(P.mix + (size_t)t * D + 256 + h * 64 + part * 8) = o; }
        __syncthreads();
    }
}
constexpr size_t al256(size_t x) { return (x + 255) & ~(size_t)255; }
constexpr size_t WS_CTL = 0;
constexpr size_t CTL_BYTES = 65536;
constexpr int CW_BAR = 0;
constexpr int CW_CNT = 4096;
constexpr int CW_CUR = 4096 + 128;
constexpr int CW_Q = 4096 + 256;
constexpr int CW_RDY = 8192;
constexpr size_t SZ_WIN = (size_t)NINP * D * 2, SZ_WOUT = (size_t)D * D * 2, SZ_WPE = (size_t)D * PE_DIM * 2, SZ_WG = (size_t)D * D * 2;
constexpr size_t SZ_W13 = (size_t)NH2 * D * 2, SZ_W2 = (size_t)D * DFF * 2;
constexpr size_t WS_WIN = WS_CTL + CTL_BYTES, WS_WOUT = WS_WIN + SZ_WIN, WS_WPE = WS_WOUT + SZ_WOUT, WS_WG = WS_WPE + SZ_WPE, WS_W13 = WS_WG + SZ_WG, WS_W2 = WS_W13 + NE * SZ_W13;
constexpr size_t WS_XB = WS_W2 + NE * SZ_W2;
constexpr size_t WS_PB = WS_XB + (size_t)T * D * 2;
constexpr size_t WS_PE = WS_PB + (size_t)T * PE_DIM * 2;
constexpr size_t WS_H = WS_PE + (size_t)T * D * 2;
constexpr size_t SZ_PROJ = (size_t)T * NINP * 2, SZ_HMOE = (size_t)MOE_ROWS * DFF * 2;
constexpr size_t WS_MIX = WS_H + SZ_PROJ;
constexpr size_t WS_XG = WS_H + SZ_HMOE;
constexpr size_t WS_ROUTE = WS_XG + (size_t)MOE_ROWS * D * 2;
constexpr size_t WS_RWOPS = WS_XG;
constexpr size_t WS_PRE1 = WS_H;
constexpr size_t WS_PRE2 = WS_XG;
constexpr size_t WS_XB8 = WS_XG + (size_t)T * D * 2;
constexpr size_t WS_NEED = WS_RWOPS + (size_t)T * 4 * 8 * 64 * 4;
constexpr size_t WS_END = WS_ROUTE + (size_t)T * 32;
static_assert(SZ_PROJ + (size_t)T * D * 2 <= SZ_HMOE, "proj + mix inside the hidden region");
constexpr int LDS_BYTES = 147456;
constexpr int LDS_MISC = 146432;

#ifndef PHMASK
#define PHMASK 0x1FF
#endif
#define PHEN(k) ((PHMASK >> (k)) & 1)

#ifndef PHMASK
#define PHMASK 0x1FF
#endif
#define PHEN(k) ((PHMASK >> (k)) & 1)
struct Args { const float* in[45]; float* out; unsigned char* ws; int ph_lo, ph_hi; };
constexpr int NPH = 9;
constexpr int LDS_ARGS = LDS_MISC + 64;
#ifndef MOE_FP8
#define MOE_FP8 1
#endif
#ifndef DENSE_FP8
#define DENSE_FP8 0
#endif
#ifndef DENSE_FP8_DOWN
#define DENSE_FP8_DOWN 1
#endif
constexpr int MOE_EARLY = 4;
constexpr size_t MOE13_OFF = 4 * SZ_W13, MOE2_OFF = 4 * SZ_W2;
static_assert(MOE_FP8 == 1, "the early expert conversion needs the one-byte expert weights (two sets do not fit otherwise)");
constexpr float W13_SCALE = 64.0f, W2_SCALE = 256.0f;
#define PHASE_FN static __device__ __forceinline__ void
typedef const volatile LAS Args* LArgs;
DI Ctx make_ctx() { Ctx c; c.lds = (LAS unsigned char*)0; int t = threadIdx.x; asm volatile("" : "+v"(t)); int g = gridDim.x, b = blockIdx.x; asm volatile("" : "+s"(g), "+s"(b));
    c.tid = t; c.lane = t & 63; c.wave = __builtin_amdgcn_readfirstlane(t >> 6); c.G = g; c.bid = b; return c; }
DI const float* inp(LArgs a, int i) { return (const float*)rfl64((unsigned long long)a->in[i]); }
DI unsigned char* wsp(LArgs a) { return (unsigned char*)rfl64((unsigned long long)a->ws); }
DI float* outp(LArgs a) { return (float*)rfl64((unsigned long long)a->out); }

PHASE_FN ph_cvt_in(int L) {
    const Ctx c = make_ctx(); LArgs a = (LArgs)(LDS_ARGS); unsigned char* ws = wsp(a);
    int rot = 0;
    cvt_weight(c, inp(a, 2) + (size_t)L * D * NIN, (bf16_t*)(ws + WS_WIN), D, NIN, 0, 1, 0, 0, rot);
    cvt_weight(c, inp(a, 42) + (size_t)L * PE_DIM * D, (bf16_t*)(ws + WS_WPE), PE_DIM, D, 0, 1, 0, 0, rot);
    cvt_act(c, inp(a, 1) + (size_t)L * T * PE_DIM, (bf16_t*)(ws + WS_PB), (size_t)T * PE_DIM);
    if (L == 0) cvt_act(c, inp(a, 0), (bf16_t*)(ws + WS_XB), (size_t)T * D);
}
PHASE_FN ph_cvt_queue(int L) {
    const Ctx c = make_ctx(); LArgs a = (LArgs)(LDS_ARGS); unsigned char* ws = wsp(a);
    const bool moe = (L & 1) != 0; const int fi = L >> 1;
    unsigned* q = (unsigned*)(ws + WS_CTL) + CW_Q + 64 * L;
    volatile LAS int* slot = (volatile LAS int*)(c.lds + 67584);
    const int own = moe ? 3 * 704 * (NE - MOE_EARLY) : 3 * 704, total = 576 + own + (moe ? 0 : 3 * 704 * MOE_EARLY);
    struct TileD { const float* s; bf16_t* d; int K, N, mode, k0, n0; float wsc; };
    auto desc = [&](int idx, TileD& t) -> bool {
        if (idx >= total || (idx >= 256 && idx < 320)) return false;
        if (idx < 256) { t.s = inp(a, 30) + (size_t)L * D * D; t.d = (bf16_t*)(ws + WS_WOUT); t.K = D; t.N = D; t.mode = 0; t.wsc = 0.f; t.k0 = (idx >> 4) << 6; t.n0 = (idx & 15) << 6; }
        else if (idx < 576) { const int r = idx - 320; t.s = inp(a, 43) + (size_t)L * D * D; t.d = (bf16_t*)(ws + WS_WG); t.K = D; t.N = D; t.mode = 0; t.wsc = 0.f; t.k0 = (r >> 4) << 6; t.n0 = (r & 15) << 6; }
        else { int r = idx - 576; bool mt = moe; int eo = moe ? MOE_EARLY : 0, nbx = moe ? NE - MOE_EARLY : 1;
            if (!moe && r >= own) { r -= own; mt = true; eo = 0; nbx = MOE_EARLY; }
            const int ffn = 704 * nbx; const int which = r / ffn; r -= which * ffn; const int el = r / 704; r -= el * 704; const int e = eo + el;
            const float* src = inp(a, (mt ? 39 : 35) + which) + (size_t)((mt ? fi * NE : fi) + e) * D * DFF;
            if (which < 2) { t.s = src; t.K = D; t.N = DFF; t.mode = 1 + which; t.k0 = (r / 44) << 6; t.n0 = (r % 44) << 6;
                if (mt) { t.d = (bf16_t*)(ws + WS_W13 + MOE13_OFF + (size_t)e * NH2 * D); t.wsc = W13_SCALE; }
                else if (DENSE_FP8) { t.d = (bf16_t*)(ws + WS_W13); t.wsc = W13_SCALE; } else { t.d = (bf16_t*)(ws + WS_W13); t.wsc = 0.f; } }
            else { t.s = src; t.K = DFF; t.N = D; t.mode = 0; t.k0 = (r >> 4) << 6; t.n0 = (r & 15) << 6;
                if (mt) { t.d = (bf16_t*)(ws + WS_W2 + MOE2_OFF + (size_t)e * D * DFF); t.wsc = W2_SCALE; }
                else if (DENSE_FP8 || DENSE_FP8_DOWN) { t.d = (bf16_t*)(ws + WS_W2); t.wsc = W2_SCALE; } else { t.d = (bf16_t*)(ws + WS_W2); t.wsc = 0.f; } } }
        return true; };
    constexpr int NQ = 4;
    auto loadq = [&](const TileD& t, float (&r)[NQ][8]) {
#pragma unroll
        for (int qd = 0; qd < NQ; ++qd) {
#pragma unroll
            for (int i = 0; i < 8; ++i) r[qd][i] = t.s[(size_t)(t.k0 + i * 8 + (c.tid >> 6)) * t.N + t.n0 + 64 * qd + (c.tid & 63)]; } };
    LAS float* tiles = (LAS float*)c.lds;
    auto stageq = [&](const float (&r)[NQ][8]) {
#pragma unroll
        for (int qd = 0; qd < NQ; ++qd) {
#pragma unroll
            for (int j = 0; j < 8; ++j) tiles[qd * (64 * 65) + (j * 8 + (c.tid >> 6)) * 65 + (c.tid & 63)] = r[qd][j]; } };
    auto emitq = [&](const TileD& cur) {
#pragma unroll
        for (int qd = 0; qd < NQ; ++qd) { const LAS float* tile = tiles + qd * (64 * 65);
            const int n = c.tid >> 3, kk = (c.tid & 7) * 8, ng = cur.n0 + 64 * qd + n;
            int drow = ng; if (cur.mode == 1) drow = (ng >> 7) * 256 + (ng & 127); else if (cur.mode == 2) drow = (ng >> 7) * 256 + 128 + (ng & 127);
            if (cur.wsc == 0.f) { u32x4 w; w.x = pack_bf16(tile[(kk + 0) * 65 + n], tile[(kk + 1) * 65 + n]); w.y = pack_bf16(tile[(kk + 2) * 65 + n], tile[(kk + 3) * 65 + n]);
                w.z = pack_bf16(tile[(kk + 4) * 65 + n], tile[(kk + 5) * 65 + n]); w.w = pack_bf16(tile[(kk + 6) * 65 + n], tile[(kk + 7) * 65 + n]);
                *(u32x4*)(cur.d + (size_t)drow * cur.K + cur.k0 + kk) = w; }
            else { const float s_ = cur.wsc; u32x2 w8;
                w8.x = pg8::pk4_fp8(tile[(kk + 0) * 65 + n] * s_, tile[(kk + 1) * 65 + n] * s_, tile[(kk + 2) * 65 + n] * s_, tile[(kk + 3) * 65 + n] * s_);
                w8.y = pg8::pk4_fp8(tile[(kk + 4) * 65 + n] * s_, tile[(kk + 5) * 65 + n] * s_, tile[(kk + 6) * 65 + n] * s_, tile[(kk + 7) * 65 + n] * s_);
                *(u32x2*)((unsigned char*)cur.d + (size_t)drow * cur.K + cur.k0 + kk) = w8; } } };
    if (c.tid == 0) slot[0] = (int)atomicAdd(q, 8u);
    __syncthreads();
    int base = slot[0], pi = 0;
    __syncthreads();
    TileD cq, nq; float r[NQ][8];
    bool hq = desc(base, cq);
    if (hq) loadq(cq, r);
    int nb = 0;
#pragma unroll 1
    while (base < total) {
        if (hq) stageq(r);
        const bool last = (pi == 1);
        if (pi == 0 && c.tid == 0) nb = (int)atomicAdd(q, 8u);
        if (last && c.tid == 0) slot[0] = nb;
        __syncthreads();
        const int nbase = last ? slot[0] : base, npi = last ? 0 : pi + 1;
        const bool gq = desc(nbase + NQ * npi, nq);
        if (gq) loadq(nq, r);
        if (hq) emitq(cq);
        __syncthreads();
        cq = nq; hq = gq; base = nbase; pi = npi;
    }
}
PHASE_FN ph_proj(int L) {
    const Ctx c = make_ctx(); LArgs a = (LArgs)(LDS_ARGS); unsigned char* ws = wsp(a);
    pg8::Gemm g{(bf16_t*)(ws + WS_XB), (bf16_t*)(ws + WS_WIN), T, NINP, D}; pg8::StaticOrder S; S.init(T, NINP, c.G, c.bid);
    pg8::EpiBf16 E{(bf16_t*)(ws + WS_H), NINP};
    pg8::gemm_phase<pg8::EpiBf16, pg8::StaticOrder, false>(c.lds, g, S, E, nullptr);
}
DI MixP make_mixp(LArgs a, int L) {
    unsigned char* ws = wsp(a);
    MixP P; P.proj = (const GAS bf16_t*)(ws + WS_H); P.mix = (GAS bf16_t*)(ws + WS_MIX); P.layer = L;
    P.m_i_bias = (const GAS float*)inp(a, 3); P.m_f_bias = (const GAS float*)inp(a, 4); P.m_norm_w = (const GAS float*)inp(a, 5);
    P.g_conv_w = (const GAS float*)inp(a, 6); P.g_conv_b = (const GAS float*)inp(a, 7); P.g_w_a = (const GAS float*)inp(a, 8); P.g_b_a = (const GAS float*)inp(a, 9); P.g_w_x = (const GAS float*)inp(a, 10); P.g_b_x = (const GAS float*)inp(a, 11); P.g_lambda = (const GAS float*)inp(a, 12);
    P.r_mu = (const GAS float*)inp(a, 13); P.r_w0 = (const GAS float*)inp(a, 14); P.r_w2 = (const GAS float*)inp(a, 15); P.r_a0 = (const GAS float*)inp(a, 16); P.r_a2 = (const GAS float*)inp(a, 17); P.r_g2 = (const GAS float*)inp(a, 18); P.r_k_k = (const GAS float*)inp(a, 19); P.r_k_a = (const GAS float*)inp(a, 20);
    P.r_r_k = (const GAS float*)inp(a, 21); P.r_ln_w = (const GAS float*)inp(a, 22); P.r_ln_b = (const GAS float*)inp(a, 23);
    P.s_conv_w = (const GAS float*)inp(a, 24); P.s_conv_b = (const GAS float*)inp(a, 25); P.s_dt_bias = (const GAS float*)inp(a, 26); P.s_a_log = (const GAS float*)inp(a, 27); P.s_d = (const GAS float*)inp(a, 28); P.s_norm_w = (const GAS float*)inp(a, 29);
    return P;
}
PHASE_FN ph_mix_rwkv(int L, int b, int h) { const Ctx c = make_ctx(); LArgs a = (LArgs)(LDS_ARGS); const MixP P = make_mixp(a, L); unsigned char* ws = wsp(a);
    mix_rwkv_v5(c, P, (const GAS float*)(ws + WS_RWOPS), b, h, (const GAS unsigned*)(ws + WS_CTL) + CW_RDY + (b * 4 + h) * 16, (unsigned)(L + 1)); }
PHASE_FN ph_rwkv_prep(int L, int b, int h, int sp) { const Ctx c = make_ctx(); LArgs a = (LArgs)(LDS_ARGS); const MixP P = make_mixp(a, L); unsigned char* ws = wsp(a);
    rwkv_prep(c, P, (GAS float*)(ws + WS_RWOPS), b, h, sp, (GAS unsigned*)(ws + WS_CTL) + CW_RDY + (b * 4 + h) * 16, (unsigned)(L + 1)); }
PHASE_FN ph_mix_mlstm(int L, int b, int h) { const Ctx c = make_ctx(); const MixP P = make_mixp((LArgs)(LDS_ARGS), L); mix_mlstm_v2(c, P, b, h); }
PHASE_FN ph_mix_rglru(int L, int b, int h) { const Ctx c = make_ctx(); const MixP P = make_mixp((LArgs)(LDS_ARGS), L); mix_rglru_v2(c, P, b, h); }
PHASE_FN ph_mix_ssd(int L, int b, int g) { const Ctx c = make_ctx(); const MixP P = make_mixp((LArgs)(LDS_ARGS), L); mix_ssd_v3(c, P, b, g); }
PHASE_FN ph_outproj(int L) {
    const Ctx c = make_ctx(); LArgs a = (LArgs)(LDS_ARGS); unsigned char* ws = wsp(a); float* X = outp(a);
    pg8::Gemm g{(bf16_t*)(ws + WS_MIX), (bf16_t*)(ws + WS_WOUT), T, D, D}; pg8::StaticOrder S; S.init(T, D, c.G, c.bid);
    if (L == 0) { pg8::EpiPreLn<0, false> E{(bf16_t*)(ws + WS_PRE1), inp(a, 0), nullptr, D, ALPHA}; pg8::gemm_phase<pg8::EpiPreLn<0, false>, pg8::StaticOrder, false>(c.lds, g, S, E, nullptr); }
    else { pg8::EpiPreLn<1, false> E{(bf16_t*)(ws + WS_PRE1), (bf16_t*)(ws + WS_XB), nullptr, D, ALPHA}; pg8::gemm_phase<pg8::EpiPreLn<1, false>, pg8::StaticOrder, false>(c.lds, g, S, E, nullptr); }
}
PHASE_FN ph_ln1(int L) {
    const Ctx c = make_ctx(); LArgs a = (LArgs)(LDS_ARGS); unsigned char* ws = wsp(a); float* X = outp(a);
    const bool moe = (L & 1) != 0; const int fi = L >> 1; unsigned* ctl = (unsigned*)(ws + WS_CTL);
    if (moe) ln_phase<false, true, false>(c, X, (bf16_t*)(ws + WS_PRE1), (bf16_t*)(ws + WS_XB), nullptr, inp(a, 31) + L * D, inp(a, 32) + L * D, nullptr, nullptr, (Route*)(ws + WS_ROUTE), inp(a, 38) + (size_t)fi * D * NE, ctl + CW_CNT + 64 * fi);
    else ln_phase<false, false, false>(c, X, (bf16_t*)(ws + WS_PRE1), (bf16_t*)(ws + WS_XB), DENSE_FP8 ? ws + WS_XB8 : nullptr, inp(a, 31) + L * D, inp(a, 32) + L * D, nullptr, nullptr, nullptr, nullptr, nullptr);
}
PHASE_FN ph_gate(int L) {
    const Ctx c = make_ctx(); LArgs a = (LArgs)(LDS_ARGS); unsigned char* ws = wsp(a);
    pg8::Gemm g{(bf16_t*)(ws + WS_XB), (bf16_t*)(ws + WS_WG), T, D, D}; pg8::StaticOrder S; S.init(T, D, c.G, c.bid);
    pg8::EpiGate E{(bf16_t*)(ws + WS_PE), D, inp(a, 44) + L * D};
    pg8::gemm_phase<pg8::EpiGate, pg8::StaticOrder, false>(c.lds, g, S, E, nullptr);
}
PHASE_FN ph_pe(int L) {
    const Ctx c = make_ctx(); LArgs a = (LArgs)(LDS_ARGS); unsigned char* ws = wsp(a);
    pg8::Gemm g{(bf16_t*)(ws + WS_PB), (bf16_t*)(ws + WS_WPE), T, D, PE_DIM}; pg8::StaticOrder S; S.init(T, D, c.G, c.bid);
    pg8::EpiPeMul E{(bf16_t*)(ws + WS_PE), D};
    pg8::gemm_phase<pg8::EpiPeMul, pg8::StaticOrder, false>(c.lds, g, S, E, nullptr);
}
PHASE_FN ph_pe_raw(int L, int first, int stride) {
    const Ctx c = make_ctx(); LArgs a = (LArgs)(LDS_ARGS); unsigned char* ws = wsp(a);
    pg8::Gemm g{(bf16_t*)(ws + WS_PB), (bf16_t*)(ws + WS_WPE), T, D, PE_DIM}; pg8::ListOrder S; S.init(first, stride, (T / 256) * (D / 256), D / 256);
    pg8::EpiBf16 E{(bf16_t*)(ws + WS_PE), D};
    pg8::gemm_phase<pg8::EpiBf16, pg8::ListOrder, false>(c.lds, g, S, E, nullptr);
}
PHASE_FN ph_gate_mul(int L, int first, int stride) {
    const Ctx c = make_ctx(); LArgs a = (LArgs)(LDS_ARGS); unsigned char* ws = wsp(a);
    pg8::Gemm g{(bf16_t*)(ws + WS_XB), (bf16_t*)(ws + WS_WG), T, D, D}; pg8::ListOrder S; S.init(first, stride, (T / 256) * (D / 256), D / 256);
    pg8::EpiGateMul E{(bf16_t*)(ws + WS_PE), D, inp(a, 44) + L * D};
    pg8::gemm_phase<pg8::EpiGateMul, pg8::ListOrder, false>(c.lds, g, S, E, nullptr);
}
PHASE_FN ph_gate_mul_moe(int L) {
    const Ctx c = make_ctx(); LArgs a = (LArgs)(LDS_ARGS); unsigned char* ws = wsp(a); const int fi = L >> 1; const unsigned* counts = (const unsigned*)(ws + WS_CTL) + CW_CNT + 64 * fi;
    int nt = 0;
#pragma unroll
    for (int e = 0; e < NE; ++e) nt += __builtin_amdgcn_readfirstlane(((int)counts[e] + 255) >> 8);
    const int nwg = nt * (D / 256), rem = nwg % c.G, fast = c.G - rem;
    const int first = (c.bid >= rem) ? c.bid - rem : -1;
    pg8::Gemm g{(bf16_t*)(ws + WS_XB), (bf16_t*)(ws + WS_WG), T, D, D}; pg8::ListOrder S; S.init(first, fast, (T / 256) * (D / 256), D / 256);
    pg8::EpiGateMul E{(bf16_t*)(ws + WS_PE), D, inp(a, 44) + L * D};
    pg8::gemm_phase<pg8::EpiGateMul, pg8::ListOrder, false>(c.lds, g, S, E, nullptr);
}
PHASE_FN ph_cvt_pe(int L) {
    const Ctx c = make_ctx(); LArgs a = (LArgs)(LDS_ARGS); unsigned char* ws = wsp(a);
    int rot = 0;
    cvt_weight(c, inp(a, 42) + (size_t)L * PE_DIM * D, (bf16_t*)(ws + WS_WPE), PE_DIM, D, 0, 1, 0, 0, rot);
}
PHASE_FN ph_gather(int L) {
    const Ctx c = make_ctx(); LArgs a = (LArgs)(LDS_ARGS); unsigned char* ws = wsp(a); const int fi = L >> 1; unsigned* ctl = (unsigned*)(ws + WS_CTL);
    moe_assign_gather(c, (Route*)(ws + WS_ROUTE), ctl + CW_CNT + 64 * fi, ctl + CW_CUR + 64 * fi, (bf16_t*)(ws + WS_XB), (bf16_t*)(ws + WS_XG));
}
PHASE_FN ph_up_dense(int L) {
    const Ctx c = make_ctx(); LArgs a = (LArgs)(LDS_ARGS); unsigned char* ws = wsp(a);
#if DENSE_FP8
    pg8::Gemm g{(bf16_t*)(ws + WS_XB8), (bf16_t*)(ws + WS_W13), T, NH2, D / 2}; pg8::StaticOrder S; S.init(T, NH2, c.G, c.bid);
    pg8::EpiSwiglu8 E{ws + WS_H, DFF, 1.0f / W13_SCALE};
    pg8::gemm_phase<pg8::EpiSwiglu8, pg8::StaticOrder, false>(c.lds, g, S, E, nullptr);
#elif DENSE_FP8_DOWN
    pg8::Gemm g{(bf16_t*)(ws + WS_XB), (bf16_t*)(ws + WS_W13), T, NH2, D}; pg8::StaticOrder S; S.init(T, NH2, c.G, c.bid);
    pg8::EpiSwiglu8T<false> E{ws + WS_H, DFF, 1.0f};
    pg8::gemm_phase<pg8::EpiSwiglu8T<false>, pg8::StaticOrder, false>(c.lds, g, S, E, nullptr);
#else
    pg8::Gemm g{(bf16_t*)(ws + WS_XB), (bf16_t*)(ws + WS_W13), T, NH2, D}; pg8::StaticOrder S; S.init(T, NH2, c.G, c.bid);
    pg8::EpiSwiglu E{(bf16_t*)(ws + WS_H), DFF};
    pg8::gemm_phase<pg8::EpiSwiglu, pg8::StaticOrder, false>(c.lds, g, S, E, nullptr);
#endif
}
PHASE_FN ph_up_moe(int L) {
    const Ctx c = make_ctx(); LArgs a = (LArgs)(LDS_ARGS); unsigned char* ws = wsp(a); const int fi = L >> 1; unsigned* ctl = (unsigned*)(ws + WS_CTL);
#if MOE_FP8
    pg8::Gemm g{(bf16_t*)(ws + WS_XG), (bf16_t*)(ws + WS_W13 + MOE13_OFF), MOE_ROWS, NH2, D / 2}; pg8::MoeOrder S; S.init_moe(ctl + CW_CNT + 64 * fi, NH2 / 256, c.G, c.bid, (size_t)NH2 * D);
    pg8::EpiSwiglu8 E{ws + WS_H, DFF, 1.0f / W13_SCALE};
    pg8::gemm_phase<pg8::EpiSwiglu8, pg8::MoeOrder, false>(c.lds, g, S, E, nullptr);
#else
    pg8::Gemm g{(bf16_t*)(ws + WS_XG), (bf16_t*)(ws + WS_W13), MOE_ROWS, NH2, D}; pg8::MoeOrder S; S.init_moe(ctl + CW_CNT + 64 * fi, NH2 / 256, c.G, c.bid, SZ_W13);
    pg8::EpiSwiglu E{(bf16_t*)(ws + WS_H), DFF};
    pg8::gemm_phase<pg8::EpiSwiglu, pg8::MoeOrder, false>(c.lds, g, S, E, nullptr);
#endif
}
PHASE_FN ph_down_dense(int L) {
    const Ctx c = make_ctx(); LArgs a = (LArgs)(LDS_ARGS); unsigned char* ws = wsp(a); float* X = outp(a);
#if DENSE_FP8 || DENSE_FP8_DOWN
    pg8::Gemm g{(bf16_t*)(ws + WS_H), (bf16_t*)(ws + WS_W2), T, D, DFF / 2}; pg8::StaticOrder S; S.init(T, D, c.G, c.bid);
    pg8::EpiPreLn<1, true, true> E{(bf16_t*)(ws + WS_PRE2), (bf16_t*)(ws + WS_XB), (bf16_t*)(ws + WS_PE), D, ALPHA, 1.0f / W2_SCALE};
    pg8::gemm_phase<pg8::EpiPreLn<1, true, true>, pg8::StaticOrder, false>(c.lds, g, S, E, nullptr);
#else
    pg8::Gemm g{(bf16_t*)(ws + WS_H), (bf16_t*)(ws + WS_W2), T, D, DFF}; pg8::StaticOrder S; S.init(T, D, c.G, c.bid);
    pg8::EpiPreLn<1, true> E{(bf16_t*)(ws + WS_PRE2), (bf16_t*)(ws + WS_XB), (bf16_t*)(ws + WS_PE), D, ALPHA};
    pg8::gemm_phase<pg8::EpiPreLn<1, true>, pg8::StaticOrder, false>(c.lds, g, S, E, nullptr);
#endif
}
PHASE_FN ph_down_moe(int L) {
    const Ctx c = make_ctx(); LArgs a = (LArgs)(LDS_ARGS); unsigned char* ws = wsp(a); const int fi = L >> 1; unsigned* ctl = (unsigned*)(ws + WS_CTL);
#if MOE_FP8
    pg8::Gemm g{(bf16_t*)(ws + WS_H), (bf16_t*)(ws + WS_W2 + MOE2_OFF), MOE_ROWS, D, DFF / 2}; pg8::MoeOrder S; S.init_moe(ctl + CW_CNT + 64 * fi, D / 256, c.G, c.bid, (size_t)D * DFF);
    pg8::EpiBf16S8 E{(bf16_t*)(ws + WS_XG), D, 1.0f / W2_SCALE};
    pg8::gemm_phase<pg8::EpiBf16S8, pg8::MoeOrder, false>(c.lds, g, S, E, nullptr);
#else
    pg8::Gemm g{(bf16_t*)(ws + WS_H), (bf16_t*)(ws + WS_W2), MOE_ROWS, D, DFF}; pg8::MoeOrder S; S.init_moe(ctl + CW_CNT + 64 * fi, D / 256, c.G, c.bid, SZ_W2);
    pg8::EpiBf16 E{(bf16_t*)(ws + WS_XG), D};
    pg8::gemm_phase<pg8::EpiBf16, pg8::MoeOrder, false>(c.lds, g, S, E, nullptr);
#endif
}
PHASE_FN ph_ln2(int L) {
    const Ctx c = make_ctx(); LArgs a = (LArgs)(LDS_ARGS); unsigned char* ws = wsp(a); float* X = outp(a);
    const bool moe = (L & 1) != 0;
    if (moe) { if (L == DEPTH - 1) ln_phase<true, false, true>(c, X, nullptr, (bf16_t*)(ws + WS_XB), nullptr, inp(a, 33) + L * D, inp(a, 34) + L * D, (bf16_t*)(ws + WS_XG), (bf16_t*)(ws + WS_PE), (Route*)(ws + WS_ROUTE), nullptr, nullptr);
               else ln_phase<true, false, false>(c, X, nullptr, (bf16_t*)(ws + WS_XB), nullptr, inp(a, 33) + L * D, inp(a, 34) + L * D, (bf16_t*)(ws + WS_XG), (bf16_t*)(ws + WS_PE), (Route*)(ws + WS_ROUTE), nullptr, nullptr); }
    else ln_phase<false, false, false>(c, X, (bf16_t*)(ws + WS_PRE2), (bf16_t*)(ws + WS_XB), nullptr, inp(a, 33) + L * D, inp(a, 34) + L * D, nullptr, nullptr, nullptr, nullptr, nullptr);
}

DI void grid_bar(unsigned* barw, unsigned x, volatile LAS unsigned* st) { asm volatile("" : "+s"(barw), "+s"(x)); XcdBarrier b; b.bar = barw; b.x = x; b.st = st; xcd_barrier(b); }

#define IN(k) (ph_lo <= (k) && (k) < ph_hi)
#define SEAM(k) do { if (IN((k) + 1)) grid_bar(bar.bar, bar.x, bar.st); } while (0)
template <int L> DI void layer_body(const int ph_lo, const int ph_hi, const XcdBarrier& bar) {
        const int p0 = L * NPH; const bool moe = (L & 1) != 0;
        if (PHEN(0) && IN(p0 + 0)) { if (L == 0) { ph_cvt_in(0); SEAM(p0 + 0); } }
        if (PHEN(1) && IN(p0 + 1)) { ph_proj(L); SEAM(p0 + 1); }
        if (PHEN(2) && IN(p0 + 2)) {
            { const bool handoff = gridDim.x == 256; const int grp = blockIdx.x & 3, idx = blockIdx.x >> 2;
              const int rank = (grp == 2) ? idx : (grp == 1) ? 64 + idx : (grp == 3 && idx >= 32) ? 96 + idx : 512;
              const int nr = handoff ? 4 : (512 + (int)gridDim.x - 1) / (int)gridDim.x;
              for (int r = 0; r < nr; ++r) {
                  const int t = !handoff ? (int)blockIdx.x + r * (int)gridDim.x : (r == 0) ? rank : (rank < 128) ? 160 + (r - 1) * 128 + ((r == 3) ? rank : ((rank + 64) & 127)) : 512;
                  if (t < 512) { ph_rwkv_prep(L, (t & 63) >> 2, t & 3, t >> 6); __syncthreads(); } }
              if (!handoff) grid_bar(bar.bar, bar.x, bar.st); }
            for (int task = blockIdx.x; task < 256; task += gridDim.x) {
                const int grp = task & 3, idx = task >> 2;
                if (grp == 0) ph_mix_rwkv(L, idx >> 2, idx & 3);
                else if (grp == 1) ph_mix_mlstm(L, idx >> 2, idx & 3);
                else if (grp == 2) ph_mix_rglru(L, idx >> 2, idx & 3);
                else if (idx < 32) ph_mix_ssd(L, idx >> 1, idx & 1);
                else ph_pe_raw(L, idx - 32, 32);
                __syncthreads();
            }
            ph_cvt_queue(L);
            SEAM(p0 + 2);
        }
        if (PHEN(3) && IN(p0 + 3)) { ph_outproj(L); SEAM(p0 + 3); }
        if (PHEN(4) && IN(p0 + 4)) { ph_ln1(L); SEAM(p0 + 4); }
        if (PHEN(5) && IN(p0 + 5)) { if (moe) { ph_gather(L); SEAM(p0 + 5); } }
        if (PHEN(6) && IN(p0 + 6)) { if (moe) ph_up_moe(L); else { ph_up_dense(L); ph_gate_mul(L, blockIdx.x, gridDim.x); } SEAM(p0 + 6); }
        if (PHEN(7) && IN(p0 + 7)) { if (moe) { ph_down_moe(L); ph_gate_mul_moe(L); } else ph_down_dense(L); SEAM(p0 + 7); }
        if (PHEN(8) && IN(p0 + 8)) { ph_ln2(L); if (L + 1 < DEPTH) { __syncthreads(); ph_cvt_in(L + 1); SEAM(p0 + 8); } }
}

__global__ void __launch_bounds__(512, 2) fwd_kernel(Args args) {
    extern __shared__ __attribute__((aligned(16))) unsigned char lds_raw[];
    LAS unsigned char* lds = (LAS unsigned char*)lds_raw;
    const int tid = threadIdx.x;
    volatile LAS unsigned* misc = (volatile LAS unsigned*)(lds + LDS_MISC);
    if (tid < 4) misc[tid] = 0u;
    { LAS unsigned long long* la = (LAS unsigned long long*)(lds + LDS_ARGS); const unsigned long long* ga = (const unsigned long long*)&args;
      if (tid < (int)(sizeof(Args) / 8)) la[tid] = ga[tid]; }
    __syncthreads();
    const int ph_lo = args.ph_lo, ph_hi = args.ph_hi;
    const bool multi = !(ph_lo == 0 && ph_hi == DEPTH * NPH);
    unsigned* ctl = (unsigned*)(args.ws + WS_CTL);
    XcdBarrier bar; bar.bar = ctl + CW_BAR; bar.x = 0; bar.st = misc;
    if (!multi) bar = xcd_barrier_post(ctl + CW_BAR, misc);
    layer_body<0>(ph_lo, ph_hi, bar); layer_body<1>(ph_lo, ph_hi, bar); layer_body<2>(ph_lo, ph_hi, bar); layer_body<3>(ph_lo, ph_hi, bar);
#undef IN
#undef SEAM
}

#ifndef MK_PER_PHASE
#define MK_PER_PHASE 0
#endif
extern "C" void kernel_launch(void* const* d_in, const int* in_sizes, int n_in, void* d_out, int out_size, void* d_ws, size_t ws_size, hipStream_t stream) {
    static int grid = 0;
    if (grid == 0) {
        if (n_in != 45 || in_sizes[0] != T * D || out_size != T * D || ws_size < (WS_END > WS_NEED ? WS_END : WS_NEED)) {
            fprintf(stderr, "kernel_launch: unexpected shapes (n_in %d, in0 %d, out %d, ws %zu < %zu); nothing launched\n", n_in, n_in > 0 ? in_sizes[0] : -1, out_size, ws_size, (size_t)WS_END); grid = -1; return; }
        int dev = 0, cus = 0, per_cu = 0;
        if (hipGetDevice(&dev) != hipSuccess || hipDeviceGetAttribute(&cus, hipDeviceAttributeMultiprocessorCount, dev) != hipSuccess) { grid = -1; return; }
        if (hipFuncSetAttribute((const void*)fwd_kernel, hipFuncAttributeMaxDynamicSharedMemorySize, LDS_BYTES) != hipSuccess) { fprintf(stderr, "kernel_launch: hipFuncSetAttribute failed\n"); grid = -1; return; }
        if (hipOccupancyMaxActiveBlocksPerMultiprocessor(&per_cu, (const void*)fwd_kernel, 512, LDS_BYTES) != hipSuccess || per_cu < 1) { fprintf(stderr, "kernel_launch: occupancy query reports %d\n", per_cu); (void)hipGetLastError(); grid = -1; return; }
        grid = cus;
    }
    if (grid < 0) return;
    (void)hipMemsetAsync((char*)d_ws + WS_CTL, 0, CTL_BYTES, stream);
    Args a{};
    for (int i = 0; i < 45; ++i) a.in[i] = (const float*)d_in[i];
    a.out = (float*)d_out; a.ws = (unsigned char*)d_ws;
#if MK_PER_PHASE
    for (int ph = 0; ph < DEPTH * NPH; ++ph) { a.ph_lo = ph; a.ph_hi = ph + 1; hipLaunchKernelGGL(fwd_kernel, dim3(grid), dim3(512), LDS_BYTES, stream, a); }
#else
    a.ph_lo = 0; a.ph_hi = DEPTH * NPH;
    hipLaunchKernelGGL(fwd_kernel, dim3(grid), dim3(512), LDS_BYTES, stream, a);
#endif
}
```
